# Optimizing an MI355X kernel written in HIP

```python
import math
import jax
import jax.numpy as jnp
from jax import lax
import numpy as np

D_MODEL = 4096
BATCH = 1
SEQ = 16384
DEPTH = 4

GRID_W = 64
CTX_LEN = 256
N_MIXERS = 3
N_HG = (DEPTH + 2) // 3
N_AT = (DEPTH + 1) // 3
N_SSM = DEPTH // 3
ALPHA = (2 * DEPTH) ** 0.25
OUT_SCALE = (8 * DEPTH) ** -0.25
LN_EPS = 1e-6
RMS_EPS = 1e-6
SCAN_CHUNK = 64

HG_HEADS = 16
HG_KDIM = 128
HG_VDIM = D_MODEL // HG_HEADS
HG_FDIM = HG_HEADS * HG_KDIM
HG_PROJ = 3 * HG_FDIM + 2 * D_MODEL
HG_SPLITS = (HG_FDIM, 2 * HG_FDIM, 3 * HG_FDIM, 3 * HG_FDIM + D_MODEL)

ATT_HEADS = 32
ATT_KV_HEADS = 8
ATT_HDIM = D_MODEL // ATT_HEADS
ATT_GROUP = ATT_HEADS // ATT_KV_HEADS
ATT_KV_DIM = ATT_KV_HEADS * ATT_HDIM
AT_PROJ = D_MODEL + 2 * ATT_KV_DIM
ROPE_THETA = 10000.0
ROPE_PAIRS_PER_AXIS = ATT_HDIM // 4
Q_BLOCK = 128

SSM_DINNER = 2 * D_MODEL
SSM_HDIM = 64
SSM_HEADS = SSM_DINNER // SSM_HDIM
SSM_GROUPS = 8
SSM_DSTATE = 128
SSM_CONV = 3
SSM_CONV_DIM = SSM_DINNER + 2 * SSM_GROUPS * SSM_DSTATE
SSM_PROJ = SSM_DINNER + SSM_CONV_DIM + 2 * SSM_HEADS
SSM_SPLITS = (SSM_DINNER, SSM_DINNER + SSM_CONV_DIM)
SSM_XB_SPLITS = (SSM_DINNER, SSM_DINNER + SSM_GROUPS * SSM_DSTATE)

FFN_DIM = 4096
FFN_CONV = 3

kernel_name = 'hybrid_hgrn2_gqa_mamba2_diffusion_trunk'


def _split_heads(a, n):
    return a.reshape(a.shape[:-1] + (n, a.shape[-1] // n))


def _flip(a):
    return jnp.flip(a, axis=1)


def _same(a):
    return a


def rms_norm(x, gain):
    xf = x.astype(jnp.float32)
    y = xf * lax.rsqrt(jnp.mean(xf * xf, axis=-1, keepdims=True) + RMS_EPS)
    return (y * gain.astype(jnp.float32)).astype(x.dtype)


def layer_norm(x, gain, bias):
    xf = x.astype(jnp.float32)
    xc = xf - jnp.mean(xf, axis=-1, keepdims=True)
    var = jnp.mean(xc * xc, axis=-1, keepdims=True)
    y = xc * lax.rsqrt(var + LN_EPS) * gain.astype(jnp.float32) + bias.astype(jnp.float32)
    return y.astype(x.dtype)


def modulate(x, shift, scale):
    return x * (1.0 + scale) + shift


def depthwise_conv(x, w, b):
    width = w.shape[0]
    pad = width // 2
    n = x.shape[1]
    xp = jnp.pad(x, ((0, 0), (pad, pad), (0, 0)))
    return sum(xp[:, j:j + n] * w[j] for j in range(width)) + b


def _to_chunks(a):
    b, n = a.shape[0], a.shape[1] // SCAN_CHUNK
    a = a.astype(jnp.float32).reshape((b, n, SCAN_CHUNK) + a.shape[2:])
    return jnp.moveaxis(a, 1, 0)


def _from_chunks(a):
    a = jnp.moveaxis(a, 0, 1)
    return a.reshape((a.shape[0], a.shape[1] * a.shape[2]) + a.shape[3:])


def _gla_chunk_scan(q, k, v, log_f, s0):
    mask = jnp.tril(jnp.ones((SCAN_CHUNK, SCAN_CHUNK), dtype=bool))[None, :, :, None, None]

    def step(s, inp):
        qi, ki, vi, lf = inp
        g = jnp.cumsum(lf, axis=1)
        decay = jnp.exp(jnp.where(mask, g[:, :, None] - g[:, None], -jnp.inf))
        scores = jnp.einsum('bthk,bshk,btshk->bhts', qi, ki, decay)
        o = (jnp.einsum('bhts,bshv->bthv', scores, vi)
             + jnp.einsum('bthk,bhkv->bthv', qi * jnp.exp(g), s))
        g_end = g[:, -1]
        s = (jnp.exp(g_end)[..., None] * s
             + jnp.einsum('bshk,bshv->bhkv', ki * jnp.exp(g_end[:, None] - g), vi))
        return s, o

    s_end, o = lax.scan(step, s0, (_to_chunks(q), _to_chunks(k), _to_chunks(v), _to_chunks(log_f)))
    return _from_chunks(o), s_end


def _ssd_chunk_scan(x, dt, log_a, bm, cm, s0):
    bsz, seq, heads, hdim = x.shape
    groups, nstate = bm.shape[2], bm.shape[3]
    rep = heads // groups
    xdt = (x.astype(jnp.float32) * dt[..., None]).reshape(bsz, seq, groups, rep, hdim)
    la = log_a.reshape(bsz, seq, groups, rep)
    mask = jnp.tril(jnp.ones((SCAN_CHUNK, SCAN_CHUNK), dtype=bool))[None, :, :, None, None]

    def step(s, inp):
        xi, lai, bi, ci = inp
        g = jnp.cumsum(lai, axis=1)
        seg = jnp.exp(jnp.where(mask, g[:, :, None] - g[:, None], -jnp.inf))
        cb = jnp.einsum('btgn,bsgn->btsg', ci, bi)
        y = (jnp.einsum('btsg,btsgr,bsgrp->btgrp', cb, seg, xi)
             + jnp.einsum('btgn,bgrpn->btgrp', ci, s) * jnp.exp(g)[..., None])
        g_end = g[:, -1]
        s = (jnp.exp(g_end)[..., None, None] * s
             + jnp.einsum('bsgn,bsgrp->bgrpn', bi, xi * jnp.exp(g_end[:, None] - g)[..., None]))
        return s, y

    s_end, y = lax.scan(step, s0.reshape(bsz, groups, rep, hdim, nstate),
                        (_to_chunks(xdt), _to_chunks(la), _to_chunks(bm), _to_chunks(cm)))
    return _from_chunks(y).reshape(bsz, seq, heads, hdim), s_end.reshape(bsz, heads, hdim, nstate)


def hgrn2_lower_bounds(lb_raw):
    p = jax.nn.softmax(lb_raw.astype(jnp.float32), axis=1)
    return jnp.cumsum(p, axis=1) - p[:, :1]


def _hgrn2_streams(h, w_in, lb):
    q, z_fw, z_bw, v, gate = jnp.split(h @ w_in, HG_SPLITS, axis=-1)
    q = _split_heads(jax.nn.silu(q) * HG_KDIM ** -0.5, HG_HEADS)
    v = _split_heads(v, HG_HEADS)
    dirs = []
    for d, z in enumerate((z_fw, z_bw)):
        z = _split_heads(z.astype(jnp.float32), HG_HEADS)
        lbd = _split_heads(lb[d].astype(jnp.float32), HG_HEADS)
        log_f = jnp.logaddexp(jnp.log(lbd), jnp.log1p(-lbd) + jax.nn.log_sigmoid(z))
        key = (1.0 - lbd) * jax.nn.sigmoid(-z)
        dirs.append((key, log_f))
    return q, v, gate, dirs


def hgrn2_mixer(h_lat, h_ctx, w_in, w_out, lb, norm_g, ctx_out):
    q_l, v_l, gate_l, dirs_l = _hgrn2_streams(h_lat, w_in, lb)
    q_c, v_c, gate_c, dirs_c = _hgrn2_streams(h_ctx, w_in, lb)
    s0 = jnp.zeros((h_lat.shape[0], HG_HEADS, HG_KDIM, HG_VDIM), jnp.float32)
    o_l, o_c = [], []
    for d in range(2):
        fl = _flip if d == 1 else _same
        (k_l, lf_l), (k_c, lf_c) = dirs_l[d], dirs_c[d]
        oc, s_ctx = _gla_chunk_scan(fl(q_c), fl(k_c), fl(v_c), fl(lf_c), s0)
        ol, _ = _gla_chunk_scan(fl(q_l), fl(k_l), fl(v_l), fl(lf_l), s_ctx)
        o_l.append(fl(ol))
        o_c.append(fl(oc))

    def readout(o, gate, h):
        o = o.reshape(h.shape).astype(h.dtype)
        return (rms_norm(o, norm_g) * jax.nn.silu(gate)) @ w_out

    y_l = readout(o_l[0] + o_l[1], gate_l, h_lat)
    y_c = readout(o_c[0] + o_c[1], gate_c, h_ctx) if ctx_out else None
    return y_l, y_c


def axial_rope_tables(rows):
    row_id = jnp.repeat(jnp.arange(rows, dtype=jnp.float32), GRID_W)
    col_id = jnp.tile(jnp.arange(GRID_W, dtype=jnp.float32), rows)
    inv_freq = ROPE_THETA ** (-jnp.arange(ROPE_PAIRS_PER_AXIS, dtype=jnp.float32) / ROPE_PAIRS_PER_AXIS)
    ang = jnp.concatenate([row_id[:, None] * inv_freq, col_id[:, None] * inv_freq], axis=-1)
    return jnp.cos(ang), jnp.sin(ang)


def apply_rope(x, cos, sin):
    extra = x.ndim - 3
    cos = cos.reshape(cos.shape[:1] + (1,) * extra + cos.shape[1:])
    sin = sin.reshape(sin.shape[:1] + (1,) * extra + sin.shape[1:])
    xf = x.astype(jnp.float32).reshape(x.shape[:-1] + (-1, 2))
    x1, x2 = xf[..., 0], xf[..., 1]
    out = jnp.stack([x1 * cos - x2 * sin, x1 * sin + x2 * cos], axis=-1)
    return out.reshape(x.shape).astype(x.dtype)


def gqa_mixer(h_lat, h_ctx, w_qkv, w_out, q_gain, k_gain, cos, sin, ctx_out):
    bsz, n_lat, _ = h_lat.shape
    scale = ATT_HDIM ** -0.5

    def qkv(h):
        t = h.shape[1]
        q, k, v = jnp.split(h @ w_qkv, (D_MODEL, D_MODEL + ATT_KV_DIM), axis=-1)
        q = rms_norm(q.reshape(bsz, t, ATT_KV_HEADS, ATT_GROUP, ATT_HDIM), q_gain)
        k = rms_norm(k.reshape(bsz, t, ATT_KV_HEADS, ATT_HDIM), k_gain)
        return q, k, v.reshape(bsz, t, ATT_KV_HEADS, ATT_HDIM)

    def attend(q, k, v):
        s = jnp.einsum('bqhgd,bnhd->bhgqn', q, k).astype(jnp.float32) * scale
        p = jax.nn.softmax(s, axis=-1).astype(v.dtype)
        return jnp.einsum('bhgqn,bnhd->bqhgd', p, v)

    q_l, k_l, v_l = qkv(h_lat)
    q_c, k_c, v_c = qkv(h_ctx)
    q_l = apply_rope(q_l, cos, sin)
    k_l = apply_rope(k_l, cos, sin)
    keys = jnp.concatenate([k_l, k_c], axis=1)
    vals = jnp.concatenate([v_l, v_c], axis=1)
    n_blocks = n_lat // Q_BLOCK
    q_blocks = jnp.moveaxis(q_l.reshape(bsz, n_blocks, Q_BLOCK, ATT_KV_HEADS, ATT_GROUP, ATT_HDIM), 1, 0)
    o_l = lax.map(lambda qb: attend(qb, keys, vals), q_blocks)
    o_l = jnp.moveaxis(o_l, 0, 1).reshape(bsz, n_lat, D_MODEL)
    y_c = None
    if ctx_out:
        y_c = attend(q_c, k_c, v_c).reshape(bsz, h_ctx.shape[1], D_MODEL) @ w_out
    return o_l @ w_out, y_c


def _mamba2_streams(h, w_in, conv_w, conv_b):
    z, xbc, dt = jnp.split(h @ w_in, SSM_SPLITS, axis=-1)
    xbc = jax.nn.silu(depthwise_conv(xbc, conv_w, conv_b))
    xs, bm, cm = jnp.split(xbc, SSM_XB_SPLITS, axis=-1)
    return (z, _split_heads(xs, SSM_HEADS), _split_heads(bm, SSM_GROUPS),
            _split_heads(cm, SSM_GROUPS), _split_heads(dt, 2))


def mamba2_mixer(h_lat, h_ctx, w_in, conv_w, conv_b, dt_bias, a_log, d_skip, norm_g, w_out, ctx_out):
    st_l = _mamba2_streams(h_lat, w_in, conv_w, conv_b)
    st_c = _mamba2_streams(h_ctx, w_in, conv_w, conv_b)
    s0 = jnp.zeros((h_lat.shape[0], SSM_HEADS, SSM_HDIM, SSM_DSTATE), jnp.float32)
    y_l, y_c = [], []
    for d in range(2):
        fl = _flip if d == 1 else _same
        a = -jnp.exp(a_log[d].astype(jnp.float32))
        bias = dt_bias[d].astype(jnp.float32)

        def dir_inputs(st):
            _, xs, bm, cm, dt = st
            dt_d = jax.nn.softplus(dt[:, :, d].astype(jnp.float32) + bias)
            return fl(xs), fl(dt_d), fl(dt_d * a), fl(bm), fl(cm)

        yc, s_ctx = _ssd_chunk_scan(*dir_inputs(st_c), s0)
        yl, _ = _ssd_chunk_scan(*dir_inputs(st_l), s_ctx)
        y_l.append(fl(yl))
        y_c.append(fl(yc))

    def readout(y, st, h):
        z, xs = st[0], st[1]
        y = y + d_skip.astype(jnp.float32)[:, None] * xs.astype(jnp.float32)
        y = y.reshape(z.shape) * jax.nn.silu(z.astype(jnp.float32))
        y = rms_norm(_split_heads(y, SSM_GROUPS), _split_heads(norm_g, SSM_GROUPS)).reshape(z.shape)
        return y.astype(h.dtype) @ w_out

    out_l = readout(y_l[0] + y_l[1], st_l, h_lat)
    out_c = readout(y_c[0] + y_c[1], st_c, h_ctx) if ctx_out else None
    return out_l, out_c


def conv_ffn(h, w_gate, w_up, conv_w, conv_b, w_down):
    a = depthwise_conv(h @ w_gate, conv_w, conv_b)
    return (jax.nn.silu(a) * (h @ w_up)) @ w_down


def setup_inputs(seed: int = 0) -> dict:
    key = jax.random.key(seed)
    keys = iter(jax.random.split(key, 40))
    f32 = jnp.float32

    def nrm(shape, scale):
        return jax.random.normal(next(keys), shape, f32) * scale

    d_in = D_MODEL ** -0.5
    dt = jnp.exp(jax.random.uniform(next(keys), (N_SSM, 2, SSM_HEADS), f32, math.log(1e-3), math.log(1e-1)))
    dt_bias = dt + jnp.log(-jnp.expm1(-dt))
    a_log = jnp.log(jax.random.uniform(next(keys), (N_SSM, 2, SSM_HEADS), f32, 1.0, 16.0))
    return {
        'x': nrm((BATCH, SEQ, D_MODEL), 1.0),
        'c': nrm((BATCH, D_MODEL), 1.0),
        'ctx': nrm((BATCH, CTX_LEN, D_MODEL), 1.0),
        'c_ctx': nrm((D_MODEL,), 1.0),
        'mod_w': nrm((DEPTH, D_MODEL, 6 * D_MODEL), d_in),
        'mod_b': nrm((DEPTH, 6 * D_MODEL), 0.02),
        'ln_g': 1.0 + nrm((DEPTH, 2, D_MODEL), 0.02),
        'ln_b': nrm((DEPTH, 2, D_MODEL), 0.02),
        'hg_win': nrm((N_HG, D_MODEL, HG_PROJ), d_in),
        'hg_wout': nrm((N_HG, D_MODEL, D_MODEL), d_in * OUT_SCALE),
        'hg_lb': nrm((2, N_HG, HG_FDIM), 1.0),
        'hg_norm': 1.0 + nrm((N_HG, D_MODEL), 0.02),
        'at_wqkv': nrm((N_AT, D_MODEL, AT_PROJ), d_in),
        'at_wout': nrm((N_AT, D_MODEL, D_MODEL), d_in * OUT_SCALE),
        'at_qn': 1.0 + nrm((N_AT, ATT_HDIM), 0.02),
        'at_kn': 1.0 + nrm((N_AT, ATT_HDIM), 0.02),
        'ssm_win': nrm((N_SSM, D_MODEL, SSM_PROJ), d_in),
        'ssm_conv_w': nrm((N_SSM, SSM_CONV, SSM_CONV_DIM), SSM_CONV ** -0.5),
        'ssm_conv_b': nrm((N_SSM, SSM_CONV_DIM), 0.02),
        'ssm_dt_bias': dt_bias,
        'ssm_a_log': a_log,
        'ssm_d': 1.0 + nrm((N_SSM, SSM_HEADS), 0.02),
        'ssm_norm': 1.0 + nrm((N_SSM, SSM_DINNER), 0.02),
        'ssm_wout': nrm((N_SSM, SSM_DINNER, D_MODEL), SSM_DINNER ** -0.5 * OUT_SCALE),
        'ffn_wg': nrm((DEPTH, D_MODEL, FFN_DIM), d_in),
        'ffn_wu': nrm((DEPTH, D_MODEL, FFN_DIM), d_in),
        'ffn_conv_w': nrm((DEPTH, FFN_CONV, FFN_DIM), FFN_CONV ** -0.5),
        'ffn_conv_b': nrm((DEPTH, FFN_DIM), 0.02),
        'ffn_wd': nrm((DEPTH, FFN_DIM, D_MODEL), FFN_DIM ** -0.5 * OUT_SCALE),
    }


def reference(x, c, ctx, c_ctx, mod_w, mod_b, ln_g, ln_b, hg_win, hg_wout, hg_lb, hg_norm,
              at_wqkv, at_wout, at_qn, at_kn, ssm_win, ssm_conv_w, ssm_conv_b, ssm_dt_bias,
              ssm_a_log, ssm_d, ssm_norm, ssm_wout, ffn_wg, ffn_wu, ffn_conv_w, ffn_conv_b, ffn_wd):
    rows = x.shape[1] // GRID_W
    cos, sin = axial_rope_tables(rows)
    lb = hgrn2_lower_bounds(hg_lb)
    cond_lat = jax.nn.silu(c)
    cond_ctx = jax.nn.silu(c_ctx)[None, :]
    x_lat, x_ctx = x, ctx
    for l in range(DEPTH):
        kind, j = l % N_MIXERS, l // N_MIXERS
        ctx_out = l < DEPTH - 1
        sh_a, sc_a, gt_a, sh_f, sc_f, gt_f = jnp.split(
            (cond_lat @ mod_w[l] + mod_b[l])[:, None, :], 6, axis=-1)
        csh_a, csc_a, cgt_a, csh_f, csc_f, cgt_f = jnp.split(
            (cond_ctx @ mod_w[l] + mod_b[l])[:, None, :], 6, axis=-1)
        h_lat = modulate(x_lat, sh_a, sc_a)
        h_ctx = modulate(x_ctx, csh_a, csc_a)
        if kind == 0:
            o_lat, o_ctx = hgrn2_mixer(h_lat, h_ctx, hg_win[j], hg_wout[j], lb[:, j], hg_norm[j], ctx_out)
        elif kind == 1:
            o_lat, o_ctx = gqa_mixer(h_lat, h_ctx, at_wqkv[j], at_wout[j], at_qn[j], at_kn[j], cos, sin, ctx_out)
        else:
            o_lat, o_ctx = mamba2_mixer(h_lat, h_ctx, ssm_win[j], ssm_conv_w[j], ssm_conv_b[j],
                                        ssm_dt_bias[j], ssm_a_log[j], ssm_d[j], ssm_norm[j],
                                        ssm_wout[j], ctx_out)
        x_lat = layer_norm(ALPHA * x_lat + gt_a * o_lat, ln_g[l, 0], ln_b[l, 0])
        f_lat = conv_ffn(modulate(x_lat, sh_f, sc_f), ffn_wg[l], ffn_wu[l], ffn_conv_w[l], ffn_conv_b[l], ffn_wd[l])
        x_lat = layer_norm(ALPHA * x_lat + gt_f * f_lat, ln_g[l, 1], ln_b[l, 1])
        if ctx_out:
            x_ctx = layer_norm(ALPHA * x_ctx + cgt_a * o_ctx, ln_g[l, 0], ln_b[l, 0])
            f_ctx = conv_ffn(modulate(x_ctx, csh_f, csc_f), ffn_wg[l], ffn_wu[l], ffn_conv_w[l],
                             ffn_conv_b[l], ffn_wd[l])
            x_ctx = layer_norm(ALPHA * x_ctx + cgt_f * f_ctx, ln_g[l, 1], ln_b[l, 1])
    return x_lat
```

```cpp
#include <hip/hip_runtime.h>
#include <cstdio>
#include <cstdint>

#define LAS __attribute__((address_space(3)))
typedef unsigned short bf16_t;
typedef short bf16x8 __attribute__((ext_vector_type(8)));
typedef short s16x4 __attribute__((ext_vector_type(4)));
typedef float f32x2 __attribute__((ext_vector_type(2)));
typedef float f32x4 __attribute__((ext_vector_type(4)));
typedef float f32x8 __attribute__((ext_vector_type(8)));
typedef float f32x16 __attribute__((ext_vector_type(16)));
typedef unsigned u32x2 __attribute__((ext_vector_type(2)));
typedef unsigned u32x4 __attribute__((ext_vector_type(4)));

#ifndef MK_MULTI
#define MK_MULTI 0
#define MK_PROBE 0
#endif

constexpr int D = 4096, TL = 16384, TC = 256, T = TL + TC, DEPTH = 4, NT = 512;
constexpr float ALPHA = 1.6817928305074292f;
constexpr float LN_EPS = 1e-6f, RMS_EPS = 1e-6f;
constexpr int HG_PROJ = 14336, AT_PROJ = 6144, SSM_PROJ = 18688, MODN = 6 * D;
constexpr int SKMAX = 16;

constexpr size_t al256(size_t x) { return (x + 255) & ~(size_t)255; }
constexpr size_t WS_CTL   = 0;
constexpr size_t WS_MODP  = 65536;
constexpr size_t WS_MODV  = WS_MODP + (size_t)32 * 4 * 2 * MODN * 4;
constexpr size_t WS_ROPE  = WS_MODV + (size_t)4 * 2 * MODN * 4;
constexpr size_t WS_LB    = WS_ROPE + (size_t)256 * 32 * 2 * 4;
constexpr size_t WS_W     = al256(WS_LB + (size_t)3 * 2 * 2 * 2048 * 4);
constexpr size_t SZ_HGIN = (size_t)HG_PROJ * D * 2, SZ_SQ = (size_t)D * D * 2, SZ_ATQKV = (size_t)AT_PROJ * D * 2, SZ_SSMIN = (size_t)SSM_PROJ * D * 2, SZ_SSMOUT = (size_t)D * 8192 * 2, SZ_GU = (size_t)8192 * D * 2;
constexpr size_t WS_HGIN  = WS_W;
constexpr size_t WS_HGOUT = WS_HGIN + 2 * SZ_HGIN;
constexpr size_t WS_ATQKV = WS_HGOUT + 2 * SZ_SQ;
constexpr size_t WS_ATOUT = WS_ATQKV + SZ_ATQKV;
constexpr size_t WS_SSMIN = WS_ATOUT + SZ_SQ;
constexpr size_t WS_SSMOUT = WS_SSMIN + SZ_SSMIN;
constexpr size_t WS_GU    = WS_SSMOUT + SZ_SSMOUT;
constexpr size_t WS_FD    = WS_GU + 4 * SZ_GU;
constexpr size_t WS_ACT   = WS_FD + 4 * SZ_SQ;
constexpr size_t WS_X     = WS_ACT;
constexpr size_t WS_H     = WS_X + (size_t)T * D * 4;
constexpr size_t WS_YB    = WS_H + (size_t)T * D * 2;
constexpr size_t WS_OB    = WS_YB + (size_t)T * 8192 * 2;
constexpr size_t WS_AU    = WS_OB + (size_t)T * D * 2;
constexpr size_t WS_HID   = WS_AU + (size_t)T * 8192 * 2;
constexpr size_t WS_PART  = WS_HID + (size_t)T * D * 2;
constexpr size_t WS_EDGE  = WS_PART + (size_t)68 * 1024 * 1024;
constexpr size_t WS_MIX   = WS_EDGE + (size_t)65 * 6 * 4096 * 4;
constexpr int NCH = 260;
constexpr size_t HG_QB  = WS_MIX;
constexpr size_t HG_LF  = HG_QB + (size_t)T * 2048 * 2;
constexpr size_t HG_KB  = HG_LF + (size_t)2 * T * 2048 * 4;
constexpr size_t HG_V   = HG_KB + (size_t)2 * T * 2048 * 2;
constexpr size_t HG_SG  = HG_V + (size_t)T * D * 2;
constexpr size_t HG_O   = HG_SG + (size_t)T * D * 2;
constexpr size_t HG_A   = HG_O + (size_t)2 * T * D * 2;
constexpr size_t HG_QT  = HG_A + (size_t)32 * NCH * 64 * 64 * 2;
constexpr size_t HG_KT  = HG_QT + (size_t)32 * NCH * 64 * 128 * 2;
constexpr size_t HG_D   = HG_KT + (size_t)32 * NCH * 64 * 128 * 2;
constexpr size_t HG_VT  = HG_D + (size_t)32 * NCH * 128 * 4;
constexpr size_t HG_END = HG_VT + (size_t)16 * NCH * 256 * 64 * 2;
constexpr size_t AT_Q   = WS_MIX;
constexpr size_t AT_K   = AT_Q + (size_t)T * D * 2;
constexpr size_t AT_V   = AT_K + (size_t)T * 1024 * 2;
constexpr size_t AT_END = AT_V + (size_t)T * 1024 * 2;
constexpr size_t MB_Z   = WS_MIX;
constexpr size_t MB_XBC = MB_Z + (size_t)T * 8192 * 2;
constexpr size_t MB_DT  = MB_XBC + (size_t)T * 10240 * 2;
constexpr size_t MB_XS  = MB_DT + (size_t)T * 256 * 4;
constexpr size_t MB_BB  = MB_XS + (size_t)T * 8192 * 2;
constexpr size_t MB_CB  = MB_BB + (size_t)T * 1024 * 2;
constexpr size_t MB_DTV = MB_CB + (size_t)T * 1024 * 2;
constexpr size_t MB_Y   = MB_DTV + (size_t)2 * T * 128 * 4;
constexpr size_t MB_G   = MB_Y + (size_t)2 * T * 8192 * 2;
constexpr size_t MB_CP  = MB_G + (size_t)8 * NCH * 64 * 64 * 2;
constexpr size_t MB_BT  = MB_CP + (size_t)8 * NCH * 64 * 128 * 2;
constexpr size_t MB_XT  = MB_BT + (size_t)8 * NCH * 64 * 128 * 2;
constexpr size_t MB_GV  = MB_XT + (size_t)128 * NCH * 64 * 64 * 2;
constexpr size_t MB_DTC = MB_GV + (size_t)256 * NCH * 64 * 4;
constexpr size_t MB_END = MB_DTC + (size_t)256 * NCH * 64 * 4;
constexpr size_t WS_END = (MB_END > HG_END ? (MB_END > AT_END ? MB_END : AT_END) : (HG_END > AT_END ? HG_END : AT_END));

constexpr int LDS_MAIN = 131072, LDS_HALO = LDS_MAIN, LDS_XB = 162816, LDS_WMAP = LDS_XB + 256, LDS_BYTES = LDS_WMAP + 256;

__device__ __forceinline__ unsigned cvt_pk_bf16(float lo, float hi) { unsigned r; asm volatile("v_cvt_pk_bf16_f32 %0, %1, %2" : "=v"(r) : "v"(lo), "v"(hi)); return r; }
typedef __bf16 bf16v2_t __attribute__((ext_vector_type(2)));
__device__ __forceinline__ unsigned cvt_pk_bf16_n(float lo, float hi) { const bf16v2_t v = __builtin_convertvector((f32x2){lo, hi}, bf16v2_t); return __builtin_bit_cast(unsigned, v); }
__device__ __forceinline__ float bf_lo(unsigned w) { return __uint_as_float(w << 16); }
__device__ __forceinline__ float bf_hi(unsigned w) { return __uint_as_float(w & 0xffff0000u); }
__device__ __forceinline__ float bf1(bf16_t b) { return __uint_as_float(((unsigned)b) << 16); }
__device__ __forceinline__ bf16_t f2bf(float f) { return (bf16_t)(cvt_pk_bf16(f, 0.f) & 0xffffu); }
__device__ __forceinline__ bf16_t f2bf_n(float f) { return (bf16_t)(cvt_pk_bf16_n(f, 0.f) & 0xffffu); }
__device__ __forceinline__ float sigmoidf_(float x) { return 1.0f / (1.0f + __expf(-x)); }
__device__ __forceinline__ float siluf_(float x) { return x / (1.0f + __expf(-x)); }
template <int CTRL> __device__ __forceinline__ float dpp_mov(float v) { return __int_as_float(__builtin_amdgcn_update_dpp(0, __float_as_int(v), CTRL, 0xF, 0xF, false)); }
__device__ __forceinline__ float xch16(float v, int lane) { const auto r = __builtin_amdgcn_permlane16_swap(__float_as_uint(v), __float_as_uint(v), false, false); return __uint_as_float((lane & 16) ? r[0] : r[1]); }
__device__ __forceinline__ float xch32(float v, int lane) { const auto r = __builtin_amdgcn_permlane32_swap(__float_as_uint(v), __float_as_uint(v), false, false); return __uint_as_float((lane & 32) ? r[0] : r[1]); }
struct OpSum { __device__ __forceinline__ float operator()(float a, float b) const { return a + b; } };
struct OpMax { __device__ __forceinline__ float operator()(float a, float b) const { return fmaxf(a, b); } };
template <class Op> __device__ __forceinline__ float row16_all(float v, Op op) {
    v = op(v, dpp_mov<0xB1>(v)); v = op(v, dpp_mov<0x4E>(v)); v = op(v, dpp_mov<0x141>(v)); v = op(v, dpp_mov<0x140>(v));
    return v;
}
template <class Op> __device__ __forceinline__ float wave_all(float v, Op op) {
    v = row16_all(v, op);
    { const auto r = __builtin_amdgcn_permlane16_swap(__float_as_uint(v), __float_as_uint(v), false, false); v = op(__uint_as_float(r[0]), __uint_as_float(r[1])); }
    { const auto r = __builtin_amdgcn_permlane32_swap(__float_as_uint(v), __float_as_uint(v), false, false); v = op(__uint_as_float(r[0]), __uint_as_float(r[1])); }
    return v;
}
__device__ __forceinline__ float wave_sum(float v) { return wave_all(v, OpSum()); }
__device__ __forceinline__ float wave_max(float v) { return wave_all(v, OpMax()); }
__device__ __forceinline__ unsigned mk_hwslot() { return (unsigned)__builtin_amdgcn_s_getreg((5 << 11) | 4) & 63u; }
__device__ __forceinline__ int mk_tid() {
    extern __shared__ __attribute__((aligned(16))) unsigned char mk_lds_[];
    const int w = __builtin_amdgcn_readfirstlane(((const LAS int*)((LAS unsigned char*)mk_lds_ + LDS_WMAP))[mk_hwslot()]);
    int l; asm volatile("v_mbcnt_lo_u32_b32 %0, -1, 0\n\tv_mbcnt_hi_u32_b32 %0, -1, %0" : "=v"(l));
    return w * 64 + l;
}
__device__ __forceinline__ int mk_bid() { int b = blockIdx.x; asm volatile("" : "+v"(b)); return __builtin_amdgcn_readfirstlane(b); }
__device__ __forceinline__ void lds_barrier() { asm volatile("s_waitcnt lgkmcnt(0)\n\ts_barrier" ::: "memory"); }
__device__ __forceinline__ void ld8bf(const bf16_t* p, float (&o)[8]) { const u32x4 w = *(const u32x4*)p; o[0] = bf_lo(w.x); o[1] = bf_hi(w.x); o[2] = bf_lo(w.y); o[3] = bf_hi(w.y); o[4] = bf_lo(w.z); o[5] = bf_hi(w.z); o[6] = bf_lo(w.w); o[7] = bf_hi(w.w); }
__device__ __forceinline__ void st_bf16x8(bf16_t* p, f32x4 v0, f32x4 v1) {
    u32x4 w; w.x = cvt_pk_bf16(v0[0], v0[1]); w.y = cvt_pk_bf16(v0[2], v0[3]); w.z = cvt_pk_bf16(v1[0], v1[1]); w.w = cvt_pk_bf16(v1[2], v1[3]);
    *(u32x4*)p = w;
}
__device__ __forceinline__ void st_bf16x8_n(bf16_t* p, f32x4 v0, f32x4 v1) {
    u32x4 w; w.x = cvt_pk_bf16_n(v0[0], v0[1]); w.y = cvt_pk_bf16_n(v0[2], v0[3]); w.z = cvt_pk_bf16_n(v1[0], v1[1]); w.w = cvt_pk_bf16_n(v1[2], v1[3]);
    *(u32x4*)p = w;
}
#define XB_TMO      128
#define XB_XCNT(j)  (256  + 64 * (j))
#define XB_XSUB(j)  (1280 + 64 * (j))
#define XB_XGEN(j)  (2304 + 64 * (j))
#define XB_TOP      3328
#define XB_TOPGEN   3392
#define XCD_BAR_WORDS 3456
#define XB_SPIN_CAP (1u << 22)

__device__ __forceinline__ unsigned xb_ld(unsigned* p)              { return __hip_atomic_load(p, __ATOMIC_RELAXED, __HIP_MEMORY_SCOPE_AGENT); }
__device__ __forceinline__ unsigned xb_add(unsigned* p, unsigned v) { return __hip_atomic_fetch_add(p, v, __ATOMIC_RELAXED, __HIP_MEMORY_SCOPE_AGENT); }
__device__ __forceinline__ unsigned xb_xcc_id() { return (unsigned)__builtin_amdgcn_s_getreg((3 << 11) | 20) & 0xFu; }
#define XB_SPIN(cond, bar) do { unsigned _sp = 0; while (cond) { __builtin_amdgcn_s_sleep(1); \
    if ((++_sp & 255u) == 0u) { if (xb_ld(&(bar)[XB_TMO])) break; if (_sp > XB_SPIN_CAP) { atomicAdd(&(bar)[XB_TMO], 1u); break; } } } } while (0)

struct XcdBarrier {
    unsigned* bar; unsigned x;
    volatile LAS unsigned* st;
};

__device__ __forceinline__ XcdBarrier xcd_barrier_post(unsigned* bar, volatile LAS unsigned* st) {
    XcdBarrier b; b.bar = bar; b.x = xb_xcc_id(); b.st = st;
    if (mk_tid() == 0) (void)xb_add(&bar[XB_XCNT(b.x)], 1u);
    return b;
}
__device__ __forceinline__ void xcd_barrier_complete(unsigned* bar, unsigned x, unsigned& nloc, unsigned& nx) {
    const unsigned G = gridDim.x * gridDim.y * gridDim.z;
    unsigned sum, cnt, mine, sp = 0u;
    for (;;) {
        sum = 0u; cnt = 0u; mine = 0u;
#pragma unroll
        for (unsigned j = 0; j < 16; ++j) { const unsigned c = xb_ld(&bar[XB_XCNT(j)]); sum += c; cnt += (c > 0u) ? 1u : 0u; mine = (j == x) ? c : mine; }
        if (sum == G) break;
        __builtin_amdgcn_s_sleep(1);
        if ((++sp & 255u) == 0u) { if (xb_ld(&bar[XB_TMO])) break; if (sp > XB_SPIN_CAP) { atomicAdd(&bar[XB_TMO], 1u); break; } }
    }
    nloc = mine > 0u ? mine : 1u; nx = cnt > 0u ? cnt : 1u;
}

__device__ __forceinline__ void xcd_barrier(const XcdBarrier& b) {
    asm volatile("s_waitcnt vmcnt(0)" ::: "memory");
    __syncthreads();
    if (mk_tid() == 0) {
        unsigned* bar = b.bar;
        __builtin_amdgcn_s_waitcnt(0);
        unsigned nloc = b.st[0], nx = b.st[1];
        if (nloc == 0u) { xcd_barrier_complete(bar, b.x, nloc, nx); b.st[0] = nloc; b.st[1] = nx; }
        const unsigned old = xb_add(&bar[XB_XSUB(b.x)], 1u);
        const unsigned gen = old / nloc;
        if (old + 1u == (gen + 1u) * nloc) {
            __builtin_amdgcn_fence(__ATOMIC_RELEASE, "agent");
            asm volatile("s_waitcnt vmcnt(0)" ::: "memory");
            const unsigned og = xb_add(&bar[XB_TOP], 1u);
            const unsigned tg = og / nx;
            if (og + 1u == (tg + 1u) * nx) xb_add(&bar[XB_TOPGEN], 1u);
            else XB_SPIN(xb_ld(&bar[XB_TOPGEN]) == tg, bar);
            __builtin_amdgcn_fence(__ATOMIC_ACQUIRE, "agent");
            xb_add(&bar[XB_XGEN(b.x)], 1u);
            asm volatile("s_waitcnt vmcnt(0)" ::: "memory");
        } else {
            XB_SPIN(xb_ld(&bar[XB_XGEN(b.x)]) == gen, bar);
            __builtin_amdgcn_fence(__ATOMIC_ACQUIRE, "agent");
            asm volatile("s_waitcnt vmcnt(0)" ::: "memory");
        }
    }
    __syncthreads();
}
namespace pg8 {
#define PG8_LAS __attribute__((address_space(3)))
constexpr int BM = 256, BK = 64, HALF = 128, HTB = HALF * BK * 2  , STAGE_BYTES = 8 * HTB, NXCD = 8, WGM = 8;

__host__ __device__ __forceinline__ int lds_byte(int r, int c) { const int st = (r >> 4) * 2 + (c >> 5), rr = r & 15, cc = c & 31, ob = rr * 64 + cc * 2; return st * 1024 + (ob ^ (((ob >> 9) & 1) << 5)); }
__host__ __device__ __forceinline__ void stage_rc(int b, int& R, int& C) { const int st = b / 1024, sb = b % 1024, swz = sb ^ (((sb >> 9) & 1) << 5); R = (st >> 1) * 16 + swz / 64; C = (st & 1) * 32 + (swz % 64) / 2; }
__host__ __device__ __forceinline__ int perm32(int rho) { const int n = rho >> 4, i = rho & 15; return 8 * (i >> 2) + 4 * n + (i & 3); }
struct Unit { int pm, pn, k0, nt, sk; };
struct Gemm { const bf16_t* A; const bf16_t* Bt; int M, N, K; };
struct StaticOrder {
    int nM, nN, nwg, G, c, ntf;
    __host__ __device__ __forceinline__ void init(int M, int N, int K, int G_, int c_) { nM = M / BM; nN = N / BM; nwg = nM * nN; G = G_; c = c_; ntf = K / BK; }
    __host__ __device__ __forceinline__ Unit get(int i) const {
        Unit u; u.pm = -1; u.pn = 0; u.k0 = 0; u.nt = ntf; u.sk = -1;
        const long L = (long)i * G + c; if (L >= nwg) return u;
        int wgid = (int)L; { const int q = nwg / NXCD, r = nwg % NXCD, xcd = wgid % NXCD, off = wgid / NXCD; wgid = (xcd < r ? xcd * (q + 1) : r * (q + 1) + (xcd - r) * q) + off; }
        const int nig = WGM * nN, gid = wgid / nig, fm = gid * WGM, gsz = (nM - fm) < WGM ? (nM - fm) : WGM;
        u.pm = fm + ((wgid % nig) % gsz); u.pn = (wgid % nig) / gsz; return u;
    }
    __device__ __forceinline__ void a_ready(const Unit&) const {}
    __device__ __forceinline__ void done(const Unit&) const {}
};
struct TailOrder {
    StaticOrder so; int U0, SK, nsplit;
    __host__ __device__ static constexpr int pick_sk(int nN, int ntf) { int sk = 1; while (sk * 2 <= SKMAX && sk * 2 * nN <= 256 && ntf / (sk * 2) >= 4) sk *= 2; return sk; }
    __host__ __device__ __forceinline__ void init(int Mlat, int N, int K, int G_, int c_, bool has_ctx) { so.init(Mlat, N, K, G_, c_); U0 = so.nwg; SK = pick_sk(so.nN, so.ntf); nsplit = has_ctx ? so.nN * SK : 0; }
    __host__ __device__ __forceinline__ Unit get(int i) const {
        const long L = (long)i * so.G + so.c;
        if (L < U0) return so.get(i);
        Unit u; const int s = (int)(L - U0); const bool ok = s < nsplit;
        u.pm = ok ? so.nM : -1; u.pn = s % so.nN; u.sk = s / so.nN; u.nt = so.ntf / SK; u.k0 = u.sk * u.nt; return u;
    }
    __device__ __forceinline__ void a_ready(const Unit&) const {}
    __device__ __forceinline__ void done(const Unit&) const {}
};
template <class Epi, class Sched>
__device__ __forceinline__ void gemm_phase(PG8_LAS unsigned char* lds, const Gemm g, const Sched& S, const Epi& E) {
    const int tid = mk_tid(), wid = __builtin_amdgcn_readfirstlane(tid >> 6), lane = tid & 63, wr = wid >> 2, wc = wid & 3, fr = lane & 15, fq = lane >> 4;
    const int K = g.K;
    unsigned voffA[2], voffB[2];
#pragma unroll
    for (int i = 0; i < 2; ++i) { int R, C; stage_rc(tid * 16 + i * 8192, R, C); const int Rb = Epi::PERM ? ((R & ~31) + perm32(R & 31)) : R;
        voffA[i] = (unsigned)(R * K + C) * 2u; voffB[i] = (unsigned)(Rb * K + C) * 2u; }
    const size_t kstep = (size_t)(BK * 2);
    const size_t hstep = (size_t)HALF * K * 2;
    const size_t tstep = 2 * hstep;
    const unsigned ldsw = (unsigned)wid * 1024u;
    const int aoff = lds_byte(wr * 64 + fr, fq * 8), boff = lds_byte(wc * 32 + fr, fq * 8);
#define PG8_SA(b, h) (((b) * 2 + (h)) * HTB)
#define PG8_SB(b, h) ((4 + (b) * 2 + (h)) * HTB)
#define PG8_STAGE(bufoff, gbase, voff) do { _Pragma("unroll") for (int _i = 0; _i < 2; ++_i) \
        __builtin_amdgcn_global_load_lds((const unsigned*)((const char*)(gbase) + (voff)[_i]), (PG8_LAS unsigned*)(lds + (bufoff) + ldsw + _i * 8192), 16, 0, 0); } while (0)
#define PG8_LDA(dst, b, h) do { _Pragma("unroll") for (int m = 0; m < 4; ++m) _Pragma("unroll") for (int k = 0; k < 2; ++k) dst[m][k] = *(const PG8_LAS bf16x8*)(lds + PG8_SA(b, h) + aoff + m * 2048 + k * 1024); } while (0)
#define PG8_LDB(dst, b, h) do { _Pragma("unroll") for (int n = 0; n < 2; ++n) _Pragma("unroll") for (int k = 0; k < 2; ++k) dst[n][k] = *(const PG8_LAS bf16x8*)(lds + PG8_SB(b, h) + boff + n * 2048 + k * 1024); } while (0)
#define PG8_MMA(ai, bj, At, Bt) do { __builtin_amdgcn_s_setprio(1); _Pragma("unroll") for (int m = 0; m < 4; ++m) _Pragma("unroll") for (int n = 0; n < 2; ++n) _Pragma("unroll") for (int k = 0; k < 2; ++k) \
        acc[ai][bj][m][n] = __builtin_amdgcn_mfma_f32_16x16x32_bf16(Bt[n][k], At[m][k], acc[ai][bj][m][n], 0, 0, 0); __builtin_amdgcn_s_setprio(0); } while (0)
#define PG8_WAIT_V(n) asm volatile("s_waitcnt vmcnt(" #n ")" ::: "memory")
#define PG8_WAIT_L(n) asm volatile("s_waitcnt lgkmcnt(" #n ")" ::: "memory")
#define PG8_BAR __builtin_amdgcn_s_barrier()
#define PG8_SCHED __builtin_amdgcn_sched_barrier(0)
    Unit cur, nxt; int ui = 0;
    cur = S.get(0); if (cur.pm < 0) return;
    f32x4 acc[2][2][4][2];
#pragma unroll
    for (int a = 0; a < 2; ++a)
#pragma unroll
        for (int b = 0; b < 2; ++b)
#pragma unroll
            for (int m = 0; m < 4; ++m)
#pragma unroll
                for (int n = 0; n < 2; ++n) acc[a][b][m][n] = (f32x4){0.f, 0.f, 0.f, 0.f};
    bf16x8 At[4][2], B0[2][2], B1[2][2];
    const char* cA = (const char*)g.A + (size_t)cur.pm * tstep + (size_t)cur.k0 * kstep; const char* cB = (const char*)g.Bt + (size_t)cur.pn * tstep + (size_t)cur.k0 * kstep;
    S.a_ready(cur);
    PG8_STAGE(PG8_SB(0, 0), cB, voffB); PG8_STAGE(PG8_SA(0, 0), cA, voffA); PG8_STAGE(PG8_SB(0, 1), cB + hstep, voffB); PG8_STAGE(PG8_SA(0, 1), cA + hstep, voffA);
    if (wr == 1) PG8_BAR;
    PG8_WAIT_V(4); PG8_BAR;
    PG8_STAGE(PG8_SB(1, 0), cB + kstep, voffB); PG8_STAGE(PG8_SA(1, 0), cA + kstep, voffA); PG8_STAGE(PG8_SB(1, 1), cB + hstep + kstep, voffB);
    PG8_WAIT_V(6); PG8_BAR;
    for (;;) {
        nxt = S.get(ui + 1); const bool has_next = nxt.pm >= 0;
        const char* nA = has_next ? (const char*)g.A + (size_t)nxt.pm * tstep + (size_t)nxt.k0 * kstep : cA; const char* nB = has_next ? (const char*)g.Bt + (size_t)nxt.pn * tstep + (size_t)nxt.k0 * kstep : cB;
        const int nt = cur.nt;
        for (int t = 0; t < nt; t += 2) {
            const bool last = (t == nt - 2);
            const char* a1 = cA + (size_t)(t + 1) * kstep;
            const char* a2 = last ? nA : cA + (size_t)(t + 2) * kstep; const char* b2 = last ? nB : cB + (size_t)(t + 2) * kstep;
            const char* a3 = a2 + kstep; const char* b3 = b2 + kstep;
            if (last && has_next) S.a_ready(nxt);
            PG8_LDB(B0, 0, 0); PG8_SCHED; PG8_LDA(At, 0, 0); PG8_STAGE(PG8_SA(1, 1), a1 + hstep, voffA);
            PG8_WAIT_L(8); PG8_BAR; PG8_WAIT_L(0); PG8_MMA(0, 0, At, B0); PG8_BAR; PG8_SCHED;
            PG8_LDB(B1, 0, 1); PG8_STAGE(PG8_SB(0, 0), b2, voffB);
            PG8_BAR; PG8_WAIT_L(0); PG8_MMA(0, 1, At, B1); PG8_BAR;
            PG8_LDA(At, 0, 1); PG8_STAGE(PG8_SA(0, 0), a2, voffA);
            PG8_BAR; PG8_WAIT_L(0); PG8_MMA(1, 0, At, B0); PG8_BAR; PG8_SCHED;
            PG8_STAGE(PG8_SB(0, 1), b2 + hstep, voffB);
            PG8_WAIT_V(6); PG8_BAR; PG8_MMA(1, 1, At, B1); PG8_BAR;
            PG8_LDB(B0, 1, 0); PG8_SCHED; PG8_LDA(At, 1, 0); PG8_STAGE(PG8_SA(0, 1), a2 + hstep, voffA);
            PG8_WAIT_L(8); PG8_BAR; PG8_WAIT_L(0); PG8_MMA(0, 0, At, B0); PG8_BAR; PG8_SCHED;
            PG8_LDB(B1, 1, 1); PG8_STAGE(PG8_SB(1, 0), b3, voffB);
            PG8_BAR; PG8_WAIT_L(0); PG8_MMA(0, 1, At, B1); PG8_BAR;
            PG8_LDA(At, 1, 1); PG8_STAGE(PG8_SA(1, 0), a3, voffA);
            PG8_BAR; PG8_WAIT_L(0); PG8_MMA(1, 0, At, B0); PG8_BAR; PG8_SCHED;
            PG8_STAGE(PG8_SB(1, 1), b3 + hstep, voffB);
            PG8_WAIT_V(6); PG8_BAR; PG8_MMA(1, 1, At, B1); PG8_BAR;
        }
            if constexpr (!Epi::AFTER_DRAIN) { E(acc, cur, wr, wc, fr, fq); S.done(cur); }
            if (!has_next) break;
#pragma unroll
        for (int a = 0; a < 2; ++a)
#pragma unroll
            for (int b = 0; b < 2; ++b)
#pragma unroll
                for (int m = 0; m < 4; ++m)
#pragma unroll
                    for (int n = 0; n < 2; ++n) acc[a][b][m][n] = (f32x4){0.f, 0.f, 0.f, 0.f};
        cur = nxt; cA = nA; cB = nB; ++ui;
    }
    PG8_WAIT_V(0);
    if (wr == 0) PG8_BAR;
    PG8_BAR;
    if constexpr (Epi::AFTER_DRAIN) { E.fused(acc, cur, wr, wc, fr, fq, lds, wid, lane); S.done(cur); }
#undef PG8_SA
#undef PG8_SB
#undef PG8_STAGE
#undef PG8_LDA
#undef PG8_LDB
#undef PG8_MMA
#undef PG8_WAIT_V
#undef PG8_WAIT_L
#undef PG8_BAR
#undef PG8_SCHED
}
}
namespace att {
using bf16 = bf16_t;
constexpr int   D = 128, NW = 8, QBLK = 32, KVBLK = 64;
constexpr float SCALE = 0.088388347648318440f;
constexpr float THR = 8.f;
constexpr int SDEPTH = 2;
constexpr int LDQ = 4096, LDK = 1024, LDO = 4096;
constexpr size_t SHM_V = KVBLK * D * 2, SHM_K = KVBLK * D * 2, SHM_ATTN = 2 * SHM_V + 2 * SHM_K + NW * 64 * 4;
#define KSWZ(row, colB) ((row) * 256 + ((colB) ^ (((row) & 7) << 4)))
#define SBAR() __builtin_amdgcn_sched_barrier(0)
__device__ __forceinline__ int crow(int r, int hi) { return (r & 3) + 8 * (r >> 2) + 4 * hi; }
__device__ __forceinline__ unsigned cvtpk(float lo, float hi) {
  unsigned r; asm volatile("v_cvt_pk_bf16_f32 %0, %1, %2" : "=v"(r) : "v"(lo), "v"(hi)); return r;
}
template <typename TIn> struct Stage;
template <> struct Stage<bf16>  { using T = bf16x8;
  __device__ static __forceinline__ T ld8(const bf16* p) { return *reinterpret_cast<const bf16x8*>(p); }
  __device__ static __forceinline__ bf16x8 tobf(T x) { return x; } };
template <> struct Stage<float> { using T = f32x8;
  __device__ static __forceinline__ T ld8(const float* p) { return *reinterpret_cast<const f32x8*>(p); }
  __device__ static __forceinline__ bf16x8 tobf(T x) {
    u32x4 w = {cvtpk(x[0], x[1]), cvtpk(x[2], x[3]), cvtpk(x[4], x[5]), cvtpk(x[6], x[7])}; return *reinterpret_cast<bf16x8*>(&w); } };

__device__ __forceinline__ void partialSM(f32x16& p0, f32x16& p1, float& m_reg, float& mn, float& alpha) {
  constexpr float C = SCALE * 1.4426950408889634f;
  float pmax = p0[0]; for (int r = 1; r < 16; ++r) pmax = fmaxf(pmax, p0[r]); for (int r = 0; r < 16; ++r) pmax = fmaxf(pmax, p1[r]);
  { auto rr = __builtin_amdgcn_permlane32_swap(__float_as_uint(pmax), __float_as_uint(pmax), false, false);
    pmax = fmaxf(__uint_as_float(rr[0]), __uint_as_float(rr[1])); }
  if (__builtin_expect(__all(pmax - m_reg <= THR / SCALE), 1)) { mn = m_reg; alpha = 1.f; }
  else { mn = fmaxf(m_reg, pmax); alpha = __builtin_amdgcn_exp2f((m_reg - mn) * C); m_reg = mn; }
  float mnC = -mn * C;
  for (int r = 0; r < 16; ++r) p0[r] = fmaf(p0[r], C, mnC); for (int r = 0; r < 16; ++r) p1[r] = fmaf(p1[r], C, mnC);
  for (int r = 0; r < 16; ++r) p0[r] = __builtin_amdgcn_exp2f(p0[r]);
}
__device__ __forceinline__ void finishSM(f32x16& p0, f32x16& p1, float alpha, float& l_reg, bf16x8& pa0, bf16x8& pa1, bf16x8& pa2, bf16x8& pa3) {
  for (int r = 0; r < 16; ++r) p1[r] = __builtin_amdgcn_exp2f(p1[r]);
  float ps = 0; for (int r = 0; r < 16; ++r) ps += p0[r]; for (int r = 0; r < 16; ++r) ps += p1[r];
  { auto rr = __builtin_amdgcn_permlane32_swap(__float_as_uint(ps), __float_as_uint(ps), false, false);
    ps = __uint_as_float(rr[0]) + __uint_as_float(rr[1]); }
  l_reg = l_reg * alpha + ps;
#define PK4(P, BASE, OUT) do { unsigned a0 = cvtpk(P[BASE + 0], P[BASE + 1]), a1 = cvtpk(P[BASE + 2], P[BASE + 3]);   \
    unsigned b0 = cvtpk(P[BASE + 4], P[BASE + 5]), b1 = cvtpk(P[BASE + 6], P[BASE + 7]);                              \
    auto r0 = __builtin_amdgcn_permlane32_swap(a0, b0, false, false); auto r1 = __builtin_amdgcn_permlane32_swap(a1, b1, false, false); \
    u32x4 w = {r0[0], r1[0], r0[1], r1[1]}; OUT = *reinterpret_cast<bf16x8*>(&w); } while (0)
  PK4(p0, 0, pa0); PK4(p0, 8, pa1); PK4(p1, 0, pa2); PK4(p1, 8, pa3);
#undef PK4
}
__device__ __forceinline__ void qkt(f32x16& p0, f32x16& p1, const bf16* Ks, const bf16x8* qr, int r32, int hi) {
  p0 = f32x16{}; p1 = f32x16{};
  for (int d0 = 0; d0 < 8; ++d0) { int cb = (d0 * 16 + hi * 8) * 2;
    bf16x8 b0 = *reinterpret_cast<const bf16x8*>((const char*)Ks + KSWZ(r32, cb));
    bf16x8 b1 = *reinterpret_cast<const bf16x8*>((const char*)Ks + KSWZ(32 + r32, cb));
    p0 = __builtin_amdgcn_mfma_f32_32x32x16_bf16(b0, qr[d0], p0, 0, 0, 0);
    p1 = __builtin_amdgcn_mfma_f32_32x32x16_bf16(b1, qr[d0], p1, 0, 0, 0); }
}
__device__ __forceinline__ int v_st(int k, int c) { const int kk = (k & ~0xC) | ((k & 4) << 1) | ((k & 8) >> 1); return ((kk >> 3) * 4 + (c >> 5)) * 512 + ((kk & 7) * 32 + (c & 31)) * 2; }
__device__ __forceinline__ int v_rd_base(int lane) { return ((lane & 3) << 3) | (((lane >> 2) & 3) << 6) | (((lane >> 4) & 1) << 5) | (((lane >> 5) & 1) << 8); }
constexpr int v_rd_off(int d0, int ks, int half) { return d0 * 512 + ks * 4096 + half * 2048; }
template <int OFF> __device__ __forceinline__ s16x4 tr_read(int vb) {
  s16x4 r; asm volatile("ds_read_b64_tr_b16 %0, %1 offset:%2" : "=&v"(r) : "v"(vb), "i"(OFF) : "memory"); return r;
}
template <int D0> __device__ __forceinline__ void pv_one(f32x16& od, int vb, bf16x8 pa0, bf16x8 pa1, bf16x8 pa2, bf16x8 pa3) {
  const s16x4 l0 = tr_read<v_rd_off(D0, 0, 0)>(vb), h0 = tr_read<v_rd_off(D0, 0, 1)>(vb), l1 = tr_read<v_rd_off(D0, 1, 0)>(vb), h1 = tr_read<v_rd_off(D0, 1, 1)>(vb);
  const s16x4 l2 = tr_read<v_rd_off(D0, 2, 0)>(vb), h2 = tr_read<v_rd_off(D0, 2, 1)>(vb), l3 = tr_read<v_rd_off(D0, 3, 0)>(vb), h3 = tr_read<v_rd_off(D0, 3, 1)>(vb);
  asm volatile("s_waitcnt lgkmcnt(0)" ::: "memory"); SBAR();
#define PK(L, H) (bf16x8){L[0], L[1], L[2], L[3], H[0], H[1], H[2], H[3]}
  od = __builtin_amdgcn_mfma_f32_32x32x16_bf16(pa0, PK(l0, h0), od, 0, 0, 0);
  od = __builtin_amdgcn_mfma_f32_32x32x16_bf16(pa1, PK(l1, h1), od, 0, 0, 0);
  od = __builtin_amdgcn_mfma_f32_32x32x16_bf16(pa2, PK(l2, h2), od, 0, 0, 0);
  od = __builtin_amdgcn_mfma_f32_32x32x16_bf16(pa3, PK(l3, h3), od, 0, 0, 0);
#undef PK
}
__device__ __forceinline__ void pv_d0(f32x16* o, int vb, bf16x8 pa0, bf16x8 pa1, bf16x8 pa2, bf16x8 pa3) {
  pv_one<0>(o[0], vb, pa0, pa1, pa2, pa3); pv_one<1>(o[1], vb, pa0, pa1, pa2, pa3); pv_one<2>(o[2], vb, pa0, pa1, pa2, pa3); pv_one<3>(o[3], vb, pa0, pa1, pa2, pa3);
}

template <typename TQ>
__device__ __forceinline__ void attn_dense_body(const TQ* __restrict__ Qb, const bf16* __restrict__ Kh, const bf16* __restrict__ Vh,
                                                bf16* __restrict__ Ob, int seq, char* lds) {
  using St = Stage<bf16>; using SQ = Stage<TQ>;
  const int tid = mk_tid(), wid = tid >> 6, lane = tid & 63, r32 = lane & 31, hi = lane >> 5;
  bf16* V_lds = (bf16*)lds; bf16* K_lds = (bf16*)(lds + 2 * SHM_V);
  float* ws = (float*)(lds + 2 * SHM_V + 2 * SHM_K) + wid * 64; float* li_l = ws; float* al_l = ws + 32;
  float m_reg = -1e30f, l_reg = 0; f32x16 o[4] = {}; bf16x8 qr[8];
  const TQ* Qw = Qb + (long)(wid * QBLK + r32) * LDQ + hi * 8;
#pragma unroll
  for (int d0 = 0; d0 < 8; ++d0) qr[d0] = SQ::tobf(SQ::ld8(Qw + d0 * 16));
  const int sr = tid >> 4, sc = (tid & 15) * 8, vst0 = v_st(sr, sc), vst1 = v_st(32 + sr, sc);
  const int vb0 = (int)(uintptr_t)V_lds + v_rd_base(lane);
  struct { typename St::T vs0, vs1, ks0, ks1; } sr_[SDEPTH];
#define SLOAD(i, k0) do { sr_[i].vs0 = St::ld8(&Vh[(long)((k0) + sr) * LDK + sc]); sr_[i].vs1 = St::ld8(&Vh[(long)((k0) + 32 + sr) * LDK + sc]); \
    sr_[i].ks0 = St::ld8(&Kh[(long)((k0) + sr) * LDK + sc]); sr_[i].ks1 = St::ld8(&Kh[(long)((k0) + 32 + sr) * LDK + sc]); } while (0)
#define SWRITE(b, i) do { *(bf16x8*)((char*)V_lds + (b) * SHM_V + vst0) = St::tobf(sr_[i].vs0);          \
    *(bf16x8*)((char*)V_lds + (b) * SHM_V + vst1) = St::tobf(sr_[i].vs1); int kc = sc * 2;               \
    *(bf16x8*)((char*)K_lds + (b) * SHM_K + KSWZ(sr, kc)) = St::tobf(sr_[i].ks0);                       \
    *(bf16x8*)((char*)K_lds + (b) * SHM_K + KSWZ(32 + sr, kc)) = St::tobf(sr_[i].ks1); } while (0)
#define SWAIT() do { if constexpr (SDEPTH == 2) asm volatile("s_waitcnt vmcnt(4)" ::: "memory"); else asm volatile("s_waitcnt vmcnt(0)" ::: "memory"); } while (0)
#define RESC(a) do { if (__any((a) < 1.f)) { if (hi == 0) al_l[r32] = (a); asm volatile("s_waitcnt lgkmcnt(0)" ::: "memory"); \
    for (int d = 0; d < 4; ++d) for (int r = 0; r < 16; ++r) o[d][r] *= al_l[crow(r, hi)]; } } while (0)
  f32x16 pA0, pA1, pB0, pB1; float mnA, mnB, alA, alB; bf16x8 pa0, pa1, pa2, pa3; const int NT = seq / KVBLK;
  constexpr int SE = 0, SO = SDEPTH - 1;
  SLOAD(SE, 0); asm volatile("s_waitcnt vmcnt(0)" ::: "memory"); SWRITE(0, SE); __syncthreads();
  qkt(pA0, pA1, K_lds, qr, r32, hi); partialSM(pA0, pA1, m_reg, mnA, alA);
  SLOAD(SO, KVBLK); if constexpr (SDEPTH == 2) { if (2 < NT) SLOAD(SE, 2 * KVBLK); }
  SWAIT(); SWRITE(1, SO); __syncthreads();
  for (int j = 1; j + 1 < NT; j += 2) {
    SBAR(); qkt(pB0, pB1, (bf16*)((char*)K_lds + SHM_K), qr, r32, hi);
    finishSM(pA0, pA1, alA, l_reg, pa0, pa1, pa2, pa3); SBAR();
    SLOAD(SO, (j + SDEPTH) * KVBLK); SBAR();
    pv_d0(o, vb0, pa0, pa1, pa2, pa3); partialSM(pB0, pB1, m_reg, mnB, alB);
    __syncthreads(); SWAIT(); SWRITE(0, SE);
    RESC(alB); __syncthreads();
    SBAR(); qkt(pA0, pA1, K_lds, qr, r32, hi);
    finishSM(pB0, pB1, alB, l_reg, pa0, pa1, pa2, pa3); SBAR();
    if (SDEPTH == 1 || j + 3 < NT) SLOAD(SE, (j + 1 + SDEPTH) * KVBLK); SBAR();
    pv_d0(o, vb0 + (int)SHM_V, pa0, pa1, pa2, pa3); partialSM(pA0, pA1, m_reg, mnA, alA);
    __syncthreads(); SWAIT(); SWRITE(1, SO);
    RESC(alA); __syncthreads();
  }
  SBAR(); qkt(pB0, pB1, (bf16*)((char*)K_lds + SHM_K), qr, r32, hi);
  finishSM(pA0, pA1, alA, l_reg, pa0, pa1, pa2, pa3); SBAR();
  pv_d0(o, vb0, pa0, pa1, pa2, pa3); partialSM(pB0, pB1, m_reg, mnB, alB);
  __syncthreads(); RESC(alB);
  finishSM(pB0, pB1, alB, l_reg, pa0, pa1, pa2, pa3); SBAR();
  pv_d0(o, vb0 + (int)SHM_V, pa0, pa1, pa2, pa3);
  if (hi == 0) li_l[r32] = l_reg; asm volatile("s_waitcnt lgkmcnt(0)" ::: "memory");
  float rli[16];
#pragma unroll
  for (int r = 0; r < 16; ++r) rli[r] = __builtin_amdgcn_rcpf(li_l[crow(r, hi)]);
  bf16* Ow = Ob + (long)(wid * QBLK) * LDO;
  __syncthreads();
  bf16* Ot = (bf16*)(lds + wid * 8192);
#pragma unroll
  for (int r = 0; r < 16; ++r) { int orow = crow(r, hi);
    for (int d0 = 0; d0 < 4; ++d0) Ot[orow * 128 + d0 * 32 + r32] = f2bf(o[d0][r] * rli[r]); }
  asm volatile("s_waitcnt lgkmcnt(0)" ::: "memory");
#pragma unroll
  for (int k = 0; k < 8; ++k) { const int pi = k * 64 + lane, orow = pi >> 4, c16 = pi & 15;
    *reinterpret_cast<u32x4*>(Ow + (long)orow * LDO + c16 * 8) = *reinterpret_cast<const u32x4*>(Ot + orow * 128 + c16 * 8); }
#undef SLOAD
#undef SWRITE
#undef SWAIT
#undef RESC
}
}
struct Params { const float* in[29]; float* out; unsigned char* ws; int ph_lo, ph_hi; };
typedef const __attribute__((address_space(4))) Params* PP;
__device__ __forceinline__ PP launder(PP p) {
    const unsigned long long v = (unsigned long long)p; unsigned lo = (unsigned)v, hi = (unsigned)(v >> 32);
    asm volatile("" : "+s"(lo), "+s"(hi));
    return (PP)(((unsigned long long)hi << 32) | lo);
}
enum { I_X = 0, I_C, I_CTX, I_CCTX, I_MODW, I_MODB, I_LNG, I_LNB, I_HGWIN, I_HGWOUT, I_HGLB, I_HGNORM, I_ATWQKV, I_ATWOUT, I_ATQN, I_ATKN,
       I_SSMWIN, I_SSMCW, I_SSMCB, I_SSMDTB, I_SSMALOG, I_SSMD, I_SSMNORM, I_SSMWOUT, I_FFNWG, I_FFNWU, I_FFNCW, I_FFNCB, I_FFNWD };

template <class TT> __device__ __forceinline__ TT* wsp(PP p, size_t off) { return (TT*)(p->ws + off); }
__device__ __forceinline__ const float* modv(PP p, int l, int s, int part) { return wsp<const float>(p, WS_MODV) + ((size_t)(l * 2 + s) * MODN + (size_t)part * D); }
__device__ __forceinline__ const float* xin_row(PP p, int r) { return r < TL ? p->in[I_X] + (size_t)r * D : p->in[I_CTX] + (size_t)(r - TL) * D; }

template <class F> struct EpiFn {
    static constexpr bool PERM = true, AFTER_DRAIN = false;
    F f; bf16_t* part; int N;
    template <int KD> __device__ __forceinline__ void tile(const f32x4 (&acc)[2][2][4][2], const pg8::Unit& u, int wr, int wc, int fr, int fq) const {
        const int row0 = u.pm * 256 + wr * 64 + fr;
#pragma unroll
        for (int bj = 0; bj < 2; ++bj) {
            const int col = u.pn * 256 + bj * 128 + wc * 32 + 8 * fq;
#pragma unroll
            for (int ai = 0; ai < 2; ++ai)
#pragma unroll
                for (int m = 0; m < 4; ++m) f.template store<KD>(row0 + ai * 128 + m * 16, col, acc[ai][bj][m][0], acc[ai][bj][m][1]);
        }
    }
    __device__ __forceinline__ void operator()(const f32x4 (&acc)[2][2][4][2], const pg8::Unit& u, int wr, int wc, int fr, int fq) const {
        if (u.sk >= 0) {
            const int rl0 = wr * 64 + fr;
#pragma unroll
            for (int bj = 0; bj < 2; ++bj) {
                const int col = u.pn * 256 + bj * 128 + wc * 32 + 8 * fq;
#pragma unroll
                for (int ai = 0; ai < 2; ++ai)
#pragma unroll
                    for (int m = 0; m < 4; ++m) st_bf16x8_n(part + ((size_t)(u.sk * 256 + rl0 + ai * 128 + m * 16)) * N + col, acc[ai][bj][m][0], acc[ai][bj][m][1]);
            }
            return;
        }
        const int kd = f.kind(u.pn * 256);
        if (F::NK == 1 || kd == 0) tile<0>(acc, u, wr, wc, fr, fq);
        else if (F::NK == 2 || kd == 1) tile<1>(acc, u, wr, wc, fr, fq);
        else if (F::NK == 3 || kd == 2) tile<2>(acc, u, wr, wc, fr, fq);
        else tile<3>(acc, u, wr, wc, fr, fq);
    }
};
struct FBf16 { bf16_t* O; int ld;
    static constexpr int NK = 1;
    __device__ __forceinline__ int kind(int) const { return 0; }
    template <int KD> __device__ __forceinline__ void store(int row, int col, f32x4 v0, f32x4 v1) const { st_bf16x8(O + (size_t)row * ld + col, v0, v1); } };
struct FHgIn { bf16_t* q; float* lf; bf16_t* k; bf16_t* v; bf16_t* sg; const float* lb;
    static constexpr int NK = 4;
    __device__ __forceinline__ int kind(int col0) const { return col0 < 2048 ? 0 : col0 < 6144 ? 1 : col0 < 10240 ? 2 : 3; }
    template <int KD> __device__ __forceinline__ void store(int row, int col, f32x4 v0, f32x4 v1) const {
        if (KD == 0) {
            f32x4 a, b;
#pragma unroll
            for (int i = 0; i < 4; ++i) { a[i] = siluf_(v0[i]) * 0.08838834764831845f; b[i] = siluf_(v1[i]) * 0.08838834764831845f; }
            st_bf16x8(q + (size_t)row * 2048 + col, a, b);
        } else if (KD == 1) {
            const int cc = col - 2048, d = cc >> 11, c = cc & 2047;
            const float* lp = lb + d * 4096 + c;
            f32x4 fa, fb, ka, kb;
#pragma unroll
            for (int i = 0; i < 8; ++i) {
                const float z = i < 4 ? v0[i & 3] : v1[i & 3];
                const float lbv = lp[i], la = lp[8192 + i], l1 = lp[16384 + i];
                const float e = __expf(-fabsf(z)), r1 = 1.0f / (1.0f + e);
                const float ls = fminf(z, 0.f) - __logf(1.0f + e);
                const float bb = l1 + ls, mx = fmaxf(la, bb);
                const float lfv = mx + __logf(1.0f + __expf(-fabsf(la - bb)));
                const float kv = (1.0f - lbv) * (z >= 0.f ? e * r1 : r1);
                if (i < 4) { fa[i & 3] = lfv; ka[i & 3] = kv; } else { fb[i & 3] = lfv; kb[i & 3] = kv; }
            }
            const size_t o = ((size_t)d * T + row) * 2048 + c;
            *(f32x4*)(lf + o) = fa; *(f32x4*)(lf + o + 4) = fb; st_bf16x8(k + o, ka, kb);
        } else if (KD == 2) {
            st_bf16x8(v + (size_t)row * 4096 + (col - 6144), v0, v1);
        } else {
            f32x4 a, b;
#pragma unroll
            for (int i = 0; i < 4; ++i) { a[i] = siluf_(v0[i]); b[i] = siluf_(v1[i]); }
            st_bf16x8(sg + (size_t)row * 4096 + (col - 10240), a, b);
        }
    } };
struct FAtIn { bf16_t* q; bf16_t* k; bf16_t* v;
    static constexpr int NK = 3;
    __device__ __forceinline__ int kind(int col0) const { return col0 < 4096 ? 0 : col0 < 5120 ? 1 : 2; }
    template <int KD> __device__ __forceinline__ void store(int row, int col, f32x4 v0, f32x4 v1) const {
        if (KD == 0) st_bf16x8(q + (size_t)row * 4096 + col, v0, v1);
        else if (KD == 1) st_bf16x8(k + (size_t)row * 1024 + (col - 4096), v0, v1);
        else st_bf16x8(v + (size_t)row * 1024 + (col - 5120), v0, v1);
    } };
struct FMbIn { bf16_t* z; bf16_t* xbc; float* dt;
    static constexpr int NK = 3;
    __device__ __forceinline__ int kind(int col0) const { return col0 < 8192 ? 0 : col0 < 18432 ? 1 : 2; }
    template <int KD> __device__ __forceinline__ void store(int row, int col, f32x4 v0, f32x4 v1) const {
        if (KD == 0) st_bf16x8(z + (size_t)row * 8192 + col, v0, v1);
        else if (KD == 1) st_bf16x8(xbc + (size_t)row * 10240 + (col - 8192), v0, v1);
        else { float* o = dt + (size_t)row * 256 + (col - 18432); *(f32x4*)o = v0; *(f32x4*)(o + 4) = v1; }
    } };

template <class F> __device__ __forceinline__ void run_gemm(PP p, LAS unsigned char* lds, const bf16_t* A, const bf16_t* Bt, int M, int N, int K, const F& f) {
    pg8::Gemm g{A, Bt, M, N, K}; pg8::TailOrder S; S.init(TL, N, K, (int)gridDim.x, (int)mk_bid(), M > TL);
    EpiFn<F> E{f, wsp<bf16_t>(p, WS_PART), N};
    pg8::gemm_phase<EpiFn<F>, pg8::TailOrder>(lds, g, S, E);
}
template <class F> __device__ __forceinline__ void run_ctx_reduce(PP p, int N, int K, const F& f) {
    const int tid = mk_tid(), G = gridDim.x, SK = pg8::TailOrder::pick_sk(N / 256, K / 64), ng = N / 8;
    const bf16_t* part = wsp<const bf16_t>(p, WS_PART);
    for (int idx = mk_bid() * NT + tid; idx < 256 * ng; idx += G * NT) {
        const int row = idx / ng, col = (idx % ng) * 8;
        f32x4 v0 = {0.f, 0.f, 0.f, 0.f}, v1 = {0.f, 0.f, 0.f, 0.f};
        for (int s0 = 0; s0 < SK; s0 += 8) {
            u32x4 raw[8];
#pragma unroll
            for (int i = 0; i < 8; ++i) { const int s = s0 + i < SK ? s0 + i : SK - 1; raw[i] = *(const u32x4*)(part + ((size_t)(s * 256 + row)) * N + col); }
#pragma unroll
            for (int i = 0; i < 8; ++i) if (s0 + i < SK) {
                v0 += (f32x4){bf_lo(raw[i].x), bf_hi(raw[i].x), bf_lo(raw[i].y), bf_hi(raw[i].y)}; v1 += (f32x4){bf_lo(raw[i].z), bf_hi(raw[i].z), bf_lo(raw[i].w), bf_hi(raw[i].w)};
            }
        }
        const int kd = f.kind(col & ~255);
        if (F::NK == 1 || kd == 0) f.template store<0>(TL + row, col, v0, v1);
        else if (F::NK == 2 || kd == 1) f.template store<1>(TL + row, col, v0, v1);
        else if (F::NK == 3 || kd == 2) f.template store<2>(TL + row, col, v0, v1);
        else f.template store<3>(TL + row, col, v0, v1);
    }
}

__device__ __forceinline__ float dpp_ror1(float x) { return __int_as_float(__builtin_amdgcn_update_dpp(0, __float_as_int(x), 0x121, 0xF, 0xF, false)); }
__device__ __forceinline__ float dpp_ror15(float x) { return __int_as_float(__builtin_amdgcn_update_dpp(0, __float_as_int(x), 0x12F, 0xF, 0xF, false)); }
struct EpiGu {
    static constexpr bool PERM = true, AFTER_DRAIN = false;
    bf16_t* hid; bf16_t* part; float* edge; const float* cw; const float* cb; LAS unsigned char* halo;
    __device__ __forceinline__ void operator()(const f32x4 (&acc)[2][2][4][2], const pg8::Unit& u, int wr, int wc, int fr, int fq) const {
        if (u.sk >= 0) {
            const int rl0 = wr * 64 + fr;
#pragma unroll
            for (int bj = 0; bj < 2; ++bj) {
                const int col = u.pn * 256 + bj * 128 + wc * 32 + 8 * fq;
#pragma unroll
                for (int ai = 0; ai < 2; ++ai)
#pragma unroll
                    for (int m = 0; m < 4; ++m) st_bf16x8_n(part + ((size_t)(u.sk * 256 + rl0 + ai * 128 + m * 16)) * 8192 + col, acc[ai][bj][m][0], acc[ai][bj][m][1]);
            }
            return;
        }
        const int hc = u.pn * 128 + wc * 32 + 8 * fq;
        LAS float* H = (LAS float*)halo;
        const int hcol = wc * 32 + 8 * fq;
#pragma unroll
        for (int ai = 0; ai < 2; ++ai) {
            if (fr == 0)  { *(LAS f32x4*)(H + ((ai * 2 + wr) * 2 + 0) * 128 + hcol) = acc[ai][0][0][0]; *(LAS f32x4*)(H + ((ai * 2 + wr) * 2 + 0) * 128 + hcol + 4) = acc[ai][0][0][1]; }
            if (fr == 15) { *(LAS f32x4*)(H + ((ai * 2 + wr) * 2 + 1) * 128 + hcol) = acc[ai][0][3][0]; *(LAS f32x4*)(H + ((ai * 2 + wr) * 2 + 1) * 128 + hcol + 4) = acc[ai][0][3][1]; }
        }
        asm volatile("s_waitcnt lgkmcnt(0)\n\ts_barrier\n\ts_barrier" ::: "memory");
        float w0[8], w1[8], w2[8], bb[8];
        { const f32x4 a0 = *(const f32x4*)(cw + hc), a1 = *(const f32x4*)(cw + hc + 4), b0 = *(const f32x4*)(cw + D + hc), b1 = *(const f32x4*)(cw + D + hc + 4);
          const f32x4 c0 = *(const f32x4*)(cw + 2 * D + hc), c1 = *(const f32x4*)(cw + 2 * D + hc + 4), d0 = *(const f32x4*)(cb + hc), d1 = *(const f32x4*)(cb + hc + 4);
#pragma unroll
          for (int j = 0; j < 4; ++j) { w0[j] = a0[j]; w0[4 + j] = a1[j]; w1[j] = b0[j]; w1[4 + j] = b1[j]; w2[j] = c0[j]; w2[4 + j] = c1[j]; bb[j] = d0[j]; bb[4 + j] = d1[j]; } }
        const int row0 = u.pm * 256 + wr * 64 + fr;
#pragma unroll
        for (int ai = 0; ai < 2; ++ai) {
            const bool hasp = (wr == 1) || (ai == 1), hasn = (wr == 0) || (ai == 0);
            const int pb = wr == 1 ? (ai * 2 + 0) : ((ai - 1) * 2 + 1), nb = wr == 0 ? (ai * 2 + 1) : ((ai + 1) * 2 + 0);
            float hp[8], hn[8];
            { f32x4 x0 = {0.f, 0.f, 0.f, 0.f}, x1 = x0, y0 = x0, y1 = x0;
              if (hasp) { x0 = *(LAS const f32x4*)(H + (pb * 2 + 1) * 128 + hcol); x1 = *(LAS const f32x4*)(H + (pb * 2 + 1) * 128 + hcol + 4); }
              if (hasn) { y0 = *(LAS const f32x4*)(H + (nb * 2 + 0) * 128 + hcol); y1 = *(LAS const f32x4*)(H + (nb * 2 + 0) * 128 + hcol + 4); }
#pragma unroll
              for (int j = 0; j < 4; ++j) { hp[j] = x0[j]; hp[4 + j] = x1[j]; hn[j] = y0[j]; hn[4 + j] = y1[j]; } }
#pragma unroll
            for (int m = 0; m < 4; ++m) {
                float h[8];
#pragma unroll
                for (int j = 0; j < 8; ++j) {
                    const float a = j < 4 ? acc[ai][0][m][0][j & 3] : acc[ai][0][m][1][j & 3], up = j < 4 ? acc[ai][1][m][0][j & 3] : acc[ai][1][m][1][j & 3];
                    const float am = m > 0 ? (j < 4 ? acc[ai][0][m > 0 ? m - 1 : 0][0][j & 3] : acc[ai][0][m > 0 ? m - 1 : 0][1][j & 3]) : 0.f;
                    const float ap = m < 3 ? (j < 4 ? acc[ai][0][m < 3 ? m + 1 : 3][0][j & 3] : acc[ai][0][m < 3 ? m + 1 : 3][1][j & 3]) : 0.f;
                    const float p1 = dpp_ror1(a), p2 = m > 0 ? dpp_ror1(am) : hp[j];
                    const float n1 = dpp_ror15(a), n2 = m < 3 ? dpp_ror15(ap) : hn[j];
                    const float prev = fr > 0 ? p1 : p2, next = fr < 15 ? n1 : n2;
                    h[j] = siluf_(bb[j] + w0[j] * prev + w1[j] * a + w2[j] * next) * up;
                }
                u32x4 w; w.x = cvt_pk_bf16(h[0], h[1]); w.y = cvt_pk_bf16(h[2], h[3]); w.z = cvt_pk_bf16(h[4], h[5]); w.w = cvt_pk_bf16(h[6], h[7]);
                *(u32x4*)(hid + (size_t)(row0 + ai * 128 + m * 16) * D + hc) = w;
            }
        }
        float* E = edge + (size_t)u.pm * 6 * D + hc;
        if (wr == 0 && fr < 2)  { *(f32x4*)(E + (size_t)fr * D) = acc[0][0][0][0]; *(f32x4*)(E + (size_t)fr * D + 4) = acc[0][0][0][1]; }
        if (wr == 0 && fr == 0) { *(f32x4*)(E + (size_t)4 * D) = acc[0][1][0][0]; *(f32x4*)(E + (size_t)4 * D + 4) = acc[0][1][0][1]; }
        if (wr == 1 && fr >= 14) { *(f32x4*)(E + (size_t)(fr - 12) * D) = acc[1][0][3][0]; *(f32x4*)(E + (size_t)(fr - 12) * D + 4) = acc[1][0][3][1]; }
        if (wr == 1 && fr == 15) { *(f32x4*)(E + (size_t)5 * D) = acc[1][1][3][0]; *(f32x4*)(E + (size_t)5 * D + 4) = acc[1][1][3][1]; }
    }
};
__device__ __forceinline__ void run_gemm_gu(PP p, LAS unsigned char* lds, int l, int M) {
    pg8::Gemm g{wsp<const bf16_t>(p, WS_H), wsp<const bf16_t>(p, WS_GU + l * SZ_GU), M, 8192, D}; pg8::TailOrder S; S.init(TL, 8192, D, (int)gridDim.x, (int)mk_bid(), M > TL);
    EpiGu E{wsp<bf16_t>(p, WS_HID), wsp<bf16_t>(p, WS_PART), wsp<float>(p, WS_EDGE), p->in[I_FFNCW] + (size_t)l * 3 * D, p->in[I_FFNCB] + (size_t)l * D, lds + LDS_HALO};
    pg8::gemm_phase<EpiGu, pg8::TailOrder>(lds, g, S, E);
}

struct WMat { const float* src; bf16_t* dst; int K, N, ldn, il; };
__device__ __forceinline__ WMat wmat(PP p, int id) {
    WMat w; w.il = 0;
    if (id < 2)       { w.src = p->in[I_HGWIN] + (size_t)id * D * HG_PROJ; w.dst = wsp<bf16_t>(p, WS_HGIN + id * SZ_HGIN); w.K = D; w.N = HG_PROJ; w.ldn = HG_PROJ; }
    else if (id < 4)  { const int j = id - 2; w.src = p->in[I_HGWOUT] + (size_t)j * D * D; w.dst = wsp<bf16_t>(p, WS_HGOUT + j * SZ_SQ); w.K = D; w.N = D; w.ldn = D; }
    else if (id == 4) { w.src = p->in[I_ATWQKV]; w.dst = wsp<bf16_t>(p, WS_ATQKV); w.K = D; w.N = AT_PROJ; w.ldn = AT_PROJ; }
    else if (id == 5) { w.src = p->in[I_ATWOUT]; w.dst = wsp<bf16_t>(p, WS_ATOUT); w.K = D; w.N = D; w.ldn = D; }
    else if (id == 6) { w.src = p->in[I_SSMWIN]; w.dst = wsp<bf16_t>(p, WS_SSMIN); w.K = D; w.N = SSM_PROJ; w.ldn = SSM_PROJ; }
    else if (id == 7) { w.src = p->in[I_SSMWOUT]; w.dst = wsp<bf16_t>(p, WS_SSMOUT); w.K = 8192; w.N = D; w.ldn = D; }
    else if (id < 12) { const int l = id - 8; w.src = p->in[I_FFNWG] + (size_t)l * D * D; w.dst = wsp<bf16_t>(p, WS_GU + l * SZ_GU); w.K = D; w.N = D; w.ldn = D; w.il = 1; }
    else if (id < 16) { const int l = id - 12; w.src = p->in[I_FFNWU] + (size_t)l * D * D; w.dst = wsp<bf16_t>(p, WS_GU + l * SZ_GU); w.K = D; w.N = D; w.ldn = D; w.il = 2; }
    else              { const int l = id - 16; w.src = p->in[I_FFNWD] + (size_t)l * D * D; w.dst = wsp<bf16_t>(p, WS_FD + l * SZ_SQ); w.K = D; w.N = D; w.ldn = D; }
    return w;
}
constexpr int N_WMAT = 20;
__device__ __forceinline__ void wt_tile(const WMat& w, int tk, int tn, LAS unsigned* T32  , int tid) {
    const int k0 = tk * 128, n0 = tn * 64;
    const int r = tid >> 4, c4 = (tid & 15) * 4;
#pragma unroll
    for (int i = 0; i < 2; ++i) {
        const int kk = 2 * r + 64 * i;
        const f32x4 a = *(const f32x4*)(w.src + (size_t)(k0 + kk) * w.ldn + n0 + c4);
        const f32x4 b = *(const f32x4*)(w.src + (size_t)(k0 + kk + 1) * w.ldn + n0 + c4);
#pragma unroll
        for (int j = 0; j < 4; ++j) T32[(c4 + j) * 65 + (kk >> 1)] = cvt_pk_bf16(a[j], b[j]);
    }
    __syncthreads();
    const int n = tid >> 3, q = tid & 7;
    u32x4 o0, o1;
    o0.x = T32[n * 65 + q * 8 + 0]; o0.y = T32[n * 65 + q * 8 + 1]; o0.z = T32[n * 65 + q * 8 + 2]; o0.w = T32[n * 65 + q * 8 + 3];
    o1.x = T32[n * 65 + q * 8 + 4]; o1.y = T32[n * 65 + q * 8 + 5]; o1.z = T32[n * 65 + q * 8 + 6]; o1.w = T32[n * 65 + q * 8 + 7];
    const int nr = n0 + n, orow = w.il ? 256 * (nr >> 7) + (nr & 127) + (w.il == 2 ? 128 : 0) : nr;
    bf16_t* dp = w.dst + (size_t)orow * w.K + k0 + q * 16;
    *(u32x4*)dp = o0; *(u32x4*)(dp + 8) = o1;
    __syncthreads();
}
__device__ __forceinline__ void phase_prologue1(PP p, LAS unsigned char* lds) {
    const int tid = mk_tid(), G = gridDim.x, b = mk_bid();
    LAS unsigned* T32 = (LAS unsigned*)lds;
    for (int id = 0; id < N_WMAT; ++id) {
        const WMat w = wmat(p, id);
        const int nk = w.K / 128, nn = w.N / 64, ntile = nk * nn;
        for (int t = b; t < ntile; t += G) wt_tile(w, t % nk, t / nk, T32, tid);
    }
    LAS float* cs = (LAS float*)(lds + 32768);
    for (int task = b; task < 4 * 32 * 12; task += G) {
        const int cb = task % 12, ks = (task / 12) % 32, l = task / (12 * 32);
        __syncthreads();
        if (tid < 256) { const int s = tid >> 7, i = tid & 127; const float cv = (s == 0 ? p->in[I_C] : p->in[I_CCTX])[ks * 128 + i]; cs[tid] = siluf_(cv); }
        __syncthreads();
        const int j0 = cb * 2048 + tid * 4;
        const float* wp = p->in[I_MODW] + ((size_t)l * D + (size_t)ks * 128) * MODN + j0;
        f32x4 al = {0.f, 0.f, 0.f, 0.f}, ac = {0.f, 0.f, 0.f, 0.f};
#pragma unroll 8
        for (int i = 0; i < 128; ++i) { const f32x4 wv = *(const f32x4*)(wp + (size_t)i * MODN); al += cs[i] * wv; ac += cs[128 + i] * wv; }
        float* pp = wsp<float>(p, WS_MODP) + ((size_t)(ks * 4 + l) * 2) * MODN + j0;
        *(f32x4*)pp = al; *(f32x4*)(pp + MODN) = ac;
    }
    if (b == 0 && tid < 32) {
        const int j = tid; double th = 1.0;
        for (int i = 0; i < j; ++i) th *= 0.7498942093324559;
        const double t2 = th * th; double ct = 1.0, st = th, tc = 1.0, ts = th;
        for (int n = 1; n <= 14; ++n) { tc *= -t2 / (double)((2 * n - 1) * (2 * n)); ts *= -t2 / (double)((2 * n) * (2 * n + 1)); ct += tc; st += ts; }
        double cc = 1.0, ss = 0.0; float* o = wsp<float>(p, WS_ROPE);
        for (int pos = 0; pos < 256; ++pos) { o[(size_t)(pos * 32 + j) * 2] = (float)cc; o[(size_t)(pos * 32 + j) * 2 + 1] = (float)ss; const double nc = cc * ct - ss * st, ns = ss * ct + cc * st; cc = nc; ss = ns; }
    }
    for (int i = b * NT + tid; i < 2 * 2048; i += G * NT) {
        const int d = i >> 11, c = i & 2047;
        const float r0 = p->in[I_HGLB][(size_t)(d * 2 + 0) * 2048 + c], r1 = p->in[I_HGLB][(size_t)(d * 2 + 1) * 2048 + c];
        const float m = fmaxf(r0, r1), e0 = __expf(r0 - m), e1 = __expf(r1 - m);
        float* o = wsp<float>(p, WS_LB);
        const float lb1 = e1 / (e0 + e1);
        o[(size_t)(d * 2 + 0) * 2048 + c] = 0.f; o[8192 + (size_t)(d * 2 + 0) * 2048 + c] = -__builtin_inff(); o[16384 + (size_t)(d * 2 + 0) * 2048 + c] = 0.f;
        o[(size_t)(d * 2 + 1) * 2048 + c] = lb1; o[8192 + (size_t)(d * 2 + 1) * 2048 + c] = __logf(lb1); o[16384 + (size_t)(d * 2 + 1) * 2048 + c] = __logf(1.0f - lb1);
    }
}
__device__ __forceinline__ void phase_modreduce(PP p) {
    const int tid = mk_tid(), G = gridDim.x, b = mk_bid();
    for (int i = b * NT + tid; i < 4 * 2 * MODN; i += G * NT) {
        const int j = i % MODN, l = i / (2 * MODN);
        float s = p->in[I_MODB][(size_t)l * MODN + j];
        const float* pp = wsp<const float>(p, WS_MODP) + i;
#pragma unroll 8
        for (int ks = 0; ks < 32; ++ks) s += pp[(size_t)ks * 4 * 2 * MODN];
        wsp<float>(p, WS_MODV)[i] = s;
    }
}
__device__ __forceinline__ void phase_mod0(PP p) {
    const int tid = mk_tid(), G = gridDim.x, b = mk_bid();
    bf16_t* H = wsp<bf16_t>(p, WS_H);
    const int c = ((b * NT + tid) & 511) * 8, r00 = (b * NT + tid) >> 9, rs = (G * NT) >> 9;
    for (int s = 0; s < 2; ++s) {
        const float* sh = modv(p, 0, s, 0) + c; const float* sc = modv(p, 0, s, 1) + c;
        const f32x4 h0 = *(const f32x4*)sh, h1 = *(const f32x4*)(sh + 4), c0 = 1.0f + *(const f32x4*)sc, c1 = 1.0f + *(const f32x4*)(sc + 4);
        const int rlo = s == 0 ? 0 : TL, rhi = s == 0 ? TL : T;
        for (int r = rlo + r00; r < rhi; r += 4 * rs) {
            f32x4 x0[4], x1[4];
#pragma unroll
            for (int u = 0; u < 4; ++u) { const int ru = r + u * rs < rhi ? r + u * rs : r; const float* xr = xin_row(p, ru) + c; x0[u] = *(const f32x4*)xr; x1[u] = *(const f32x4*)(xr + 4); }
#pragma unroll
            for (int u = 0; u < 4; ++u) if (r + u * rs < rhi) st_bf16x8(H + (size_t)(r + u * rs) * D + c, x0[u] * c0 + h0, x1[u] * c1 + h1);
        }
    }
}

constexpr float XQ_MAGIC = 12615680.0f;
__device__ __forceinline__ float xq_lo(unsigned w) { return __uint_as_float((w & 0xffffu) | 0x4B400000u) - XQ_MAGIC; }
__device__ __forceinline__ float xq_hi(unsigned w) { return __uint_as_float((w >> 16) | 0x4B400000u) - XQ_MAGIC; }
__device__ __forceinline__ unsigned xq_pack(float y0, float y1, float inv) { return (__float_as_uint(fmaf(y0, inv, XQ_MAGIC)) & 0xffffu) | (__float_as_uint(fmaf(y1, inv, XQ_MAGIC)) << 16); }
__device__ __forceinline__ float amax4(float m, f32x4 y) { return fmaxf(fmaxf(m, fmaxf(fabsf(y[0]), fabsf(y[1]))), fmaxf(fabsf(y[2]), fabsf(y[3]))); }
template <class Op> __device__ __forceinline__ float ln_reduce8(const float (&s)[8], int lane, Op op) {
    float t[4], u[2];
    { const bool hi = lane & 32;
#pragma unroll
      for (int k = 0; k < 4; ++k) { const float send = hi ? s[k] : s[4 + k], keep = hi ? s[4 + k] : s[k]; t[k] = op(keep, xch32(send, lane)); } }
    { const bool hi = lane & 16;
#pragma unroll
      for (int k = 0; k < 2; ++k) { const float send = hi ? t[k] : t[2 + k], keep = hi ? t[2 + k] : t[k]; u[k] = op(keep, xch16(send, lane)); } }
    float w;
    { const bool hi = lane & 8; const float send = hi ? u[0] : u[1], keep = hi ? u[1] : u[0]; w = op(keep, dpp_mov<0x128>(send)); }
    w = op(w, dpp_mov<0xB1>(w)); w = op(w, dpp_mov<0x4E>(w)); w = op(w, dpp_mov<0x141>(w));
    return w;
}
typedef OpSum LnSum; typedef OpMax LnMax;
template <bool FIRST> struct LnRaw { u32x4 x[FIRST ? 16 : 8]; u32x4 o[8]; float xs; };
__device__ __forceinline__ float sum8_(f32x4 a, f32x4 b) { return ((a[0] + a[1]) + (a[2] + a[3])) + ((b[0] + b[1]) + (b[2] + b[3])); }
template <bool FIRST, bool LAST> __device__ __forceinline__ void ln_latent(PP p, LAS unsigned char* lds, int l, int which) {
    const int tid = mk_tid(), lane = tid & 63, wid = __builtin_amdgcn_readfirstlane(tid >> 6), G = gridDim.x, b = mk_bid();
    const unsigned c = (unsigned)(wid & 7) * 512u + (unsigned)lane * 8u; const int NB = TL / 8;
    LAS float* red = (LAS float*)(lds + 98304);
    const bf16_t* OB = wsp<const bf16_t>(p, WS_OB); bf16_t* XQ = wsp<bf16_t>(p, WS_X); float* XS = (float*)(p->ws + WS_X + (size_t)T * D * 2); bf16_t* H = wsp<bf16_t>(p, WS_H);
    LAS const float* vg = (LAS const float*)lds;
    const int k = (wid & 7) * 64 + lane;
#define LNV(vi, hf) (*(const LAS f32x4*)(vg + (vi) * D + (hf) * 2048 + k * 4))
    auto load = [&](int bt, LnRaw<FIRST>& w) {
        const int r0 = (bt < NB ? bt : NB - 1) * 8;
#pragma unroll
        for (int j = 0; j < 8; ++j) {
            const size_t ro = (size_t)(r0 + j) * D;
            w.o[j] = *(const u32x4*)(OB + ro + c);
            if (FIRST) { const float* xr = p->in[I_X] + ro; w.x[2 * j] = *(const u32x4*)(xr + c); w.x[2 * j + 1] = *(const u32x4*)(xr + c + 4u); }
            else w.x[j] = *(const u32x4*)(XQ + ro + c);
        }
        if (!FIRST) w.xs = XS[r0 + (lane & 7)];
    };
    auto exchange = [&](int k, float wv, float (&tot)[8], bool is_max) {
        if ((lane & 7) == 0) red[(k * 8 + wid) * 8 + (lane >> 3)] = wv;
        lds_barrier();
        f32x4 a0 = *(const LAS f32x4*)(red + k * 64), a1 = *(const LAS f32x4*)(red + k * 64 + 4);
#pragma unroll
        for (int w = 1; w < 8; ++w) {
            const f32x4 c0 = *(const LAS f32x4*)(red + (k * 8 + w) * 8), c1 = *(const LAS f32x4*)(red + (k * 8 + w) * 8 + 4);
            if (is_max) {
#pragma unroll
                for (int e = 0; e < 4; ++e) { a0[e] = fmaxf(a0[e], c0[e]); a1[e] = fmaxf(a1[e], c1[e]); }
            } else { a0 += c0; a1 += c1; }
        }
#pragma unroll
        for (int j = 0; j < 8; ++j) tot[j] = j < 4 ? a0[j & 3] : a1[j & 3];
    };
    auto process = [&](int bt, const LnRaw<FIRST>& w, bool valid) {
        int r0 = (bt < NB ? bt : NB - 1) * 8;
        asm volatile("" : "+s"(r0));
        f32x4 v0[8], v1[8]; float s[8], tot[8];
        const f32x4 gt0 = LNV(0, 0), gt1 = LNV(0, 1);
#pragma unroll
        for (int j = 0; j < 8; ++j) {
            const u32x4 ow = w.o[j];
            const f32x4 o0 = {bf_lo(ow.x), bf_hi(ow.x), bf_lo(ow.y), bf_hi(ow.y)}, o1 = {bf_lo(ow.z), bf_hi(ow.z), bf_lo(ow.w), bf_hi(ow.w)};
            if (FIRST) {
                v0[j] = ALPHA * __builtin_bit_cast(f32x4, w.x[2 * j]) + gt0 * o0; v1[j] = ALPHA * __builtin_bit_cast(f32x4, w.x[2 * j + 1]) + gt1 * o1;
            } else {
                const float as = ALPHA * __uint_as_float(__builtin_amdgcn_readlane(__float_as_uint(w.xs), j));
                const u32x4 xw = w.x[j];
                const f32x4 q0 = {xq_lo(xw.x), xq_hi(xw.x), xq_lo(xw.y), xq_hi(xw.y)}, q1 = {xq_lo(xw.z), xq_hi(xw.z), xq_lo(xw.w), xq_hi(xw.w)};
                v0[j] = as * q0 + gt0 * o0; v1[j] = as * q1 + gt1 * o1;
            }
            s[j] = sum8_(v0[j], v1[j]);
        }
        exchange(0, ln_reduce8(s, lane, LnSum()), tot, false);
#pragma unroll
        for (int j = 0; j < 8; ++j) { const float mean = tot[j] * (1.0f / D); v0[j] = v0[j] - mean; v1[j] = v1[j] - mean; s[j] = sum8_(v0[j] * v0[j], v1[j] * v1[j]); }
        exchange(1, ln_reduce8(s, lane, LnSum()), tot, false);
        const f32x4 g0 = LNV(1, 0), g1 = LNV(1, 1), b0 = LNV(2, 0), b1 = LNV(2, 1);
#pragma unroll
        for (int j = 0; j < 8; ++j) {
            const float rstd = rsqrtf(tot[j] * (1.0f / D) + LN_EPS);
            v0[j] = v0[j] * (rstd * g0) + b0; v1[j] = v1[j] * (rstd * g1) + b1;
            if (!LAST) s[j] = amax4(amax4(0.f, v0[j]), v1[j]);
        }
        if (LAST) {
            if (valid) {
#pragma unroll
                for (int j = 0; j < 8; ++j) { float* o = p->out + (size_t)(r0 + j) * D; *(f32x4*)(o + c) = v0[j]; *(f32x4*)(o + c + 4u) = v1[j]; }
            }
        } else {
            exchange(2, ln_reduce8(s, lane, LnMax()), tot, true);
            if (valid) {
                const f32x4 sc0 = 1.0f + LNV(3, 0), sc1 = 1.0f + LNV(3, 1), sh0 = LNV(4, 0), sh1 = LNV(4, 1);
                float mine = 0.f;
#pragma unroll
                for (int j = 0; j < 8; ++j) {
                    const float M = fmaxf(tot[j], 1e-20f), inv = 32767.0f / M;
                    mine = lane == j ? M * (1.0f / 32767.0f) : mine;
                    const size_t ro = (size_t)(r0 + j) * D;
                    u32x4 xw; xw.x = xq_pack(v0[j][0], v0[j][1], inv); xw.y = xq_pack(v0[j][2], v0[j][3], inv); xw.z = xq_pack(v1[j][0], v1[j][1], inv); xw.w = xq_pack(v1[j][2], v1[j][3], inv);
                    *(u32x4*)(XQ + ro + c) = xw;
                    st_bf16x8(H + ro + c, v0[j] * sc0 + sh0, v1[j] * sc1 + sh1);
                }
                if (wid == 0 && lane < 8) XS[r0 + lane] = mine;
            }
        }
    };
    const int nmine = b < NB ? (NB - b + G - 1) / G : 0;
    if (FIRST) {
        LnRaw<FIRST> ra;
        for (int i = 0; i < nmine; ++i) { load(b + i * G, ra); process(b + i * G, ra, true); }
    } else {
        LnRaw<FIRST> ra, rb;
        load(b, ra);
#pragma unroll 1
        for (int i = 0; i < nmine; i += 2) {
            load(b + (i + 1) * G, rb); process(b + i * G, ra, true);
            load(b + (i + 2) * G, ra); process(b + (i + 1) * G, rb, i + 1 < nmine);
        }
    }
}
#undef LNV
__device__ __forceinline__ void phase_ln(PP p, LAS unsigned char* lds, int l, int which  ) {
    const int tid = mk_tid(), lane = tid & 63, wid = tid >> 6, G = gridDim.x, b = mk_bid();
    LAS float* vg = (LAS float*)lds;
    const bool last = (l == DEPTH - 1 && which == 1), first = (l == 0 && which == 0);
    const bf16_t* OB = wsp<const bf16_t>(p, WS_OB); bf16_t* XQ = wsp<bf16_t>(p, WS_X); float* XS = (float*)(p->ws + WS_X + (size_t)T * D * 2); bf16_t* H = wsp<bf16_t>(p, WS_H);
    const float* lg = p->in[I_LNG] + (size_t)(l * 2 + which) * D; const float* lbv = p->in[I_LNB] + (size_t)(l * 2 + which) * D;
    for (int s = 0; s < 2; ++s) {
        if (s == 1 && l == DEPTH - 1) break;
        __syncthreads();
        const float* gt = modv(p, l, s, which == 0 ? 2 : 5);
        const float* sc = last ? nullptr : (which == 0 ? modv(p, l, s, 4) : modv(p, l + 1, s, 1));
        const float* sh = last ? nullptr : (which == 0 ? modv(p, l, s, 3) : modv(p, l + 1, s, 0));
        for (int i = tid; i < D; i += NT) { const int ps = ((i >> 2) & 1) * 2048 + (i >> 3) * 4 + (i & 3); vg[ps] = gt[i]; vg[D + ps] = lg[i]; vg[2 * D + ps] = lbv[i]; vg[3 * D + ps] = sc ? sc[i] : 0.f; vg[4 * D + ps] = sh ? sh[i] : 0.f; }
        __syncthreads();
        if (s == 0) { if (first) ln_latent<true, false>(p, lds, l, which); else if (last) ln_latent<false, true>(p, lds, l, which); else ln_latent<false, false>(p, lds, l, which); continue; }
#define LN_VEC(vi, k, hf) (*(const LAS f32x4*)(vg + (vi) * D + (hf) * 2048 + (k) * 4))
        auto load_piece = [&](int r, int c, int k, float as, f32x4& v0, f32x4& v1) {
            const bf16_t* part = wsp<const bf16_t>(p, WS_PART) + (size_t)(r - TL) * D + c;
            u32x4 pw[16];
#pragma unroll
            for (int sk = 0; sk < 16; ++sk) pw[sk] = *(const u32x4*)(part + (size_t)sk * 256 * D);
            f32x4 o0 = {0.f, 0.f, 0.f, 0.f}, o1 = o0;
#pragma unroll
            for (int sk = 0; sk < 16; ++sk) { o0 += (f32x4){bf_lo(pw[sk].x), bf_hi(pw[sk].x), bf_lo(pw[sk].y), bf_hi(pw[sk].y)}; o1 += (f32x4){bf_lo(pw[sk].z), bf_hi(pw[sk].z), bf_lo(pw[sk].w), bf_hi(pw[sk].w)}; }
            if (first) {
                const float* xr = xin_row(p, r) + c;
                v0 = ALPHA * *(const f32x4*)xr + LN_VEC(0, k, 0) * o0; v1 = ALPHA * *(const f32x4*)(xr + 4) + LN_VEC(0, k, 1) * o1;
            } else {
                const u32x4 xw = *(const u32x4*)(XQ + (size_t)r * D + c);
                const f32x4 q0 = {xq_lo(xw.x), xq_hi(xw.x), xq_lo(xw.y), xq_hi(xw.y)}, q1 = {xq_lo(xw.z), xq_hi(xw.z), xq_lo(xw.w), xq_hi(xw.w)};
                v0 = as * q0 + LN_VEC(0, k, 0) * o0; v1 = as * q1 + LN_VEC(0, k, 1) * o1;
            }
        };
        auto store_piece = [&](int r, int c, int k, f32x4 y0, f32x4 y1, float inv) {
            u32x4 xw; xw.x = xq_pack(y0[0], y0[1], inv); xw.y = xq_pack(y0[2], y0[3], inv); xw.z = xq_pack(y1[0], y1[1], inv); xw.w = xq_pack(y1[2], y1[3], inv);
            *(u32x4*)(XQ + (size_t)r * D + c) = xw;
            st_bf16x8(H + (size_t)r * D + c, y0 * (1.0f + LN_VEC(3, k, 0)) + LN_VEC(4, k, 0), y1 * (1.0f + LN_VEC(3, k, 1)) + LN_VEC(4, k, 1));
        };
        if (s == 1) {
            if (l < DEPTH - 1) {
                LAS float* red = vg + 5 * D;
                for (int rr = b; rr < TC; rr += G) {
                    const int r = TL + rr, c = wid * 512 + lane * 8, k = wid * 64 + lane;
                    f32x4 v0, v1;
                    load_piece(r, c, k, first ? 0.f : ALPHA * XS[r], v0, v1);
                    const float ws_ = wave_sum(((v0[0] + v0[1]) + (v0[2] + v0[3])) + ((v1[0] + v1[1]) + (v1[2] + v1[3]))); if (lane == 0) red[wid] = ws_;
                    __syncthreads();
                    float tot = 0.f;
#pragma unroll
                    for (int w = 0; w < 8; ++w) tot += red[w];
                    const float mean = tot * (1.0f / D);
                    const f32x4 d0 = v0 - mean, d1 = v1 - mean;
                    const float wq = wave_sum(((d0[0] * d0[0] + d0[1] * d0[1]) + (d0[2] * d0[2] + d0[3] * d0[3])) + ((d1[0] * d1[0] + d1[1] * d1[1]) + (d1[2] * d1[2] + d1[3] * d1[3]))); if (lane == 0) red[8 + wid] = wq;
                    __syncthreads();
                    float qt = 0.f;
#pragma unroll
                    for (int w = 0; w < 8; ++w) qt += red[8 + w];
                    const float rstd = rsqrtf(qt * (1.0f / D) + LN_EPS);
                    const f32x4 y0 = d0 * rstd * LN_VEC(1, k, 0) + LN_VEC(2, k, 0), y1 = d1 * rstd * LN_VEC(1, k, 1) + LN_VEC(2, k, 1);
                    const float wm = wave_max(amax4(amax4(0.f, y0), y1)); if (lane == 0) red[16 + wid] = wm;
                    __syncthreads();
                    float M = 1e-20f;
#pragma unroll
                    for (int w = 0; w < 8; ++w) M = fmaxf(M, red[16 + w]);
                    if (tid == 0) XS[r] = M * (1.0f / 32767.0f);
                    store_piece(r, c, k, y0, y1, 32767.0f / M);
                }
            }
            continue;
        }
#undef LN_VEC
    }
}

__device__ __forceinline__ void phase_ffn_fix(PP p, int l, bool ctx_out) {
    const int tid = mk_tid(), G = gridDim.x, b = mk_bid();
    bf16_t* HID = wsp<bf16_t>(p, WS_HID); const float* edge = wsp<const float>(p, WS_EDGE); const bf16_t* part = wsp<const bf16_t>(p, WS_PART);
    const float* cw = p->in[I_FFNCW] + (size_t)l * 3 * D; const float* cb = p->in[I_FFNCB] + (size_t)l * D;
    for (int idx = b * NT + tid; idx < 64 * 2 * 512; idx += G * NT) {
        const int c = (idx & 511) * 8, e = (idx >> 9) & 1, pm = idx >> 10;
        const float* E = edge + (size_t)pm * 6 * D + c;
        float h[8];
#pragma unroll
        for (int j = 0; j < 8; ++j) {
            float a, ap, an, uu;
            if (e == 0) { a = E[j]; an = E[D + j]; ap = pm > 0 ? edge[((size_t)(pm - 1) * 6 + 3) * D + c + j] : 0.f; uu = E[4 * D + j]; }
            else { a = E[3 * D + j]; ap = E[2 * D + j]; an = pm < 63 ? edge[((size_t)(pm + 1) * 6 + 0) * D + c + j] : 0.f; uu = E[5 * D + j]; }
            h[j] = siluf_(cb[c + j] + cw[c + j] * ap + cw[D + c + j] * a + cw[2 * D + c + j] * an) * uu;
        }
        u32x4 w; w.x = cvt_pk_bf16(h[0], h[1]); w.y = cvt_pk_bf16(h[2], h[3]); w.z = cvt_pk_bf16(h[4], h[5]); w.w = cvt_pk_bf16(h[6], h[7]);
        *(u32x4*)(HID + (size_t)(pm * 256 + (e ? 255 : 0)) * D + c) = w;
    }
    if (ctx_out) {
        constexpr int SK = 8;
        for (int idx = b * NT + tid; idx < TC * 512; idx += G * NT) {
            const int c = (idx & 511) * 8, t = idx >> 9, ic = 256 * (c >> 7) + (c & 127);
            auto sum8 = [&](int tt, int col, float (&o)[8]) {
                f32x4 x = {0.f, 0.f, 0.f, 0.f}, y = x;
#pragma unroll
                for (int s = 0; s < SK; ++s) { float o8[8]; ld8bf(part + ((size_t)(s * 256 + tt)) * 8192 + col, o8); x += (f32x4){o8[0], o8[1], o8[2], o8[3]}; y += (f32x4){o8[4], o8[5], o8[6], o8[7]}; }
                o[0] = x[0]; o[1] = x[1]; o[2] = x[2]; o[3] = x[3]; o[4] = y[0]; o[5] = y[1]; o[6] = y[2]; o[7] = y[3];
            };
            float prev[8], cur[8], nxt[8], u[8], h[8];
#pragma unroll
            for (int j = 0; j < 8; ++j) { prev[j] = 0.f; nxt[j] = 0.f; }
            if (t > 0) sum8(t - 1, ic, prev);
            sum8(t, ic, cur);
            if (t + 1 < TC) sum8(t + 1, ic, nxt);
            sum8(t, ic + 128, u);
#pragma unroll
            for (int j = 0; j < 8; ++j) h[j] = siluf_(cb[c + j] + cw[c + j] * prev[j] + cw[D + c + j] * cur[j] + cw[2 * D + c + j] * nxt[j]) * u[j];
            u32x4 w; w.x = cvt_pk_bf16(h[0], h[1]); w.y = cvt_pk_bf16(h[2], h[3]); w.z = cvt_pk_bf16(h[4], h[5]); w.w = cvt_pk_bf16(h[6], h[7]);
            *(u32x4*)(HID + (size_t)(TL + t) * D + c) = w;
        }
    }
}
template <int CC> __device__ __forceinline__ size_t frag_off(int row, int col) { return ((size_t)((row >> 4) * (CC / 32) + (col >> 5)) * 64 + ((col & 31) >> 3) * 16 + (row & 15)) * 8 + (col & 7); }
__device__ __forceinline__ int hg_chunk_row(int c) { return c < 256 ? c * 64 : TL + (c - 256) * 64; }
__device__ __forceinline__ int hg_kperm(int k) { const int kl = k & 31, hi = kl >> 4, r = kl & 15; return (k & ~31) + (r >> 2) * 8 + hi * 4 + (r & 3); }
template <int V> struct IC { static constexpr int value = V; };
__device__ __forceinline__ float clamp80(float x) { return fminf(fmaxf(x, -80.f), 80.f); }
__device__ __forceinline__ void phase_hg_prep(PP p, LAS unsigned char* lds) {
    const int tid = mk_tid(), lane = tid & 63, wid = tid >> 6, G = gridDim.x, r16 = lane & 15, q4 = lane >> 4;
    const bf16_t* QB = wsp<const bf16_t>(p, HG_QB); const bf16_t* KB = wsp<const bf16_t>(p, HG_KB); const float* LF = wsp<const float>(p, HG_LF); const bf16_t* V = wsp<const bf16_t>(p, HG_V);
    bf16_t* HA = wsp<bf16_t>(p, HG_A); bf16_t* HQT = wsp<bf16_t>(p, HG_QT); bf16_t* HKT = wsp<bf16_t>(p, HG_KT); float* HD = wsp<float>(p, HG_D); bf16_t* HVT = wsp<bf16_t>(p, HG_VT);
    constexpr int RS = 272;
    constexpr int HP_TOT = 288 * RS, HP_QT = HP_TOT + 2048, HP_A = HP_QT + 16384;
    LAS float* TOT = (LAS float*)(lds + HP_TOT);
    const int k = tid & 127, I = __builtin_amdgcn_readfirstlane(tid >> 7);
    struct HpIn { u32x4 lf[4], q[2], kk[2]; };
    auto load_in = [&](int item, HpIn& v) {
        const int c = item % NCH, h = (item / NCH) & 15, d = item / (NCH * 16), rb = hg_chunk_row(c);
#pragma unroll
        for (int u = 0; u < 4; ++u) { const int pi = tid + 512 * u, row = pi >> 5, cp = pi & 31; v.lf[u] = *(const u32x4*)(LF + ((size_t)d * T + rb + row) * 2048 + h * 128 + cp * 4); }
#pragma unroll
        for (int u = 0; u < 2; ++u) { const int pi = tid + 512 * u, row = pi >> 4, cp = pi & 15;
            v.q[u] = *(const u32x4*)(QB + (size_t)(rb + row) * 2048 + h * 128 + cp * 8); v.kk[u] = *(const u32x4*)(KB + ((size_t)d * T + rb + row) * 2048 + h * 128 + cp * 8); }
    };
    auto process = [&](int item, const HpIn& in, auto dtag) {
        constexpr int d = decltype(dtag)::value;
        const int c = item % NCH, h = (item / NCH) & 15, rb = hg_chunk_row(c);
        (void)rb; (void)h;
        lds_barrier();
#pragma unroll
        for (int u = 0; u < 4; ++u) *(LAS u32x4*)(lds + (tid + 512 * u) * 16) = in.lf[u];
#pragma unroll
        for (int u = 0; u < 2; ++u) { *(LAS u32x4*)(lds + 32768 + (tid + 512 * u) * 16) = in.q[u]; *(LAS u32x4*)(lds + 49152 + (tid + 512 * u) * 16) = in.kk[u]; }
        lds_barrier();
        float b[16], qv[16], kv[16];
        const int tb = d ? 63 - 16 * I : 16 * I;
#pragma unroll
        for (int j = 0; j < 16; ++j) {
            const int to = d ? -j : j;
            b[j] = ((LAS const float*)lds + tb * 128 + k)[to * 128]; qv[j] = bf1(((LAS const bf16_t*)(lds + 32768) + tb * 128 + k)[to * 128]); kv[j] = bf1(((LAS const bf16_t*)(lds + 49152) + tb * 128 + k)[to * 128]);
        }
        lds_barrier();
#pragma unroll
        for (int j = 1; j < 16; ++j) b[j] += b[j - 1];
        TOT[I * 128 + k] = b[15];
        lds_barrier();
        const float t0 = TOT[k], t1 = TOT[128 + k], t2 = TOT[256 + k], t3 = TOT[384 + k];
        const float rI = (I > 0 ? t0 : 0.f) + (I > 1 ? t1 : 0.f) + (I > 2 ? t2 : 0.f), gtot = (t0 + t1) + (t2 + t3);
        if (I == 0) HD[(size_t)item * 128 + k] = __expf(gtot);
        const float off1 = (I == 0 ? t0 : I == 1 ? t1 : I == 2 ? t2 : t3), off2 = off1 + (I == 0 ? t1 : t2), off3 = off2 + t2;
        const float bmid = b[7];
        const int kp = hg_kperm(k);
        const float cq = __expf(rI), ck = __expf(gtot - rI - off1), c2 = __expf(off2 - off1), c3 = __expf(off3 - off1);
        unsigned short kt16[16];
        LAS bf16_t* pQD = (LAS bf16_t*)(lds + (size_t)(16 * I) * RS) + k;
        LAS bf16_t* pKD = (LAS bf16_t*)(lds + (size_t)(64 + 16 * I) * RS) + k;
        LAS bf16_t* pQO = (LAS bf16_t*)(lds + (size_t)(I >= 1 ? 128 + 16 * (I - 1) : 272) * RS) + k;
        LAS bf16_t* pK1 = (LAS bf16_t*)(lds + (size_t)(I == 0 ? 176 : I == 1 ? 208 : I == 2 ? 256 : 272) * RS) + k;
        LAS bf16_t* pK2 = (LAS bf16_t*)(lds + (size_t)(I == 0 ? 192 : I == 1 ? 240 : 272) * RS) + k;
        LAS bf16_t* pK3 = (LAS bf16_t*)(lds + (size_t)(I == 0 ? 224 : 272) * RS) + k;
        LAS bf16_t* pQT = (LAS bf16_t*)(lds + HP_QT) + frag_off<128>(tb, kp);
#pragma unroll
        for (int j = 0; j < 16; ++j) {
            const float eb = __expf(b[j]), e1 = __expf(off1 - b[j]);
            pQT[d ? -8 * j : 8 * j] = f2bf_n(qv[j] * (cq * eb));
            kt16[j] = f2bf_n(kv[j] * (ck * e1));
            pQD[j * (RS / 2)] = f2bf_n(qv[j] * __expf(clamp80(b[j] - bmid)));
            pKD[j * (RS / 2)] = f2bf_n(kv[j] * __expf(clamp80(bmid - b[j])));
            pQO[j * (RS / 2)] = f2bf_n(qv[j] * eb);
            pK1[j * (RS / 2)] = f2bf_n(kv[j] * e1);
            pK2[j * (RS / 2)] = f2bf_n(kv[j] * (c2 * e1));
            pK3[j * (RS / 2)] = f2bf_n(kv[j] * (c3 * e1));
        }
        {
            u32x4 w0, w1;
#define KT_(i) ((unsigned)(d ? kt16[15 - (i)] : kt16[(i)]))
            w0.x = KT_(0) | (KT_(1) << 16); w0.y = KT_(2) | (KT_(3) << 16); w0.z = KT_(4) | (KT_(5) << 16); w0.w = KT_(6) | (KT_(7) << 16);
            w1.x = KT_(8) | (KT_(9) << 16); w1.y = KT_(10) | (KT_(11) << 16); w1.z = KT_(12) | (KT_(13) << 16); w1.w = KT_(14) | (KT_(15) << 16);
#undef KT_
            const int s0 = d ? 48 - 16 * I : 16 * I;
            *(u32x4*)(HKT + (size_t)item * 8192 + frag_off<64>(k, s0)) = w0; *(u32x4*)(HKT + (size_t)item * 8192 + frag_off<64>(k, s0 + 8)) = w1;
        }
        lds_barrier();
        { const u32x4 x0 = *(LAS const u32x4*)(lds + HP_QT + tid * 16), x1 = *(LAS const u32x4*)(lds + HP_QT + 8192 + tid * 16);
          *(u32x4*)(HQT + (size_t)item * 8192 + tid * 8) = x0; *(u32x4*)(HQT + (size_t)item * 8192 + 4096 + tid * 8) = x1; }
#pragma unroll 1
        for (int tile = wid; tile < 16; tile += 8) {
            const int Iq = tile >> 2, J = tile & 3;
            f32x4 acc = {0.f, 0.f, 0.f, 0.f};
            if (J <= Iq) {
                const int arow = (J == Iq) ? 16 * Iq : 128 + 16 * (Iq - 1);
                const int brow = (J == Iq) ? 64 + 16 * Iq : (Iq == 1 ? 176 : Iq == 2 ? 192 : 224) + 16 * J;
#pragma unroll
                for (int kk = 0; kk < 4; ++kk) {
                    const bf16x8 av = *(const LAS bf16x8*)(lds + (size_t)(arow + r16) * RS + kk * 64 + q4 * 16);
                    const bf16x8 bv = *(const LAS bf16x8*)(lds + (size_t)(brow + r16) * RS + kk * 64 + q4 * 16);
                    acc = __builtin_amdgcn_mfma_f32_16x16x32_bf16(av, bv, acc, 0, 0, 0);
                }
                if (J == Iq) {
#pragma unroll
                    for (int i = 0; i < 4; ++i) acc[i] = (r16 <= 4 * q4 + i) ? acc[i] : 0.f;
                }
            }
#pragma unroll
            for (int i = 0; i < 4; ++i) {
                const int tau = 16 * Iq + 4 * q4 + i, sig = 16 * J + r16, t = d ? 63 - tau : tau, s = d ? 63 - sig : sig;
                ((LAS bf16_t*)(lds + HP_A))[frag_off<64>(t, s)] = f2bf_n(acc[i]);
            }
        }
        lds_barrier();
        *(u32x4*)(HA + (size_t)item * 4096 + tid * 8) = *(LAS const u32x4*)(lds + HP_A + tid * 16);
    };
    const int NI = 32 * NCH, i0 = mk_bid();
    HpIn va, vb;
    auto run = [&](int item, const HpIn& in) { if (item < NCH * 16) process(item, in, IC<0>{}); else process(item, in, IC<1>{}); };
    if (i0 < NI) load_in(i0, va);
#pragma unroll 1
    for (int item = i0; item < NI; item += 2 * G) {
        if (item + G < NI) load_in(item + G, vb);
        run(item, va);
        if (item + 2 * G < NI) load_in(item + 2 * G, va);
        if (item + G < NI) run(item + G, vb);
    }
}
__device__ __forceinline__ int scan_chunk(int j, int d) { return d == 0 ? (j < 4 ? 256 + j : j - 4) : 259 - j; }
constexpr int HS_NF = 45, HS_BUF = HS_NF * 1024, HS_SX = 3 * HS_BUF, HS_OT = HS_SX + 16384;
static_assert(HS_OT + 8192 <= LDS_XB, "HGRN2 scan LDS image");
__device__ __forceinline__ void phase_hg_scan(PP p, LAS unsigned char* lds, bool ctx_out) {
    const int tid = mk_tid(), lane = tid & 63, wid = __builtin_amdgcn_readfirstlane(tid >> 6), G = gridDim.x, r16 = lane & 15, q4 = lane >> 4;
    const int vt = wid & 1, qt = wid >> 1;
    const bf16_t* HA = wsp<const bf16_t>(p, HG_A); const bf16_t* HQT = wsp<const bf16_t>(p, HG_QT); const bf16_t* HKT = wsp<const bf16_t>(p, HG_KT); const float* HD = wsp<const float>(p, HG_D);
    const bf16_t* HV = wsp<const bf16_t>(p, HG_V); bf16_t* HO = wsp<bf16_t>(p, HG_O);
    LAS bf16x8* Sx = (LAS bf16x8*)(lds + HS_SX);
    for (int it = mk_bid(); it < 256; it += G) {
        const int hd = (it & 7) * 4 + (it >> 6), vs = (it >> 3) & 7, d = hd >> 4, h = hd & 15;
        const bool zfa = d ? (wid == 4 || wid == 6) : (wid == 1 || wid == 3);
        auto dma_set = [&](int j, int b) {
            const int c = scan_chunk(j < NCH ? j : NCH - 1, d);
            const size_t itemc = (size_t)hd * NCH + c;
            LAS unsigned char* im = lds + b * HS_BUF;
#define HS_DMA(src, fi) __builtin_amdgcn_global_load_lds((const unsigned*)(src), (LAS unsigned*)(im + (fi) * 1024), 16, 0, 0)
            const bf16_t* dp0 = (const bf16_t*)(HD + itemc * 128) + (lane < 32 ? lane : 31) * 8;
            HS_DMA(zfa ? dp0 : HA + itemc * 4096 + (size_t)wid * 512 + lane * 8, zfa ? 44 : wid);
            HS_DMA(HQT + itemc * 8192 + (size_t)wid * 512 + lane * 8, wid + 8);
            HS_DMA(HQT + itemc * 8192 + (size_t)(wid + 8) * 512 + lane * 8, wid + 16);
            HS_DMA(HKT + itemc * 8192 + (size_t)wid * 512 + lane * 8, wid + 24);
            HS_DMA(HKT + itemc * 8192 + (size_t)(wid + 8) * 512 + lane * 8, wid + 32);
            const bf16_t* vtp = HV + (size_t)(hg_chunk_row(c) + (wid & 3) * 16 + (lane >> 2)) * D + h * 256 + vs * 32 + (lane & 3) * 8;
            const bf16_t* dp = (const bf16_t*)(HD + itemc * 128) + (lane < 32 ? lane : 31) * 8;
            HS_DMA(wid < 4 ? vtp : dp, wid < 4 ? 40 + wid : 44);
#undef HS_DMA
        };
        f32x4 S0 = {0.f, 0.f, 0.f, 0.f}, S1 = {0.f, 0.f, 0.f, 0.f};
        __syncthreads();
        if (zfa) {
#pragma unroll
            for (int b3 = 0; b3 < 3; ++b3) { unsigned zz = 0u; asm volatile("" : "+v"(zz)); *(LAS u32x4*)(lds + b3 * HS_BUF + wid * 1024 + lane * 16) = (u32x4){zz, zz, zz, zz}; }
        }
        dma_set(0, 0); dma_set(1, 1);
        { unsigned zz = 0u; asm volatile("" : "+v"(zz)); ((LAS u32x4*)(lds + HS_SX))[(vt * 4 + qt) * 64 + lane] = (u32x4){zz, zz, zz, zz}; }
        asm volatile("s_waitcnt vmcnt(6)" ::: "memory");
        lds_barrier();
        int buf = 0, ib = 0;
        auto flush_o = [&](int j) {
            const int c = scan_chunk(j, d);
            if (ctx_out || c < 256) {
                const int row = 16 * wid + (lane >> 2), piece = lane & 3;
                const u32x4 v = *(LAS const u32x4*)(lds + HS_OT + (j & 1) * 4096 + row * 64 + piece * 16);
                *(u32x4*)(HO + ((size_t)d * T + hg_chunk_row(c) + row) * D + h * 256 + vs * 32 + piece * 8) = v;
            }
        };
#pragma unroll 1
        for (int j = 0; j < NCH; ++j) {
            if (j > 0 && wid < 4) flush_o(j - 1);
            { const int ib2 = ib >= 1 ? ib - 1 : 2; dma_set(j + 2, ib2); }
            LAS const unsigned char* im = lds + ib * HS_BUF;
#define HS_FR(fi) (*(LAS const bf16x8*)(im + (fi) * 1024 + lane * 16))
            const unsigned vtb = (unsigned)(size_t)(im + 40 * 1024) + (unsigned)(((lane >> 4) * 8 + ((lane & 15) >> 2)) * 64 + (vt * 16 + 4 * (lane & 3)) * 2);
            s16x4 t00, t01, t10, t11;
            asm volatile("ds_read_b64_tr_b16 %0, %1" : "=&v"(t00) : "v"(vtb) : "memory");
            asm volatile("ds_read_b64_tr_b16 %0, %1 offset:256" : "=&v"(t01) : "v"(vtb) : "memory");
            asm volatile("ds_read_b64_tr_b16 %0, %1 offset:2048" : "=&v"(t10) : "v"(vtb) : "memory");
            asm volatile("ds_read_b64_tr_b16 %0, %1 offset:2304" : "=&v"(t11) : "v"(vtb) : "memory");
            const bf16x8 a0 = HS_FR(qt * 2), a1 = HS_FR(qt * 2 + 1);
            bf16x8 sb[4], qf[4];
#pragma unroll
            for (int kk = 0; kk < 4; ++kk) { sb[kk] = Sx[((buf * 2 + vt) * 4 + kk) * 64 + lane]; qf[kk] = HS_FR(8 + qt * 4 + kk); }
            const bf16x8 k00 = HS_FR(24 + (2 * qt) * 2), k01 = HS_FR(24 + (2 * qt) * 2 + 1), k10 = HS_FR(24 + (2 * qt + 1) * 2), k11 = HS_FR(24 + (2 * qt + 1) * 2 + 1);
            const f32x4 dv0 = *(LAS const f32x4*)(im + 44 * 1024 + ((2 * qt) * 16 + 4 * q4) * 4), dv1 = *(LAS const f32x4*)(im + 44 * 1024 + ((2 * qt + 1) * 16 + 4 * q4) * 4);
#undef HS_FR
            asm volatile("s_waitcnt lgkmcnt(0)" ::: "memory");
            __builtin_amdgcn_sched_barrier(0);
            const bf16x8 bv0 = {t00[0], t00[1], t00[2], t00[3], t01[0], t01[1], t01[2], t01[3]}, bv1 = {t10[0], t10[1], t10[2], t10[3], t11[0], t11[1], t11[2], t11[3]};
            f32x4 accq = {0.f, 0.f, 0.f, 0.f}, acca = {0.f, 0.f, 0.f, 0.f};
#pragma unroll
            for (int kk = 0; kk < 4; ++kk) accq = __builtin_amdgcn_mfma_f32_16x16x32_bf16(qf[kk], sb[kk], accq, 0, 0, 0);
            acca = __builtin_amdgcn_mfma_f32_16x16x32_bf16(a0, bv0, acca, 0, 0, 0); acca = __builtin_amdgcn_mfma_f32_16x16x32_bf16(a1, bv1, acca, 0, 0, 0);
            S0 = dv0 * S0; S1 = dv1 * S1;
            S0 = __builtin_amdgcn_mfma_f32_16x16x32_bf16(k00, bv0, S0, 0, 0, 0); S0 = __builtin_amdgcn_mfma_f32_16x16x32_bf16(k01, bv1, S0, 0, 0, 0);
            S1 = __builtin_amdgcn_mfma_f32_16x16x32_bf16(k10, bv0, S1, 0, 0, 0); S1 = __builtin_amdgcn_mfma_f32_16x16x32_bf16(k11, bv1, S1, 0, 0, 0);
            u32x4 sw; sw.x = cvt_pk_bf16_n(S0[0], S0[1]); sw.y = cvt_pk_bf16_n(S0[2], S0[3]); sw.z = cvt_pk_bf16_n(S1[0], S1[1]); sw.w = cvt_pk_bf16_n(S1[2], S1[3]);
            ((LAS u32x4*)(lds + HS_SX))[(((buf ^ 1) * 2 + vt) * 4 + qt) * 64 + lane] = sw;
            const f32x4 acc = accq + acca;
#pragma unroll
            for (int i = 0; i < 4; ++i) ((LAS bf16_t*)(lds + HS_OT + (j & 1) * 4096))[(qt * 16 + 4 * q4 + i) * 32 + vt * 16 + r16] = f2bf_n(acc[i]);
            asm volatile("s_waitcnt vmcnt(6)" ::: "memory");
            lds_barrier();
            buf ^= 1; ib = ib == 2 ? 0 : ib + 1;
        }
        if (wid < 4) flush_o(NCH - 1);
        asm volatile("s_waitcnt vmcnt(0)" ::: "memory");
        __syncthreads();
    }
}
struct HrRaw { u32x4 a[4], b[4], g[4]; };
__device__ __forceinline__ void unpack8u(u32x4 w, float (&o)[8]) { o[0] = bf_lo(w.x); o[1] = bf_hi(w.x); o[2] = bf_lo(w.y); o[3] = bf_hi(w.y); o[4] = bf_lo(w.z); o[5] = bf_hi(w.z); o[6] = bf_lo(w.w); o[7] = bf_hi(w.w); }
__device__ __forceinline__ void phase_hg_readout(PP p, LAS unsigned char* lds, int j, bool ctx_out) {
    const int tid = mk_tid(), lane = tid & 63, wid = __builtin_amdgcn_readfirstlane(tid >> 6), G = gridDim.x, bid = mk_bid();
    const bf16_t* O0 = wsp<const bf16_t>(p, HG_O); const bf16_t* O1 = O0 + (size_t)T * D; const bf16_t* SG = wsp<const bf16_t>(p, HG_SG);
    bf16_t* Y = wsp<bf16_t>(p, WS_YB); const float* ng = p->in[I_HGNORM] + (size_t)j * D;
    {
        const unsigned c = (unsigned)(wid & 7) * 512u + (unsigned)lane * 8u; const int NB = TL / 4;
        const f32x4 n0 = *(const f32x4*)(ng + c), n1 = *(const f32x4*)(ng + c + 4u);
        LAS float* red = (LAS float*)lds;
        auto load = [&](int bt, HrRaw& w) {
            const int r0 = (bt < NB ? bt : NB - 1) * 4;
#pragma unroll
            for (int q = 0; q < 4; ++q) { const size_t ro = (size_t)(r0 + q) * D; w.a[q] = *(const u32x4*)(O0 + ro + c); w.b[q] = *(const u32x4*)(O1 + ro + c); w.g[q] = *(const u32x4*)(SG + ro + c); }
        };
        auto process = [&](int bt, const HrRaw& w, bool valid, int buf) {
            int r0 = (bt < NB ? bt : NB - 1) * 4;
            asm volatile("" : "+s"(r0));
            float v[4][8], s[4];
#pragma unroll
            for (int q = 0; q < 4; ++q) {
                float a[8], b[8]; unpack8u(w.a[q], a); unpack8u(w.b[q], b);
                float ss = 0.f;
#pragma unroll
                for (int e = 0; e < 8; ++e) { v[q][e] = a[e] + b[e]; ss += v[q][e] * v[q][e]; }
                s[q] = ss;
            }
            float t2[2], wv;
            { const bool hi = lane & 32;
#pragma unroll
              for (int k = 0; k < 2; ++k) { const float send = hi ? s[k] : s[2 + k], keep = hi ? s[2 + k] : s[k]; t2[k] = keep + xch32(send, lane); } }
            { const bool hi = lane & 16; const float send = hi ? t2[0] : t2[1], keep = hi ? t2[1] : t2[0]; wv = keep + xch16(send, lane); }
            wv = row16_all(wv, OpSum());
            if ((lane & 15) == 0) red[(buf * 8 + wid) * 4 + (lane >> 4)] = wv;
            lds_barrier();
            f32x4 tot = *(const LAS f32x4*)(red + buf * 32);
#pragma unroll
            for (int w8 = 1; w8 < 8; ++w8) tot += *(const LAS f32x4*)(red + (buf * 8 + w8) * 4);
            if (valid) {
#pragma unroll
                for (int q = 0; q < 4; ++q) {
                    const float rs = rsqrtf(tot[q] * (1.0f / D) + RMS_EPS);
                    float g[8]; unpack8u(w.g[q], g);
                    f32x4 o0, o1;
#pragma unroll
                    for (int e = 0; e < 4; ++e) { o0[e] = v[q][e] * rs * n0[e] * g[e]; o1[e] = v[q][4 + e] * rs * n1[e] * g[4 + e]; }
                    st_bf16x8(Y + (size_t)(r0 + q) * D + c, o0, o1);
                }
            }
        };
        const int nmine = bid < NB ? (NB - bid + G - 1) / G : 0;
        HrRaw ra, rb;
        __syncthreads();
        load(bid, ra);
#pragma unroll 1
        for (int i = 0; i < nmine; i += 2) {
            load(bid + (i + 1) * G, rb); process(bid + i * G, ra, true, 0);
            load(bid + (i + 2) * G, ra); process(bid + (i + 1) * G, rb, i + 1 < nmine, 1);
        }
    }
    if (ctx_out) {
        LAS float* red = (LAS float*)lds;
        for (int rr = mk_bid(); rr < TC; rr += G) {
            const int r = TL + rr, c = wid * 512 + lane * 8;
            float a[8], b[8], v[8], g[8], o[8]; float ss = 0.f;
            ld8bf(O0 + (size_t)r * D + c, a); ld8bf(O1 + (size_t)r * D + c, b); ld8bf(SG + (size_t)r * D + c, g);
#pragma unroll
            for (int e = 0; e < 8; ++e) { v[e] = a[e] + b[e]; ss += v[e] * v[e]; }
            const float ws_ = wave_sum(ss);
            __syncthreads();
            if (lane == 0) red[wid] = ws_;
            __syncthreads();
            float tot = 0.f;
#pragma unroll
            for (int w = 0; w < 8; ++w) tot += red[w];
            const float rs = rsqrtf(tot * (1.0f / D) + RMS_EPS);
            const f32x4 n0 = *(const f32x4*)(ng + c), n1 = *(const f32x4*)(ng + c + 4);
#pragma unroll
            for (int e = 0; e < 8; ++e) o[e] = v[e] * rs * (e < 4 ? n0[e] : n1[e - 4]) * g[e];
            u32x4 w; w.x = cvt_pk_bf16(o[0], o[1]); w.y = cvt_pk_bf16(o[2], o[3]); w.z = cvt_pk_bf16(o[4], o[5]); w.w = cvt_pk_bf16(o[6], o[7]);
            *(u32x4*)(Y + (size_t)r * D + c) = w;
        }
    }
}

__device__ __forceinline__ void phase_mb_prep(PP p, LAS unsigned char* lds) {
    const int tid = mk_tid(), lane = tid & 63, wid = tid >> 6, G = gridDim.x, r16 = lane & 15, q4 = lane >> 4, bid = mk_bid();
    const bf16_t* XBC = wsp<const bf16_t>(p, MB_XBC); bf16_t* XSo = wsp<bf16_t>(p, MB_XS); const float* DTR = wsp<const float>(p, MB_DT);
    const float* cw = p->in[I_SSMCW]; const float* cb = p->in[I_SSMCB];
    bf16_t* MG = wsp<bf16_t>(p, MB_G); bf16_t* MCP = wsp<bf16_t>(p, MB_CP); bf16_t* MBT = wsp<bf16_t>(p, MB_BT); bf16_t* MXT = wsp<bf16_t>(p, MB_XT); float* MGV = wsp<float>(p, MB_GV); float* MDTC = wsp<float>(p, MB_DTC);
    constexpr int RS = 272;
    for (int item = bid; item < 8 * NCH; item += G) {
        const int c = item % NCH, g = item / NCH, rb = hg_chunk_row(c);
        const int row = tid >> 3, seg = tid & 7;
        {
            const int sg = tid & 15, r32 = tid >> 4, s0 = rb < TL ? 0 : TL, s1 = rb < TL ? TL : T;
            __syncthreads();
#pragma unroll
            for (int op = 0; op < 2; ++op) {
                const int ch = (op == 0 ? 9216 : 8192) + g * 128 + sg * 8;
                const f32x4 wa0 = *(const f32x4*)(cw + ch), wa1 = *(const f32x4*)(cw + ch + 4), wb0 = *(const f32x4*)(cw + 10240 + ch), wb1 = *(const f32x4*)(cw + 10240 + ch + 4);
                const f32x4 wc0 = *(const f32x4*)(cw + 20480 + ch), wc1 = *(const f32x4*)(cw + 20480 + ch + 4), bb0 = *(const f32x4*)(cb + ch), bb1 = *(const f32x4*)(cb + ch + 4);
#pragma unroll
                for (int hr = 0; hr < 2; ++hr) {
                    const int rw = r32 + 32 * hr, t = rb + rw;
                    const float mm = t - 1 >= s0 ? 1.f : 0.f, mp = t + 1 < s1 ? 1.f : 0.f;
                    const u32x4 um = *(const u32x4*)(XBC + (size_t)(t - 1 >= s0 ? t - 1 : t) * 10240 + ch), u0 = *(const u32x4*)(XBC + (size_t)t * 10240 + ch), up = *(const u32x4*)(XBC + (size_t)(t + 1 < s1 ? t + 1 : t) * 10240 + ch);
                    float xm[8], x0[8], xp[8]; unpack8u(um, xm); unpack8u(u0, x0); unpack8u(up, xp);
                    f32x4 h0, h1;
#pragma unroll
                    for (int e = 0; e < 4; ++e) {
                        h0[e] = siluf_(bb0[e] + wa0[e] * (xm[e] * mm) + wb0[e] * x0[e] + wc0[e] * (xp[e] * mp)); h1[e] = siluf_(bb1[e] + wa1[e] * (xm[4 + e] * mm) + wb1[e] * x0[4 + e] + wc1[e] * (xp[4 + e] * mp));
                    }
                    u32x4 hw; hw.x = cvt_pk_bf16(h0[0], h0[1]); hw.y = cvt_pk_bf16(h0[2], h0[3]); hw.z = cvt_pk_bf16(h1[0], h1[1]); hw.w = cvt_pk_bf16(h1[2], h1[3]);
                    *(LAS u32x4*)(lds + (size_t)(op * 64 + rw) * RS + sg * 16) = hw;
                }
            }
            __syncthreads();
        }
        const u32x4 c0 = *(const LAS u32x4*)(lds + (size_t)row * RS + seg * 32), c1 = *(const LAS u32x4*)(lds + (size_t)row * RS + seg * 32 + 16);
        {
            const int blk = seg >> 1, hi = seg & 1;
            bf16_t* cp = MCP + (size_t)item * 8192; const int p0 = blk * 32 + hi * 4;
            *(u32x2*)(cp + frag_off<128>(row, p0)) = (u32x2){c0.x, c0.y}; *(u32x2*)(cp + frag_off<128>(row, p0 + 8)) = (u32x2){c0.z, c0.w};
            *(u32x2*)(cp + frag_off<128>(row, p0 + 16)) = (u32x2){c1.x, c1.y}; *(u32x2*)(cp + frag_off<128>(row, p0 + 24)) = (u32x2){c1.z, c1.w};
        }
        __syncthreads();
#pragma unroll 1
        for (int tile = wid; tile < 16; tile += 8) {
            const int tt = tile >> 2, st = tile & 3;
            f32x4 acc = {0.f, 0.f, 0.f, 0.f};
#pragma unroll
            for (int kk = 0; kk < 4; ++kk) {
                const bf16x8 av = *(const LAS bf16x8*)(lds + (size_t)(tt * 16 + r16) * RS + kk * 64 + q4 * 16);
                const bf16x8 bv = *(const LAS bf16x8*)(lds + (size_t)(64 + st * 16 + r16) * RS + kk * 64 + q4 * 16);
                acc = __builtin_amdgcn_mfma_f32_16x16x32_bf16(av, bv, acc, 0, 0, 0);
            }
#pragma unroll
            for (int i = 0; i < 4; ++i) MG[(size_t)item * 4096 + frag_off<64>(tt * 16 + 4 * q4 + i, st * 16 + r16)] = f2bf_n(acc[i]);
        }
        {
            const int n = tid & 127, part = tid >> 7;
            unsigned w[8];
#pragma unroll
            for (int j = 0; j < 8; ++j) {
                const unsigned lo = *(const LAS bf16_t*)(lds + (size_t)(64 + part * 16 + 2 * j) * RS + n * 2), hi = *(const LAS bf16_t*)(lds + (size_t)(64 + part * 16 + 2 * j + 1) * RS + n * 2);
                w[j] = lo | (hi << 16);
            }
            bf16_t* bp = MBT + (size_t)item * 8192;
            *(u32x4*)(bp + frag_off<64>(n, part * 16)) = (u32x4){w[0], w[1], w[2], w[3]}; *(u32x4*)(bp + frag_off<64>(n, part * 16 + 8)) = (u32x4){w[4], w[5], w[6], w[7]};
        }
    }
    {
        __syncthreads();
        constexpr int RSX = 144, NI = 128 * NCH;
        const int wv = __builtin_amdgcn_readfirstlane(wid), sgx = lane & 7;
        LAS unsigned char* wl = lds + wv * (66 * RSX);
        struct XRaw { u32x4 r[8]; u32x4 h; };
        int hdw = -1; f32x4 wa0, wa1, wb0, wb1, wc0, wc1, bb0, bb1;
        auto loadx = [&](int i, XRaw& w) {
            const int ii = i < NI ? i : NI - 1, c = ii >> 7, hd = ii & 127, rb = hg_chunk_row(c), s0 = rb < TL ? 0 : TL, s1 = rb < TL ? TL : T;
            const bf16_t* src = XBC + hd * 64 + sgx * 8;
#pragma unroll
            for (int k = 0; k < 8; ++k) w.r[k] = *(const u32x4*)(src + (size_t)(rb + k * 8 + (lane >> 3)) * 10240);
            const int hr = (lane & 8) ? (rb + 64 < s1 ? rb + 64 : s1 - 1) : (rb - 1 >= s0 ? rb - 1 : s0);
            w.h = *(const u32x4*)(src + (size_t)hr * 10240);
        };
        auto procx = [&](int i, const XRaw& w) {
#pragma unroll
            for (int k = 0; k < 8; ++k) *(LAS u32x4*)(wl + (1 + k * 8 + (lane >> 3)) * RSX + sgx * 16) = w.r[k];
            if (lane < 16) *(LAS u32x4*)(wl + ((lane & 8) ? 65 : 0) * RSX + sgx * 16) = w.h;
            if (i < NI) {
                const int c = i >> 7, hd = i & 127, rb = hg_chunk_row(c), s0 = rb < TL ? 0 : TL, s1 = rb < TL ? TL : T, ch = hd * 64 + sgx * 8;
                if (hd != hdw) {
                    hdw = hd;
                    wa0 = *(const f32x4*)(cw + ch); wa1 = *(const f32x4*)(cw + ch + 4); wb0 = *(const f32x4*)(cw + 10240 + ch); wb1 = *(const f32x4*)(cw + 10240 + ch + 4);
                    wc0 = *(const f32x4*)(cw + 20480 + ch); wc1 = *(const f32x4*)(cw + 20480 + ch + 4); bb0 = *(const f32x4*)(cb + ch); bb1 = *(const f32x4*)(cb + ch + 4);
                }
                const float mf = rb - 1 >= s0 ? 1.f : 0.f, ml = rb + 64 < s1 ? 1.f : 0.f;
                u32x4 hv[8];
#pragma unroll
                for (int k = 0; k < 8; ++k) {
                    const int rw = k * 8 + (lane >> 3);
                    const u32x4 um = *(const LAS u32x4*)(wl + rw * RSX + sgx * 16), up = *(const LAS u32x4*)(wl + (rw + 2) * RSX + sgx * 16);
                    const float mm = rw > 0 ? 1.f : mf, mp = rw < 63 ? 1.f : ml;
                    float xm[8], x0[8], xp[8]; unpack8u(um, xm); unpack8u(w.r[k], x0); unpack8u(up, xp);
                    f32x4 h0, h1;
#pragma unroll
                    for (int e = 0; e < 4; ++e) {
                        h0[e] = siluf_(bb0[e] + wa0[e] * (xm[e] * mm) + wb0[e] * x0[e] + wc0[e] * (xp[e] * mp)); h1[e] = siluf_(bb1[e] + wa1[e] * (xm[4 + e] * mm) + wb1[e] * x0[4 + e] + wc1[e] * (xp[4 + e] * mp));
                    }
                    hv[k].x = cvt_pk_bf16(h0[0], h0[1]); hv[k].y = cvt_pk_bf16(h0[2], h0[3]); hv[k].z = cvt_pk_bf16(h1[0], h1[1]); hv[k].w = cvt_pk_bf16(h1[2], h1[3]);
                }
#pragma unroll
                for (int k = 0; k < 8; ++k) *(u32x4*)(XSo + (size_t)(rb + k * 8 + (lane >> 3)) * 8192 + ch) = hv[k];
            }
        };
        const int i0 = bid * 8 + wv, st = G * 8;
        XRaw xa, xb;
        loadx(i0, xa);
#pragma unroll 1
        for (int i = i0; i < NI; i += 2 * st) { loadx(i + st, xb); procx(i, xa); loadx(i + 2 * st, xa); procx(i + st, xb); }
    }
    for (int item0 = (bid * 8 + wid) * 4; item0 < 256 * NCH; item0 += G * 8 * 4) {
        float dtv[4], gsum[4]; int tt[4];
#pragma unroll
        for (int u = 0; u < 4; ++u) {
            const int item = item0 + u, c = item % NCH, dh = item / NCH, d = dh >> 7, hd = dh & 127, rb = hg_chunk_row(c);
            tt[u] = d ? 63 - lane : lane;
            { const float x = DTR[(size_t)(rb + tt[u]) * 256 + d * 128 + hd] + p->in[I_SSMDTB][d * 128 + hd]; dtv[u] = x > 20.f ? x : __logf(1.0f + __expf(x)); }
            gsum[u] = dtv[u] * -__expf(p->in[I_SSMALOG][d * 128 + hd]);
        }
#pragma unroll
        for (int u = 0; u < 4; ++u) {
#pragma unroll
            for (int o = 1; o < 64; o <<= 1) { const float x = __int_as_float(__builtin_amdgcn_ds_bpermute((lane - o) << 2, __float_as_int(gsum[u]))); if (lane >= o) gsum[u] += x; }
            MGV[(size_t)(item0 + u) * 64 + tt[u]] = gsum[u]; MDTC[(size_t)(item0 + u) * 64 + tt[u]] = dtv[u];
        }
    }
}
__device__ __forceinline__ bf16x8 pack8(const float (&v)[8]) {
    u32x4 w; w.x = cvt_pk_bf16_n(v[0], v[1]); w.y = cvt_pk_bf16_n(v[2], v[3]); w.z = cvt_pk_bf16_n(v[4], v[5]); w.w = cvt_pk_bf16_n(v[6], v[7]);
    return __builtin_bit_cast(bf16x8, w);
}
__device__ __forceinline__ void unpack8(bf16x8 x, float (&o)[8]) {
    const u32x4 w = __builtin_bit_cast(u32x4, x);
    o[0] = bf_lo(w.x); o[1] = bf_hi(w.x); o[2] = bf_lo(w.y); o[3] = bf_hi(w.y); o[4] = bf_lo(w.z); o[5] = bf_hi(w.z); o[6] = bf_lo(w.w); o[7] = bf_hi(w.w);
}
struct MsOps { bf16x8 fr[4]; };
struct MsIn  { bf16x8 f[2]; };
constexpr int MS_YT = 34816, MS_DV = 51200, MS_RX = 100352, MS_RXS = 144;
__device__ __forceinline__ void phase_mb_scan(PP p, LAS unsigned char* lds, bool ctx_out) {
    const int tid = mk_tid(), lane = tid & 63, wid = __builtin_amdgcn_readfirstlane(tid >> 6), G = gridDim.x, r16 = lane & 15, q4 = lane >> 4;
    const int tq = wid & 3, ph = wid >> 2;
    const bf16_t* MG = wsp<const bf16_t>(p, MB_G); const bf16_t* MCP = wsp<const bf16_t>(p, MB_CP); const bf16_t* MBT = wsp<const bf16_t>(p, MB_BT); const bf16_t* MXS = wsp<const bf16_t>(p, MB_XS);
    const float* MGV = wsp<const float>(p, MB_GV); const float* MDTC = wsp<const float>(p, MB_DTC); bf16_t* MY = wsp<bf16_t>(p, MB_Y);
    LAS bf16x8* Sx = (LAS bf16x8*)lds;
    LAS float* VX = (LAS float*)(lds + 32768);
    for (int it = mk_bid(); it < 256; it += G) {
        const int g = it & 7, d = (it >> 3) & 1, hd = g * 16 + (it >> 4);
        auto load_ops = [&](int j, MsOps& o) {
            const int c = scan_chunk(j < NCH ? j : NCH - 1, d);
            const size_t gc = (size_t)g * NCH + c;
            const bf16_t* src = wid < 4 ? MCP + gc * 8192 + (size_t)(wid * 4) * 512 : MBT + gc * 8192 + (size_t)((wid - 4) * 4) * 512;
#pragma unroll
            for (int k = 0; k < 4; ++k) o.fr[k] = *(const bf16x8*)(src + (size_t)k * 512 + lane * 8);
        };
        auto load_in = [&](int j, MsIn& v) {
            const int c = scan_chunk(j < NCH ? j : NCH - 1, d);
            const size_t gc = (size_t)g * NCH + c, hc = (size_t)hd * NCH + c;
            const bf16_t* xs0 = MXS + (size_t)(hg_chunk_row(c) + wid * 16 + (lane >> 3)) * 8192 + hd * 64 + (lane & 7) * 8;
            const bf16_t* g0 = MG + gc * 4096 + (size_t)((wid - 4) * 2) * 512 + lane * 8;
#pragma unroll
            for (int ks = 0; ks < 2; ++ks) v.f[ks] = *(const bf16x8*)(wid < 4 ? xs0 + (size_t)ks * 8 * 8192 : g0 + (size_t)ks * 512);
        };
        auto put_x = [&](int rxi, const MsIn& v) {
            if (wid < 4) {
#pragma unroll
                for (int ks = 0; ks < 2; ++ks) *(LAS bf16x8*)(lds + MS_RX + rxi * (64 * MS_RXS) + (wid * 16 + ks * 8 + (lane >> 3)) * MS_RXS + (lane & 7) * 16) = v.f[ks];
            }
        };
        auto derive = [&](int b, const MsIn& v, int vb, int rxi) {
            LAS unsigned char* im = lds + MS_DV + b * 24576;
            LAS const float* gv = VX + vb * 128;
            const float gtot = gv[d ? 0 : 63], gt = gv[((wid - 4) & 3) * 16 + r16];
#pragma unroll
            for (int ks = 0; ks < 2; ++ks) {
                float x[8], gs[8];
                if (wid < 4) {
                    const unsigned ta = (unsigned)(size_t)(lds + MS_RX + rxi * (64 * MS_RXS)) + (unsigned)((ks * 32 + (lane >> 4) * 8 + ((lane & 15) >> 2)) * MS_RXS + (wid * 16 + 4 * (lane & 3)) * 2);
                    s16x4 t0, t1;
                    asm volatile("ds_read_b64_tr_b16 %0, %1" : "=&v"(t0) : "v"(ta) : "memory");
                    asm volatile("ds_read_b64_tr_b16 %0, %1 offset:576" : "=&v"(t1) : "v"(ta) : "memory");
                    asm volatile("s_waitcnt lgkmcnt(0)" ::: "memory");
                    unpack8((bf16x8){t0[0], t0[1], t0[2], t0[3], t1[0], t1[1], t1[2], t1[3]}, x);
                } else unpack8(v.f[ks], x);
                const f32x4 ga = *(LAS const f32x4*)(gv + ks * 32 + 8 * q4), gb = *(LAS const f32x4*)(gv + ks * 32 + 8 * q4 + 4);
#pragma unroll
                for (int jj = 0; jj < 8; ++jj) gs[jj] = jj < 4 ? ga[jj & 3] : gb[jj & 3];
                if (wid < 4) {
                    const f32x4 da = *(LAS const f32x4*)(gv + 64 + ks * 32 + 8 * q4), db = *(LAS const f32x4*)(gv + 64 + ks * 32 + 8 * q4 + 4);
                    float xd[8], xc[8];
#pragma unroll
                    for (int jj = 0; jj < 8; ++jj) { const float dtv = jj < 4 ? da[jj & 3] : db[jj & 3]; xd[jj] = x[jj] * dtv; xc[jj] = xd[jj] * __expf(gtot - gs[jj]); }
                    *(LAS bf16x8*)(im + (wid * 2 + ks) * 1024 + lane * 16) = pack8(xd);
                    *(LAS bf16x8*)(im + (8 + wid * 2 + ks) * 1024 + lane * 16) = pack8(xc);
                } else {
                    const int t = (wid - 4) * 16 + r16; float w[8];
#pragma unroll
                    for (int jj = 0; jj < 8; ++jj) { const int s = ks * 32 + 8 * q4 + jj; const bool keep = d ? (s >= t) : (s <= t); w[jj] = keep ? x[jj] * __expf(gt - gs[jj]) : 0.f; }
                    *(LAS bf16x8*)(im + (16 + (wid - 4) * 2 + ks) * 1024 + lane * 16) = pack8(w);
                }
            }
        };
        auto load_vec = [&](int j) -> float {
            const int c = scan_chunk(j < NCH ? j : NCH - 1, d);
            const size_t dhc = ((size_t)d * 128 + hd) * NCH + c;
            return *(wid == 1 ? MDTC + dhc * 64 + lane : MGV + dhc * 64 + lane);
        };
        f32x4 S[2][4];
#pragma unroll
        for (int a = 0; a < 2; ++a)
#pragma unroll
            for (int b = 0; b < 4; ++b) S[a][b] = (f32x4){0.f, 0.f, 0.f, 0.f};
        MsOps o0, o1; MsIn ia, ib;
        load_in(0, ia); load_in(1, ib); load_ops(0, o0);
        float vnext = 0.f, vn1 = 0.f;
        vnext = load_vec(0); vn1 = load_vec(1);
        __syncthreads();
#pragma unroll
        for (int b = 0; b < 2; ++b) { unsigned zz = 0u; asm volatile("" : "+v"(zz)); ((LAS u32x4*)lds)[((2 * ph + b) * 4 + tq) * 64 + lane] = (u32x4){zz, zz, zz, zz}; }
        if (wid < 2) { VX[wid * 64 + lane] = vnext; VX[128 + wid * 64 + lane] = vn1; }
        put_x(0, ia); put_x(1, ib);
        if (wid < 4) load_in(2, ib);
        __syncthreads();
        derive(0, ia, 0, 0);
        __syncthreads();
        int vcur = 0;
        int buf = 0;
        auto flush_y = [&](int j) {
            const int c = scan_chunk(j, d);
            if (ctx_out || c < 256) {
                const int row = 8 * wid + (lane >> 3), piece = lane & 7;
                const u32x4 v = *(LAS const u32x4*)(lds + MS_YT + (j & 1) * 8192 + row * 128 + piece * 16);
                *(u32x4*)(MY + ((size_t)d * T + hg_chunk_row(c) + row) * 8192 + hd * 64 + piece * 8) = v;
            }
        };
        auto step = [&](int j, const MsOps& u, MsOps& ld, const MsIn& inx, MsIn& inl) {
            load_ops(j + 1, ld);
            load_in(wid < 4 ? j + 3 : j + 2, inl);
            vnext = load_vec(j + 2);
            if (j > 0) flush_y(j - 1);
            const int vn = vcur == 2 ? 0 : vcur + 1, vn2 = vn == 2 ? 0 : vn + 1;
            LAS const float* gv = VX + vcur * 128;
            LAS const unsigned char* im = lds + MS_DV + buf * 24576;
#define MS_FR(fi) (*(LAS const bf16x8*)(im + (fi) * 1024 + lane * 16))
            if (wid < 4) {
                const int tl = wid * 16;
                const f32x4 gr = *(LAS const f32x4*)(gv + tl + 4 * q4);
                const f32x4 eg = {__expf(gr[0]), __expf(gr[1]), __expf(gr[2]), __expf(gr[3])};
                const bf16x8 wA0 = MS_FR(16 + wid * 2), wA1 = MS_FR(16 + wid * 2 + 1);
                bf16x8 sb[4][4], xf[4][2];
#pragma unroll
                for (int pj = 0; pj < 4; ++pj) {
#pragma unroll
                    for (int kk = 0; kk < 4; ++kk) sb[pj][kk] = Sx[((buf * 4 + pj) * 4 + kk) * 64 + lane];
                    xf[pj][0] = MS_FR(pj * 2); xf[pj][1] = MS_FR(pj * 2 + 1);
                }
                __builtin_amdgcn_sched_barrier(0);
                f32x4 acc[4];
#pragma unroll
                for (int pj = 0; pj < 4; ++pj) acc[pj] = (f32x4){0.f, 0.f, 0.f, 0.f};
#pragma unroll
                for (int kk = 0; kk < 4; ++kk)
#pragma unroll
                    for (int pj = 0; pj < 4; ++pj) acc[pj] = __builtin_amdgcn_mfma_f32_16x16x32_bf16(u.fr[kk], sb[pj][kk], acc[pj], 0, 0, 0);
#pragma unroll
                for (int pj = 0; pj < 4; ++pj) acc[pj] = acc[pj] * eg;
#pragma unroll
                for (int pj = 0; pj < 4; ++pj) acc[pj] = __builtin_amdgcn_mfma_f32_16x16x32_bf16(wA0, xf[pj][0], acc[pj], 0, 0, 0);
#pragma unroll
                for (int pj = 0; pj < 4; ++pj) acc[pj] = __builtin_amdgcn_mfma_f32_16x16x32_bf16(wA1, xf[pj][1], acc[pj], 0, 0, 0);
#pragma unroll
                for (int pj = 0; pj < 4; ++pj)
#pragma unroll
                    for (int i = 0; i < 4; ++i) ((LAS bf16_t*)(lds + MS_YT + (j & 1) * 8192))[(tl + 4 * q4 + i) * 64 + pj * 16 + r16] = f2bf_n(acc[pj][i]);
            } else {
                const float Dc = __expf(gv[d ? 0 : 63]);
                bf16x8 xc[4][2];
#pragma unroll
                for (int pj = 0; pj < 4; ++pj) { xc[pj][0] = MS_FR(8 + pj * 2); xc[pj][1] = MS_FR(8 + pj * 2 + 1); }
                __builtin_amdgcn_sched_barrier(0);
#pragma unroll
                for (int pj = 0; pj < 4; ++pj)
#pragma unroll
                    for (int a = 0; a < 2; ++a) S[a][pj] = Dc * S[a][pj];
#pragma unroll
                for (int h2 = 0; h2 < 2; ++h2)
#pragma unroll
                    for (int pj = 0; pj < 4; ++pj)
#pragma unroll
                        for (int a = 0; a < 2; ++a) S[a][pj] = __builtin_amdgcn_mfma_f32_16x16x32_bf16(u.fr[a * 2 + h2], xc[pj][h2], S[a][pj], 0, 0, 0);
            }
#undef MS_FR
            derive(buf ^ 1, inx, vn, (j + 1) & 1);
            put_x(j & 1, inx);
            if (wid >= 4) {
#pragma unroll
                for (int pj = 0; pj < 4; ++pj) {
                    u32x4 sw; sw.x = cvt_pk_bf16_n(S[0][pj][0], S[0][pj][1]); sw.y = cvt_pk_bf16_n(S[0][pj][2], S[0][pj][3]); sw.z = cvt_pk_bf16_n(S[1][pj][0], S[1][pj][1]); sw.w = cvt_pk_bf16_n(S[1][pj][2], S[1][pj][3]);
                    ((LAS u32x4*)lds)[(((buf ^ 1) * 4 + pj) * 4 + (wid - 4)) * 64 + lane] = sw;
                }
            }
            if (wid < 2) VX[vn2 * 128 + wid * 64 + lane] = vnext;
            lds_barrier();
            buf ^= 1; vcur = vn;
        };
#pragma unroll 1
        for (int j = 0; j < NCH; j += 2) { step(j, o0, o1, ib, ia); step(j + 1, o1, o0, ia, ib); }
        flush_y(NCH - 1);
    }
}
struct MrRaw { u32x4 a[2], b[2], x[2], z[2]; };
__device__ __forceinline__ void phase_mb_readout(PP p) {
    const int tid = mk_tid(), lane = tid & 63, wid = __builtin_amdgcn_readfirstlane(tid >> 6), G = gridDim.x, bid = mk_bid();
    const bf16_t* Y0 = wsp<const bf16_t>(p, MB_Y); const bf16_t* Y1 = Y0 + (size_t)T * 8192; const bf16_t* XS = wsp<const bf16_t>(p, MB_XS); const bf16_t* Z = wsp<const bf16_t>(p, MB_Z);
    bf16_t* Y = wsp<bf16_t>(p, WS_YB); const float* ng = p->in[I_SSMNORM]; const float* dsk = p->in[I_SSMD];
    const unsigned c = (unsigned)(wid & 7) * 1024u + (unsigned)lane * 8u;
    f32x4 n[2][2]; float dk[2];
#pragma unroll
    for (int i = 0; i < 2; ++i) { n[i][0] = *(const f32x4*)(ng + c + i * 512u); n[i][1] = *(const f32x4*)(ng + c + i * 512u + 4u); dk[i] = dsk[(c + i * 512u) >> 6]; }
    auto load = [&](int i, MrRaw& w) {
        const int r = bid + i * G; const size_t ro = (size_t)(r < T ? r : T - 1) * 8192;
#pragma unroll
        for (int h = 0; h < 2; ++h) { w.a[h] = *(const u32x4*)(Y0 + ro + c + h * 512u); w.b[h] = *(const u32x4*)(Y1 + ro + c + h * 512u); w.x[h] = *(const u32x4*)(XS + ro + c + h * 512u); w.z[h] = *(const u32x4*)(Z + ro + c + h * 512u); }
    };
    auto process = [&](int i, const MrRaw& w) {
        int r = bid + i * G;
        asm volatile("" : "+s"(r));
        float v[2][8]; float ss = 0.f;
#pragma unroll
        for (int h = 0; h < 2; ++h) {
            float a[8], b[8], x[8], z[8]; unpack8u(w.a[h], a); unpack8u(w.b[h], b); unpack8u(w.x[h], x); unpack8u(w.z[h], z);
#pragma unroll
            for (int e = 0; e < 8; ++e) { const float y = (a[e] + b[e] + dk[h] * x[e]) * siluf_(z[e]); v[h][e] = y; ss += y * y; }
        }
        const float rs = rsqrtf(wave_sum(ss) * (1.0f / 1024.0f) + RMS_EPS);
        if (r < T) {
#pragma unroll
            for (int h = 0; h < 2; ++h) {
                f32x4 o0, o1;
#pragma unroll
                for (int e = 0; e < 4; ++e) { o0[e] = v[h][e] * rs * n[h][0][e]; o1[e] = v[h][4 + e] * rs * n[h][1][e]; }
                st_bf16x8(Y + (size_t)r * 8192 + c + h * 512u, o0, o1);
            }
        }
    };
    const int nmine = bid < T ? (T - bid + G - 1) / G : 0;
    MrRaw ra, rb, rc;
    load(0, ra); load(1, rb);
#pragma unroll 1
    for (int i = 0; i < nmine; i += 3) {
        load(i + 2, rc); process(i, ra);
        load(i + 3, ra); process(i + 1, rb);
        load(i + 4, rb); process(i + 2, rc);
    }
}

struct QkRaw { u32x4 x[10]; f32x2 cs[4]; };
__device__ __forceinline__ void phase_at_qknorm(PP p) {
    const int tid = mk_tid(), lane = tid & 63, wid = __builtin_amdgcn_readfirstlane(tid >> 6), G = gridDim.x, bid = mk_bid();
    const int sub = lane >> 4, l16 = lane & 15;
    bf16_t* Qb = wsp<bf16_t>(p, AT_Q); bf16_t* Kb = wsp<bf16_t>(p, AT_K);
    const float* rope = wsp<const float>(p, WS_ROPE);
    float gq[8], gk[8];
#pragma unroll
    for (int e = 0; e < 8; ++e) { gq[e] = p->in[I_ATQN][l16 * 8 + e]; gk[e] = p->in[I_ATKN][l16 * 8 + e]; }
    auto piece_ptr = [&](int r, int it) -> bf16_t* {
        return it < 8 ? Qb + (size_t)r * 4096 + (it * 4 + sub) * 128 + l16 * 8 : Kb + (size_t)r * 1024 + ((it - 8) * 4 + sub) * 128 + l16 * 8;
    };
    auto one = [&](u32x4 raw, bool isq, const float (&cs)[4], const float (&sn)[4], bf16_t* ptr) {
        float x[8]; unpack8u(raw, x);
        float ss = 0.f;
#pragma unroll
        for (int e = 0; e < 8; ++e) ss += x[e] * x[e];
        ss = row16_all(ss, OpSum());
        const float rs = rsqrtf(ss * (1.0f / 128.0f) + RMS_EPS);
        float y[8], o[8];
#pragma unroll
        for (int e = 0; e < 8; ++e) y[e] = x[e] * rs * (isq ? gq[e] : gk[e]);
#pragma unroll
        for (int e2 = 0; e2 < 4; ++e2) { o[2 * e2] = y[2 * e2] * cs[e2] - y[2 * e2 + 1] * sn[e2]; o[2 * e2 + 1] = y[2 * e2] * sn[e2] + y[2 * e2 + 1] * cs[e2]; }
        u32x4 w; w.x = cvt_pk_bf16(o[0], o[1]); w.y = cvt_pk_bf16(o[2], o[3]); w.z = cvt_pk_bf16(o[4], o[5]); w.w = cvt_pk_bf16(o[6], o[7]);
        *(u32x4*)ptr = w;
    };
    const int rw0 = bid * 8 + wid, nmine = rw0 < TL ? (TL - rw0 + G * 8 - 1) / (G * 8) : 0;
    auto load = [&](int i, QkRaw& w) {
        int r = rw0 + i * G * 8; r = r < TL ? r : TL - 1;
#pragma unroll
        for (int it = 0; it < 10; ++it) w.x[it] = *(const u32x4*)piece_ptr(r, it);
        const int pos = (l16 < 8) ? (r >> 6) : (r & 63);
#pragma unroll
        for (int e2 = 0; e2 < 4; ++e2) w.cs[e2] = *(const f32x2*)(rope + (size_t)(pos * 32 + ((l16 * 4 + e2) & 31)) * 2);
    };
    auto process = [&](int i, const QkRaw& w) {
        int r = rw0 + i * G * 8;
        asm volatile("" : "+s"(r));
        if (r < TL) {
            float cs[4], sn[4];
#pragma unroll
            for (int e2 = 0; e2 < 4; ++e2) { cs[e2] = w.cs[e2][0]; sn[e2] = w.cs[e2][1]; }
#pragma unroll
            for (int it = 0; it < 10; ++it) one(w.x[it], it < 8, cs, sn, piece_ptr(r, it));
        }
    };
    {
        QkRaw ra;
#pragma unroll 1
        for (int i = 0; i < nmine; ++i) { load(i, ra); process(i, ra); }
    }
    {
        const float cs[4] = {1.f, 1.f, 1.f, 1.f}, sn[4] = {0.f, 0.f, 0.f, 0.f};
        static_assert(pg8::TailOrder::pick_sk(AT_PROJ / 256, D / 64) == 8, "q/k norm sums 8 context partial sums");
        const bf16_t* part = wsp<const bf16_t>(p, WS_PART); bf16_t* Vb = wsp<bf16_t>(p, AT_V);
        auto sum8 = [&](int rr, int col) -> u32x4 {
            u32x4 pw[8];
#pragma unroll
            for (int s = 0; s < 8; ++s) pw[s] = *(const u32x4*)(part + ((size_t)(s * 256 + rr)) * AT_PROJ + col);
            f32x4 a = {0.f, 0.f, 0.f, 0.f}, b = a;
#pragma unroll
            for (int s = 0; s < 8; ++s) { a += (f32x4){bf_lo(pw[s].x), bf_hi(pw[s].x), bf_lo(pw[s].y), bf_hi(pw[s].y)}; b += (f32x4){bf_lo(pw[s].z), bf_hi(pw[s].z), bf_lo(pw[s].w), bf_hi(pw[s].w)}; }
            u32x4 o; o.x = cvt_pk_bf16(a[0], a[1]); o.y = cvt_pk_bf16(a[2], a[3]); o.z = cvt_pk_bf16(b[0], b[1]); o.w = cvt_pk_bf16(b[2], b[3]); return o;
        };
        for (int rr = bid; rr < TC; rr += G) {
            const int r = TL + rr;
            bf16_t* pq = piece_ptr(r, wid); bf16_t* pk = piece_ptr(r, 8 + (wid & 1));
            const u32x4 xq = sum8(rr, (wid * 4 + sub) * 128 + l16 * 8);
            const int c2 = wid < 2 ? 4096 + ((wid & 1) * 4 + sub) * 128 + l16 * 8 : 5120 + (((wid - 2) & 1) * 64 + lane) * 8;
            const u32x4 x2 = sum8(rr, c2);
            if (wid < 2) one(x2, false, cs, sn, pk);
            else if (wid < 4) *(u32x4*)(Vb + (size_t)r * 1024 + ((wid - 2) * 64 + lane) * 8) = x2;
            one(xq, true, cs, sn, pq);
        }
    }
}
__device__ __forceinline__ void phase_attention(PP p, unsigned char* lds, bool ctx_out) {
    const int G = gridDim.x, b = mk_bid();
    const bf16_t* Qb = wsp<const bf16_t>(p, AT_Q); const bf16_t* Kb = wsp<const bf16_t>(p, AT_K); const bf16_t* Vb = wsp<const bf16_t>(p, AT_V);
    bf16_t* Y = wsp<bf16_t>(p, WS_YB);
    const int nit = ctx_out ? 2048 + 32 : 2048;
    for (int idx = b; idx < nit; idx += G) {
        int hq, row0, krow0, seq;
        if (idx < 2048) { const int kvh = idx & 7, li = idx >> 3; hq = kvh * 4 + (li >> 6); row0 = (li & 63) * 256; krow0 = 0; seq = T; }
        else { hq = idx - 2048; row0 = TL; krow0 = TL; seq = TC; }
        const int kvh = hq >> 2;
        att::attn_dense_body<bf16_t>(Qb + (size_t)row0 * 4096 + hq * 128, Kb + (size_t)krow0 * 1024 + kvh * 128, Vb + (size_t)krow0 * 1024 + kvh * 128,
                                     Y + (size_t)row0 * 4096 + hq * 128, seq, (char*)lds);
        __syncthreads();
    }
}
constexpr int N_PHASE = 3 + 16 * DEPTH;
__global__ void __launch_bounds__(NT, 2) mk_fwd(Params p_unused) {
    extern __shared__ __attribute__((aligned(16))) unsigned char lds[];
    LAS unsigned char* ldsl = (LAS unsigned char*)lds;
    ((LAS int*)(ldsl + LDS_WMAP))[mk_hwslot()] = (int)(threadIdx.x >> 6);
#if !MK_MULTI
    if (threadIdx.x < 4) ((LAS unsigned*)(ldsl + LDS_XB))[threadIdx.x] = 0u;
#endif
    __syncthreads();
#if !MK_MULTI
    XcdBarrier bar = xcd_barrier_post(wsp<unsigned>((PP)__builtin_amdgcn_kernarg_segment_ptr(), WS_CTL), (volatile LAS unsigned*)(ldsl + LDS_XB));
#endif
    PP kp = (PP)__builtin_amdgcn_kernarg_segment_ptr();
    const int lo = kp->ph_lo, hi = kp->ph_hi;
#ifndef MK_PROBE
#define MK_PROBE 0
#endif
#define REPS(t) ((MK_PROBE == 1 && ((t) == 3 || (t) == 8 || (t) == 9 || (t) == 12 || (t) == 13 || (t) == 19 || (t) == 21 || (t) == 23)) || (MK_PROBE == 2 && (t) == 11) || \
                 (MK_PROBE == 4 && (t) == 0) || (MK_PROBE == 5 && (t) == 4) || (MK_PROBE == 6 && (t) == 6) || (MK_PROBE == 7 && ((t) == 15 || (t) == 17)) || \
                 (MK_PROBE == 8 && ((t) == 7 || (t) == 18 || (t) == 22 || (t) == 14)) || (MK_PROBE == 9 && (t) == 15) || (MK_PROBE == 10 && (t) == 18) || (MK_PROBE == 11 && (t) == 7) || (MK_PROBE == 12 && (t) == 22) || (MK_PROBE == 13 && (t) == 14) || (MK_PROBE == 14 && (t) == 10) || (MK_PROBE == 15 && (t) == 17) || (MK_PROBE == 16 && ((t) == 20 || (t) == 24) && 0) ? 2 : 1)
#ifdef MK_ONLY
#define TAGON(t) ((t) == MK_ONLY)
#else
#define TAGON(t) true
#endif
#if MK_MULTI
#define PHASE(tag, id, body) do { if (TAGON(tag)) if (lo <= (id) && (id) < hi) { PP p = launder(kp); body; } } while (0)
#else
#define PHASE(tag, id, body) do { if (TAGON(tag)) if (lo <= (id) && (id) < hi) { for (int rep_ = 0; rep_ < REPS(tag); ++rep_) { { PP p = launder(kp); body; } if ((id) + 1 < hi) { xcd_barrier(bar); } } } } while (0)
#endif
    PHASE(0, 0, phase_prologue1(p, ldsl));
    PHASE(1, 1, phase_modreduce(p));
    PHASE(2, 2, phase_mod0(p));
#pragma unroll 1
    for (int l = 0; l < DEPTH; ++l) {
        const int kind = l % 3, j = l / 3, pb = 3 + 16 * l;
        const bool ctx_out = l < DEPTH - 1;
        const int Mo = ctx_out ? T : TL;
        if (kind == 0) {
#define F_HGIN FHgIn{wsp<bf16_t>(p, HG_QB), wsp<float>(p, HG_LF), wsp<bf16_t>(p, HG_KB), wsp<bf16_t>(p, HG_V), wsp<bf16_t>(p, HG_SG), wsp<const float>(p, WS_LB) + j * 2048}
            PHASE(3, pb + 0, run_gemm(p, ldsl, wsp<const bf16_t>(p, WS_H), wsp<const bf16_t>(p, WS_HGIN + j * SZ_HGIN), T, HG_PROJ, D, F_HGIN));
            PHASE(25, pb + 1, run_ctx_reduce(p, HG_PROJ, D, F_HGIN));
            PHASE(4, pb + 2, phase_hg_prep(p, ldsl));
            PHASE(6, pb + 4, phase_hg_scan(p, ldsl, ctx_out));
            PHASE(7, pb + 6, phase_hg_readout(p, ldsl, j, ctx_out));
            PHASE(8, pb + 7, run_gemm(p, ldsl, wsp<const bf16_t>(p, WS_YB), wsp<const bf16_t>(p, WS_HGOUT + j * SZ_SQ), Mo, D, D, FBf16{wsp<bf16_t>(p, WS_OB), D}));
        } else if (kind == 1) {
#define F_ATIN FAtIn{wsp<bf16_t>(p, AT_Q), wsp<bf16_t>(p, AT_K), wsp<bf16_t>(p, AT_V)}
            PHASE(9, pb + 0, run_gemm(p, ldsl, wsp<const bf16_t>(p, WS_H), wsp<const bf16_t>(p, WS_ATQKV), T, AT_PROJ, D, F_ATIN));
            PHASE(10, pb + 2, phase_at_qknorm(p));
            PHASE(11, pb + 3, phase_attention(p, lds, ctx_out));
            PHASE(12, pb + 7, run_gemm(p, ldsl, wsp<const bf16_t>(p, WS_YB), wsp<const bf16_t>(p, WS_ATOUT), Mo, D, D, FBf16{wsp<bf16_t>(p, WS_OB), D}));
        } else {
#define F_MBIN FMbIn{wsp<bf16_t>(p, MB_Z), wsp<bf16_t>(p, MB_XBC), wsp<float>(p, MB_DT)}
            PHASE(13, pb + 0, run_gemm(p, ldsl, wsp<const bf16_t>(p, WS_H), wsp<const bf16_t>(p, WS_SSMIN), T, SSM_PROJ, D, F_MBIN));
            PHASE(27, pb + 1, run_ctx_reduce(p, SSM_PROJ, D, F_MBIN));
            PHASE(15, pb + 3, phase_mb_prep(p, ldsl));
            PHASE(17, pb + 5, phase_mb_scan(p, ldsl, ctx_out));
            PHASE(18, pb + 6, phase_mb_readout(p));
            PHASE(19, pb + 7, run_gemm(p, ldsl, wsp<const bf16_t>(p, WS_YB), wsp<const bf16_t>(p, WS_SSMOUT), Mo, D, 8192, FBf16{wsp<bf16_t>(p, WS_OB), D}));
        }
        static_assert(pg8::TailOrder::pick_sk(D / 256, D / 64) == 16 && pg8::TailOrder::pick_sk(D / 256, 8192 / 64) == 16, "phase_ln sums 16 context partial sums");
        PHASE(20, pb + 9, phase_ln(p, ldsl, l, 0));
        PHASE(21, pb + 10, run_gemm_gu(p, ldsl, l, Mo));
        PHASE(22, pb + 12, phase_ffn_fix(p, l, ctx_out));
        PHASE(23, pb + 13, run_gemm(p, ldsl, wsp<const bf16_t>(p, WS_HID), wsp<const bf16_t>(p, WS_FD + l * SZ_SQ), Mo, D, D, FBf16{wsp<bf16_t>(p, WS_OB), D}));
        PHASE(24, pb + 15, phase_ln(p, ldsl, l, 1));
    }
#undef PHASE
}

static bool phase_used_host(int id) {
    if (id < 3) return true;
    const int l = (id - 3) >> 4, k = (id - 3) & 15, kind = l % 3; const bool ctx_out = l < DEPTH - 1;
    if (k == 11) return false;
    if (k == 8 || k == 14) return false;
    if (kind == 0) return !(k == 3 || k == 5);
    if (kind == 1) return !(k == 1 || k == 4 || k == 5 || k == 6);
    return !(k == 2 || k == 4);
}
extern "C" void kernel_launch(void* const* d_in, const int* in_sizes, int n_in, void* d_out, int out_size, void* d_ws, size_t ws_size, hipStream_t stream) {
    static int grid = 0;
    if (grid == 0) {
        if (n_in != 29 || out_size != TL * D || ws_size < WS_END) { fprintf(stderr, "kernel_launch: expected 29 inputs, %d outputs, >= %zu bytes of workspace; got %d, %d, %zu\n", TL * D, (size_t)WS_END, n_in, out_size, ws_size); grid = -1; return; }
        int dev = 0, cus = 0, per_cu = 0;
        if (hipGetDevice(&dev) != hipSuccess || hipDeviceGetAttribute(&cus, hipDeviceAttributeMultiprocessorCount, dev) != hipSuccess) { grid = -1; return; }
        if (hipFuncSetAttribute((const void*)mk_fwd, hipFuncAttributeMaxDynamicSharedMemorySize, LDS_BYTES) != hipSuccess) { fprintf(stderr, "kernel_launch: hipFuncSetAttribute failed\n"); grid = -1; return; }
        if (hipOccupancyMaxActiveBlocksPerMultiprocessor(&per_cu, (const void*)mk_fwd, NT, LDS_BYTES) != hipSuccess || per_cu < 1) { fprintf(stderr, "kernel_launch: occupancy query reports %d\n", per_cu); (void)hipGetLastError(); }
        grid = cus;
    }
    if (grid < 0) return;
    Params p{};
    for (int i = 0; i < 29; ++i) p.in[i] = (const float*)d_in[i];
    p.out = (float*)d_out; p.ws = (unsigned char*)d_ws;
#if MK_MULTI
    for (int id = 0; id < N_PHASE; ++id) {
        if (!phase_used_host(id)) continue;
        p.ph_lo = id; p.ph_hi = id + 1;
        hipLaunchKernelGGL(mk_fwd, dim3(grid), dim3(NT), LDS_BYTES, stream, p);
    }
#else
    (void)hipMemsetAsync((char*)d_ws + WS_CTL, 0, 65536, stream);
    p.ph_lo = 0; p.ph_hi = N_PHASE;
    hipLaunchKernelGGL(mk_fwd, dim3(grid), dim3(NT), LDS_BYTES, stream, p);
#endif
    const hipError_t le = hipPeekAtLastError();
    if (le != hipSuccess) fprintf(stderr, "kernel_launch: launch failed: %s\n", hipGetErrorName(le));
}
```

```cpp
#include <hip/hip_runtime.h>
#include <cstdio>
#include <cstdint>

#define LAS __attribute__((address_space(3)))
typedef unsigned short bf16_t;
typedef short bf16x8 __attribute__((ext_vector_type(8)));
typedef short s16x4 __attribute__((ext_vector_type(4)));
typedef float f32x2 __attribute__((ext_vector_type(2)));
typedef float f32x4 __attribute__((ext_vector_type(4)));
typedef float f32x8 __attribute__((ext_vector_type(8)));
typedef float f32x16 __attribute__((ext_vector_type(16)));
typedef unsigned u32x2 __attribute__((ext_vector_type(2)));
typedef unsigned u32x4 __attribute__((ext_vector_type(4)));

#ifndef MK_MULTI
#define MK_MULTI 0
#define MK_PROBE 0
#endif

constexpr int D = 4096, TL = 16384, TC = 256, T = TL + TC, DEPTH = 4, NT = 512;
constexpr float ALPHA = 1.6817928305074292f;
constexpr float LN_EPS = 1e-6f, RMS_EPS = 1e-6f;
constexpr int HG_PROJ = 14336, AT_PROJ = 6144, SSM_PROJ = 18688, MODN = 6 * D;
constexpr int SKMAX = 16;

constexpr size_t al256(size_t x) { return (x + 255) & ~(size_t)255; }
constexpr size_t WS_CTL   = 0;
constexpr size_t WS_MODP  = 65536;
constexpr size_t WS_MODV  = WS_MODP + (size_t)32 * 4 * 2 * MODN * 4;
constexpr size_t WS_ROPE  = WS_MODV + (size_t)4 * 2 * MODN * 4;
constexpr size_t WS_LB    = WS_ROPE + (size_t)256 * 32 * 2 * 4;
constexpr size_t WS_W     = al256(WS_LB + (size_t)3 * 2 * 2 * 2048 * 4);
constexpr size_t SZ_HGIN = (size_t)HG_PROJ * D * 2, SZ_SQ = (size_t)D * D * 2, SZ_ATQKV = (size_t)AT_PROJ * D * 2, SZ_SSMIN = (size_t)SSM_PROJ * D * 2, SZ_SSMOUT = (size_t)D * 8192 * 2, SZ_GU = (size_t)8192 * D * 2;
constexpr size_t WS_HGIN  = WS_W;
constexpr size_t WS_HGOUT = WS_HGIN + 2 * SZ_HGIN;
constexpr size_t WS_ATQKV = WS_HGOUT + 2 * SZ_SQ;
constexpr size_t WS_ATOUT = WS_ATQKV + SZ_ATQKV;
constexpr size_t WS_SSMIN = WS_ATOUT + SZ_SQ;
constexpr size_t WS_SSMOUT = WS_SSMIN + SZ_SSMIN;
constexpr size_t WS_GU    = WS_SSMOUT + SZ_SSMOUT;
constexpr size_t WS_FD    = WS_GU + 4 * SZ_GU;
constexpr size_t WS_ACT   = WS_FD + 4 * SZ_SQ;
constexpr size_t WS_X     = WS_ACT;
constexpr size_t WS_H     = WS_X + (size_t)T * D * 4;
constexpr size_t WS_YB    = WS_H + (size_t)T * D * 2;
constexpr size_t WS_OB    = WS_YB + (size_t)T * 8192 * 2;
constexpr size_t WS_AU    = WS_OB + (size_t)T * D * 2;
constexpr size_t WS_HID   = WS_AU + (size_t)T * 8192 * 2;
constexpr size_t WS_PART  = WS_HID + (size_t)T * D * 2;
constexpr size_t WS_EDGE  = WS_PART + (size_t)68 * 1024 * 1024;
constexpr size_t WS_MIX   = WS_EDGE + (size_t)65 * 6 * 4096 * 4;
constexpr int NCH = 260;
constexpr size_t HG_QB  = WS_MIX;
constexpr size_t HG_LF  = HG_QB + (size_t)T * 2048 * 2;
constexpr size_t HG_KB  = HG_LF + (size_t)2 * T * 2048 * 4;
constexpr size_t HG_V   = HG_KB + (size_t)2 * T * 2048 * 2;
constexpr size_t HG_SG  = HG_V + (size_t)T * D * 2;
constexpr size_t HG_O   = HG_SG + (size_t)T * D * 2;
constexpr size_t HG_A   = HG_O + (size_t)2 * T * D * 2;
constexpr size_t HG_QT  = HG_A + (size_t)32 * NCH * 64 * 64 * 2;
constexpr size_t HG_KT  = HG_QT + (size_t)32 * NCH * 64 * 128 * 2;
constexpr size_t HG_D   = HG_KT + (size_t)32 * NCH * 64 * 128 * 2;
constexpr size_t HG_VT  = HG_D + (size_t)32 * NCH * 128 * 4;
constexpr size_t HG_END = HG_VT + (size_t)16 * NCH * 256 * 64 * 2;
constexpr size_t AT_Q   = WS_MIX;
constexpr size_t AT_K   = AT_Q + (size_t)T * D * 2;
constexpr size_t AT_V   = AT_K + (size_t)T * 1024 * 2;
constexpr size_t AT_END = AT_V + (size_t)T * 1024 * 2;
constexpr size_t MB_Z   = WS_MIX;
constexpr size_t MB_XBC = MB_Z + (size_t)T * 8192 * 2;
constexpr size_t MB_DT  = MB_XBC + (size_t)T * 10240 * 2;
constexpr size_t MB_XS  = MB_DT + (size_t)T * 256 * 4;
constexpr size_t MB_BB  = MB_XS + (size_t)T * 8192 * 2;
constexpr size_t MB_CB  = MB_BB + (size_t)T * 1024 * 2;
constexpr size_t MB_DTV = MB_CB + (size_t)T * 1024 * 2;
constexpr size_t MB_Y   = MB_DTV + (size_t)2 * T * 128 * 4;
constexpr size_t MB_G   = MB_Y + (size_t)2 * T * 8192 * 2;
constexpr size_t MB_CP  = MB_G + (size_t)8 * NCH * 64 * 64 * 2;
constexpr size_t MB_BT  = MB_CP + (size_t)8 * NCH * 64 * 128 * 2;
constexpr size_t MB_XT  = MB_BT + (size_t)8 * NCH * 64 * 128 * 2;
constexpr size_t MB_GV  = MB_XT + (size_t)128 * NCH * 64 * 64 * 2;
constexpr size_t MB_DTC = MB_GV + (size_t)256 * NCH * 64 * 4;
constexpr size_t MB_END = MB_DTC + (size_t)256 * NCH * 64 * 4;
constexpr size_t WS_END = (MB_END > HG_END ? (MB_END > AT_END ? MB_END : AT_END) : (HG_END > AT_END ? HG_END : AT_END));

constexpr int LDS_MAIN = 131072, LDS_HALO = LDS_MAIN, LDS_XB = 162816, LDS_WMAP = LDS_XB + 256, LDS_BYTES = LDS_WMAP + 256;

__device__ __forceinline__ unsigned cvt_pk_bf16(float lo, float hi) { unsigned r; asm volatile("v_cvt_pk_bf16_f32 %0, %1, %2" : "=v"(r) : "v"(lo), "v"(hi)); return r; }
typedef __bf16 bf16v2_t __attribute__((ext_vector_type(2)));
__device__ __forceinline__ unsigned cvt_pk_bf16_n(float lo, float hi) { const bf16v2_t v = __builtin_convertvector((f32x2){lo, hi}, bf16v2_t); return __builtin_bit_cast(unsigned, v); }
__device__ __forceinline__ float bf_lo(unsigned w) { return __uint_as_float(w << 16); }
__device__ __forceinline__ float bf_hi(unsigned w) { return __uint_as_float(w & 0xffff0000u); }
__device__ __forceinline__ float bf1(bf16_t b) { return __uint_as_float(((unsigned)b) << 16); }
__device__ __forceinline__ bf16_t f2bf(float f) { return (bf16_t)(cvt_pk_bf16(f, 0.f) & 0xffffu); }
__device__ __forceinline__ bf16_t f2bf_n(float f) { return (bf16_t)(cvt_pk_bf16_n(f, 0.f) & 0xffffu); }
__device__ __forceinline__ float sigmoidf_(float x) { return 1.0f / (1.0f + __expf(-x)); }
__device__ __forceinline__ float siluf_(float x) { return x / (1.0f + __expf(-x)); }
template <int CTRL> __device__ __forceinline__ float dpp_mov(float v) { return __int_as_float(__builtin_amdgcn_update_dpp(0, __float_as_int(v), CTRL, 0xF, 0xF, false)); }
__device__ __forceinline__ float xch16(float v, int lane) { const auto r = __builtin_amdgcn_permlane16_swap(__float_as_uint(v), __float_as_uint(v), false, false); return __uint_as_float((lane & 16) ? r[0] : r[1]); }
__device__ __forceinline__ float xch32(float v, int lane) { const auto r = __builtin_amdgcn_permlane32_swap(__float_as_uint(v), __float_as_uint(v), false, false); return __uint_as_float((lane & 32) ? r[0] : r[1]); }
struct OpSum { __device__ __forceinline__ float operator()(float a, float b) const { return a + b; } };
struct OpMax { __device__ __forceinline__ float operator()(float a, float b) const { return fmaxf(a, b); } };
template <class Op> __device__ __forceinline__ float row16_all(float v, Op op) {
    v = op(v, dpp_mov<0xB1>(v)); v = op(v, dpp_mov<0x4E>(v)); v = op(v, dpp_mov<0x141>(v)); v = op(v, dpp_mov<0x140>(v));
    return v;
}
template <class Op> __device__ __forceinline__ float wave_all(float v, Op op) {
    v = row16_all(v, op);
    { const auto r = __builtin_amdgcn_permlane16_swap(__float_as_uint(v), __float_as_uint(v), false, false); v = op(__uint_as_float(r[0]), __uint_as_float(r[1])); }
    { const auto r = __builtin_amdgcn_permlane32_swap(__float_as_uint(v), __float_as_uint(v), false, false); v = op(__uint_as_float(r[0]), __uint_as_float(r[1])); }
    return v;
}
__device__ __forceinline__ float wave_sum(float v) { return wave_all(v, OpSum()); }
__device__ __forceinline__ float wave_max(float v) { return wave_all(v, OpMax()); }
__device__ __forceinline__ unsigned mk_hwslot() { return (unsigned)__builtin_amdgcn_s_getreg((5 << 11) | 4) & 63u; }
__device__ __forceinline__ int mk_tid() {
    extern __shared__ __attribute__((aligned(16))) unsigned char mk_lds_[];
    const int w = __builtin_amdgcn_readfirstlane(((const LAS int*)((LAS unsigned char*)mk_lds_ + LDS_WMAP))[mk_hwslot()]);
    int l; asm volatile("v_mbcnt_lo_u32_b32 %0, -1, 0\n\tv_mbcnt_hi_u32_b32 %0, -1, %0" : "=v"(l));
    return w * 64 + l;
}
__device__ __forceinline__ int mk_bid() { int b = blockIdx.x; asm volatile("" : "+v"(b)); return __builtin_amdgcn_readfirstlane(b); }
__device__ __forceinline__ void lds_barrier() { asm volatile("s_waitcnt lgkmcnt(0)\n\ts_barrier" ::: "memory"); }
__device__ __forceinline__ void ld8bf(const bf16_t* p, float (&o)[8]) { const u32x4 w = *(const u32x4*)p; o[0] = bf_lo(w.x); o[1] = bf_hi(w.x); o[2] = bf_lo(w.y); o[3] = bf_hi(w.y); o[4] = bf_lo(w.z); o[5] = bf_hi(w.z); o[6] = bf_lo(w.w); o[7] = bf_hi(w.w); }
__device__ __forceinline__ void st_bf16x8(bf16_t* p, f32x4 v0, f32x4 v1) {
    u32x4 w; w.x = cvt_pk_bf16(v0[0], v0[1]); w.y = cvt_pk_bf16(v0[2], v0[3]); w.z = cvt_pk_bf16(v1[0], v1[1]); w.w = cvt_pk_bf16(v1[2], v1[3]);
    *(u32x4*)p = w;
}
__device__ __forceinline__ void st_bf16x8_n(bf16_t* p, f32x4 v0, f32x4 v1) {
    u32x4 w; w.x = cvt_pk_bf16_n(v0[0], v0[1]); w.y = cvt_pk_bf16_n(v0[2], v0[3]); w.z = cvt_pk_bf16_n(v1[0], v1[1]); w.w = cvt_pk_bf16_n(v1[2], v1[3]);
    *(u32x4*)p = w;
}
#define XB_TMO      128
#define XB_XCNT(j)  (256  + 64 * (j))
#define XB_XSUB(j)  (1280 + 64 * (j))
#define XB_XGEN(j)  (2304 + 64 * (j))
#define XB_TOP      3328
#define XB_TOPGEN   3392
#define XCD_BAR_WORDS 3456
#define XB_SPIN_CAP (1u << 22)

__device__ __forceinline__ unsigned xb_ld(unsigned* p)              { return __hip_atomic_load(p, __ATOMIC_RELAXED, __HIP_MEMORY_SCOPE_AGENT); }
__device__ __forceinline__ unsigned xb_add(unsigned* p, unsigned v) { return __hip_atomic_fetch_add(p, v, __ATOMIC_RELAXED, __HIP_MEMORY_SCOPE_AGENT); }
__device__ __forceinline__ unsigned xb_xcc_id() { return (unsigned)__builtin_amdgcn_s_getreg((3 << 11) | 20) & 0xFu; }
#define XB_SPIN(cond, bar) do { unsigned _sp = 0; while (cond) { __builtin_amdgcn_s_sleep(1); \
    if ((++_sp & 255u) == 0u) { if (xb_ld(&(bar)[XB_TMO])) break; if (_sp > XB_SPIN_CAP) { atomicAdd(&(bar)[XB_TMO], 1u); break; } } } } while (0)

struct XcdBarrier {
    unsigned* bar; unsigned x;
    volatile LAS unsigned* st;
};

__device__ __forceinline__ XcdBarrier xcd_barrier_post(unsigned* bar, volatile LAS unsigned* st) {
    XcdBarrier b; b.bar = bar; b.x = xb_xcc_id(); b.st = st;
    if (mk_tid() == 0) (void)xb_add(&bar[XB_XCNT(b.x)], 1u);
    return b;
}
__device__ __forceinline__ void xcd_barrier_complete(unsigned* bar, unsigned x, unsigned& nloc, unsigned& nx) {
    const unsigned G = gridDim.x * gridDim.y * gridDim.z;
    unsigned sum, cnt, mine, sp = 0u;
    for (;;) {
        sum = 0u; cnt = 0u; mine = 0u;
#pragma unroll
        for (unsigned j = 0; j < 16; ++j) { const unsigned c = xb_ld(&bar[XB_XCNT(j)]); sum += c; cnt += (c > 0u) ? 1u : 0u; mine = (j == x) ? c : mine; }
        if (sum == G) break;
        __builtin_amdgcn_s_sleep(1);
        if ((++sp & 255u) == 0u) { if (xb_ld(&bar[XB_TMO])) break; if (sp > XB_SPIN_CAP) { atomicAdd(&bar[XB_TMO], 1u); break; } }
    }
    nloc = mine > 0u ? mine : 1u; nx = cnt > 0u ? cnt : 1u;
}

__device__ __forceinline__ void xcd_barrier(const XcdBarrier& b) {
    asm volatile("s_waitcnt vmcnt(0)" ::: "memory");
    __syncthreads();
    if (mk_tid() == 0) {
        unsigned* bar = b.bar;
        __builtin_amdgcn_s_waitcnt(0);
        unsigned nloc = b.st[0], nx = b.st[1];
        if (nloc == 0u) { xcd_barrier_complete(bar, b.x, nloc, nx); b.st[0] = nloc; b.st[1] = nx; }
        const unsigned old = xb_add(&bar[XB_XSUB(b.x)], 1u);
        const unsigned gen = old / nloc;
        if (old + 1u == (gen + 1u) * nloc) {
            __builtin_amdgcn_fence(__ATOMIC_RELEASE, "agent");
            asm volatile("s_waitcnt vmcnt(0)" ::: "memory");
            const unsigned og = xb_add(&bar[XB_TOP], 1u);
            const unsigned tg = og / nx;
            if (og + 1u == (tg + 1u) * nx) xb_add(&bar[XB_TOPGEN], 1u);
            else XB_SPIN(xb_ld(&bar[XB_TOPGEN]) == tg, bar);
            __builtin_amdgcn_fence(__ATOMIC_ACQUIRE, "agent");
            xb_add(&bar[XB_XGEN(b.x)], 1u);
            asm volatile("s_waitcnt vmcnt(0)" ::: "memory");
        } else {
            XB_SPIN(xb_ld(&bar[XB_XGEN(b.x)]) == gen, bar);
            __builtin_amdgcn_fence(__ATOMIC_ACQUIRE, "agent");
            asm volatile("s_waitcnt vmcnt(0)" ::: "memory");
        }
    }
    __syncthreads();
}
namespace pg8 {
#define PG8_LAS __attribute__((address_space(3)))
constexpr int BM = 256, BK = 64, HALF = 128, HTB = HALF * BK * 2  , STAGE_BYTES = 8 * HTB, NXCD = 8, WGM = 8;

__host__ __device__ __forceinline__ int lds_byte(int r, int c) { const int st = (r >> 4) * 2 + (c >> 5), rr = r & 15, cc = c & 31, ob = rr * 64 + cc * 2; return st * 1024 + (ob ^ (((ob >> 9) & 1) << 5)); }
__host__ __device__ __forceinline__ void stage_rc(int b, int& R, int& C) { const int st = b / 1024, sb = b % 1024, swz = sb ^ (((sb >> 9) & 1) << 5); R = (st >> 1) * 16 + swz / 64; C = (st & 1) * 32 + (swz % 64) / 2; }
__host__ __device__ __forceinline__ int perm32(int rho) { const int n = rho >> 4, i = rho & 15; return 8 * (i >> 2) + 4 * n + (i & 3); }
struct Unit { int pm, pn, k0, nt, sk; };
struct Gemm { const bf16_t* A; const bf16_t* Bt; int M, N, K; };
struct StaticOrder {
    int nM, nN, nwg, G, c, ntf;
    __host__ __device__ __forceinline__ void init(int M, int N, int K, int G_, int c_) { nM = M / BM; nN = N / BM; nwg = nM * nN; G = G_; c = c_; ntf = K / BK; }
    __host__ __device__ __forceinline__ Unit get(int i) const {
        Unit u; u.pm = -1; u.pn = 0; u.k0 = 0; u.nt = ntf; u.sk = -1;
        const long L = (long)i * G + c; if (L >= nwg) return u;
        int wgid = (int)L; { const int q = nwg / NXCD, r = nwg % NXCD, xcd = wgid % NXCD, off = wgid / NXCD; wgid = (xcd < r ? xcd * (q + 1) : r * (q + 1) + (xcd - r) * q) + off; }
        const int nig = WGM * nN, gid = wgid / nig, fm = gid * WGM, gsz = (nM - fm) < WGM ? (nM - fm) : WGM;
        u.pm = fm + ((wgid % nig) % gsz); u.pn = (wgid % nig) / gsz; return u;
    }
    __device__ __forceinline__ void a_ready(const Unit&) const {}
    __device__ __forceinline__ void done(const Unit&) const {}
};
struct TailOrder {
    StaticOrder so; int U0, SK, nsplit;
    __host__ __device__ static constexpr int pick_sk(int nN, int ntf) { int sk = 1; while (sk * 2 <= SKMAX && sk * 2 * nN <= 256 && ntf / (sk * 2) >= 4) sk *= 2; return sk; }
    __host__ __device__ __forceinline__ void init(int Mlat, int N, int K, int G_, int c_, bool has_ctx) { so.init(Mlat, N, K, G_, c_); U0 = so.nwg; SK = pick_sk(so.nN, so.ntf); nsplit = has_ctx ? so.nN * SK : 0; }
    __host__ __device__ __forceinline__ Unit get(int i) const {
        const long L = (long)i * so.G + so.c;
        if (L < U0) return so.get(i);
        Unit u; const int s = (int)(L - U0); const bool ok = s < nsplit;
        u.pm = ok ? so.nM : -1; u.pn = s % so.nN; u.sk = s / so.nN; u.nt = so.ntf / SK; u.k0 = u.sk * u.nt; return u;
    }
    __device__ __forceinline__ void a_ready(const Unit&) const {}
    __device__ __forceinline__ void done(const Unit&) const {}
};
template <class Epi, class Sched>
__device__ __forceinline__ void gemm_phase(PG8_LAS unsigned char* lds, const Gemm g, const Sched& S, const Epi& E) {
    const int tid = mk_tid(), wid = __builtin_amdgcn_readfirstlane(tid >> 6), lane = tid & 63, wr = wid >> 2, wc = wid & 3, fr = lane & 15, fq = lane >> 4;
    const int K = g.K;
    unsigned voffA[2], voffB[2];
#pragma unroll
    for (int i = 0; i < 2; ++i) { int R, C; stage_rc(tid * 16 + i * 8192, R, C); const int Rb = Epi::PERM ? ((R & ~31) + perm32(R & 31)) : R;
        voffA[i] = (unsigned)(R * K + C) * 2u; voffB[i] = (unsigned)(Rb * K + C) * 2u; }
    const size_t kstep = (size_t)(BK * 2);
    const size_t hstep = (size_t)HALF * K * 2;
    const size_t tstep = 2 * hstep;
    const unsigned ldsw = (unsigned)wid * 1024u;
    const int aoff = lds_byte(wr * 64 + fr, fq * 8), boff = lds_byte(wc * 32 + fr, fq * 8);
#define PG8_SA(b, h) (((b) * 2 + (h)) * HTB)
#define PG8_SB(b, h) ((4 + (b) * 2 + (h)) * HTB)
#define PG8_STAGE(bufoff, gbase, voff) do { _Pragma("unroll") for (int _i = 0; _i < 2; ++_i) \
        __builtin_amdgcn_global_load_lds((const unsigned*)((const char*)(gbase) + (voff)[_i]), (PG8_LAS unsigned*)(lds + (bufoff) + ldsw + _i * 8192), 16, 0, 0); } while (0)
#define PG8_LDA(dst, b, h) do { _Pragma("unroll") for (int m = 0; m < 4; ++m) _Pragma("unroll") for (int k = 0; k < 2; ++k) dst[m][k] = *(const PG8_LAS bf16x8*)(lds + PG8_SA(b, h) + aoff + m * 2048 + k * 1024); } while (0)
#define PG8_LDB(dst, b, h) do { _Pragma("unroll") for (int n = 0; n < 2; ++n) _Pragma("unroll") for (int k = 0; k < 2; ++k) dst[n][k] = *(const PG8_LAS bf16x8*)(lds + PG8_SB(b, h) + boff + n * 2048 + k * 1024); } while (0)
#define PG8_MMA(ai, bj, At, Bt) do { __builtin_amdgcn_s_setprio(1); _Pragma("unroll") for (int m = 0; m < 4; ++m) _Pragma("unroll") for (int n = 0; n < 2; ++n) _Pragma("unroll") for (int k = 0; k < 2; ++k) \
        acc[ai][bj][m][n] = __builtin_amdgcn_mfma_f32_16x16x32_bf16(Bt[n][k], At[m][k], acc[ai][bj][m][n], 0, 0, 0); __builtin_amdgcn_s_setprio(0); } while (0)
#define PG8_WAIT_V(n) asm volatile("s_waitcnt vmcnt(" #n ")" ::: "memory")
#define PG8_WAIT_L(n) asm volatile("s_waitcnt lgkmcnt(" #n ")" ::: "memory")
#define PG8_BAR __builtin_amdgcn_s_barrier()
#define PG8_SCHED __builtin_amdgcn_sched_barrier(0)
    Unit cur, nxt; int ui = 0;
    cur = S.get(0); if (cur.pm < 0) return;
    f32x4 acc[2][2][4][2];
#pragma unroll
    for (int a = 0; a < 2; ++a)
#pragma unroll
        for (int b = 0; b < 2; ++b)
#pragma unroll
            for (int m = 0; m < 4; ++m)
#pragma unroll
                for (int n = 0; n < 2; ++n) acc[a][b][m][n] = (f32x4){0.f, 0.f, 0.f, 0.f};
    bf16x8 At[4][2], B0[2][2], B1[2][2];
    const char* cA = (const char*)g.A + (size_t)cur.pm * tstep + (size_t)cur.k0 * kstep; const char* cB = (const char*)g.Bt + (size_t)cur.pn * tstep + (size_t)cur.k0 * kstep;
    S.a_ready(cur);
    PG8_STAGE(PG8_SB(0, 0), cB, voffB); PG8_STAGE(PG8_SA(0, 0), cA, voffA); PG8_STAGE(PG8_SB(0, 1), cB + hstep, voffB); PG8_STAGE(PG8_SA(0, 1), cA + hstep, voffA);
    if (wr == 1) PG8_BAR;
    PG8_WAIT_V(4); PG8_BAR;
    PG8_STAGE(PG8_SB(1, 0), cB + kstep, voffB); PG8_STAGE(PG8_SA(1, 0), cA + kstep, voffA); PG8_STAGE(PG8_SB(1, 1), cB + hstep + kstep, voffB);
    PG8_WAIT_V(6); PG8_BAR;
    for (;;) {
        nxt = S.get(ui + 1); const bool has_next = nxt.pm >= 0;
        const char* nA = has_next ? (const char*)g.A + (size_t)nxt.pm * tstep + (size_t)nxt.k0 * kstep : cA; const char* nB = has_next ? (const char*)g.Bt + (size_t)nxt.pn * tstep + (size_t)nxt.k0 * kstep : cB;
        const int nt = cur.nt;
        for (int t = 0; t < nt; t += 2) {
            const bool last = (t == nt - 2);
            const char* a1 = cA + (size_t)(t + 1) * kstep;
            const char* a2 = last ? nA : cA + (size_t)(t + 2) * kstep; const char* b2 = last ? nB : cB + (size_t)(t + 2) * kstep;
            const char* a3 = a2 + kstep; const char* b3 = b2 + kstep;
            if (last && has_next) S.a_ready(nxt);
            PG8_LDB(B0, 0, 0); PG8_SCHED; PG8_LDA(At, 0, 0); PG8_STAGE(PG8_SA(1, 1), a1 + hstep, voffA);
            PG8_WAIT_L(8); PG8_BAR; PG8_WAIT_L(0); PG8_MMA(0, 0, At, B0); PG8_BAR; PG8_SCHED;
            PG8_LDB(B1, 0, 1); PG8_STAGE(PG8_SB(0, 0), b2, voffB);
            PG8_BAR; PG8_WAIT_L(0); PG8_MMA(0, 1, At, B1); PG8_BAR;
            PG8_LDA(At, 0, 1); PG8_STAGE(PG8_SA(0, 0), a2, voffA);
            PG8_BAR; PG8_WAIT_L(0); PG8_MMA(1, 0, At, B0); PG8_BAR; PG8_SCHED;
            PG8_STAGE(PG8_SB(0, 1), b2 + hstep, voffB);
            PG8_WAIT_V(6); PG8_BAR; PG8_MMA(1, 1, At, B1); PG8_BAR;
            PG8_LDB(B0, 1, 0); PG8_SCHED; PG8_LDA(At, 1, 0); PG8_STAGE(PG8_SA(0, 1), a2 + hstep, voffA);
            PG8_WAIT_L(8); PG8_BAR; PG8_WAIT_L(0); PG8_MMA(0, 0, At, B0); PG8_BAR; PG8_SCHED;
            PG8_LDB(B1, 1, 1); PG8_STAGE(PG8_SB(1, 0), b3, voffB);
            PG8_BAR; PG8_WAIT_L(0); PG8_MMA(0, 1, At, B1); PG8_BAR;
            PG8_LDA(At, 1, 1); PG8_STAGE(PG8_SA(1, 0), a3, voffA);
            PG8_BAR; PG8_WAIT_L(0); PG8_MMA(1, 0, At, B0); PG8_BAR; PG8_SCHED;
            PG8_STAGE(PG8_SB(1, 1), b3 + hstep, voffB);
            PG8_WAIT_V(6); PG8_BAR; PG8_MMA(1, 1, At, B1); PG8_BAR;
        }
            if constexpr (!Epi::AFTER_DRAIN) { E(acc, cur, wr, wc, fr, fq); S.done(cur); }
            if (!has_next) break;
#pragma unroll
        for (int a = 0; a < 2; ++a)
#pragma unroll
            for (int b = 0; b < 2; ++b)
#pragma unroll
                for (int m = 0; m < 4; ++m)
#pragma unroll
                    for (int n = 0; n < 2; ++n) acc[a][b][m][n] = (f32x4){0.f, 0.f, 0.f, 0.f};
        cur = nxt; cA = nA; cB = nB; ++ui;
    }
    PG8_WAIT_V(0);
    if (wr == 0) PG8_BAR;
    PG8_BAR;
    if constexpr (Epi::AFTER_DRAIN) { E.fused(acc, cur, wr, wc, fr, fq, lds, wid, lane); S.done(cur); }
#undef PG8_SA
#undef PG8_SB
#undef PG8_STAGE
#undef PG8_LDA
#undef PG8_LDB
#undef PG8_MMA
#undef PG8_WAIT_V
#undef PG8_WAIT_L
#undef PG8_BAR
#undef PG8_SCHED
}
}
namespace att {
using bf16 = bf16_t;
constexpr int   D = 128, NW = 8, QBLK = 32, KVBLK = 64;
constexpr float SCALE = 0.088388347648318440f;
constexpr float THR = 8.f;
constexpr int SDEPTH = 2;
constexpr int LDQ = 4096, LDK = 1024, LDO = 4096;
constexpr size_t SHM_V = KVBLK * D * 2, SHM_K = KVBLK * D * 2, SHM_ATTN = 2 * SHM_V + 2 * SHM_K + NW * 64 * 4;
#define KSWZ(row, colB) ((row) * 256 + ((colB) ^ (((row) & 7) << 4)))
#define SBAR() __builtin_amdgcn_sched_barrier(0)
__device__ __forceinline__ int crow(int r, int hi) { return (r & 3) + 8 * (r >> 2) + 4 * hi; }
__device__ __forceinline__ unsigned cvtpk(float lo, float hi) {
  unsigned r; asm volatile("v_cvt_pk_bf16_f32 %0, %1, %2" : "=v"(r) : "v"(lo), "v"(hi)); return r;
}
template <typename TIn> struct Stage;
template <> struct Stage<bf16>  { using T = bf16x8;
  __device__ static __forceinline__ T ld8(const bf16* p) { return *reinterpret_cast<const bf16x8*>(p); }
  __device__ static __forceinline__ bf16x8 tobf(T x) { return x; } };
template <> struct Stage<float> { using T = f32x8;
  __device__ static __forceinline__ T ld8(const float* p) { return *reinterpret_cast<const f32x8*>(p); }
  __device__ static __forceinline__ bf16x8 tobf(T x) {
    u32x4 w = {cvtpk(x[0], x[1]), cvtpk(x[2], x[3]), cvtpk(x[4], x[5]), cvtpk(x[6], x[7])}; return *reinterpret_cast<bf16x8*>(&w); } };

__device__ __forceinline__ void partialSM(f32x16& p0, f32x16& p1, float& m_reg, float& mn, float& alpha) {
  constexpr float C = SCALE * 1.4426950408889634f;
  float pmax = p0[0]; for (int r = 1; r < 16; ++r) pmax = fmaxf(pmax, p0[r]); for (int r = 0; r < 16; ++r) pmax = fmaxf(pmax, p1[r]);
  { auto rr = __builtin_amdgcn_permlane32_swap(__float_as_uint(pmax), __float_as_uint(pmax), false, false);
    pmax = fmaxf(__uint_as_float(rr[0]), __uint_as_float(rr[1])); }
  if (__builtin_expect(__all(pmax - m_reg <= THR / SCALE), 1)) { mn = m_reg; alpha = 1.f; }
  else { mn = fmaxf(m_reg, pmax); alpha = __builtin_amdgcn_exp2f((m_reg - mn) * C); m_reg = mn; }
  float mnC = -mn * C;
  for (int r = 0; r < 16; ++r) p0[r] = fmaf(p0[r], C, mnC); for (int r = 0; r < 16; ++r) p1[r] = fmaf(p1[r], C, mnC);
  for (int r = 0; r < 16; ++r) p0[r] = __builtin_amdgcn_exp2f(p0[r]);
}
__device__ __forceinline__ void finishSM(f32x16& p0, f32x16& p1, float alpha, float& l_reg, bf16x8& pa0, bf16x8& pa1, bf16x8& pa2, bf16x8& pa3) {
  for (int r = 0; r < 16; ++r) p1[r] = __builtin_amdgcn_exp2f(p1[r]);
  float ps = 0; for (int r = 0; r < 16; ++r) ps += p0[r]; for (int r = 0; r < 16; ++r) ps += p1[r];
  { auto rr = __builtin_amdgcn_permlane32_swap(__float_as_uint(ps), __float_as_uint(ps), false, false);
    ps = __uint_as_float(rr[0]) + __uint_as_float(rr[1]); }
  l_reg = l_reg * alpha + ps;
#define PK4(P, BASE, OUT) do { unsigned a0 = cvtpk(P[BASE + 0], P[BASE + 1]), a1 = cvtpk(P[BASE + 2], P[BASE + 3]);   \
    unsigned b0 = cvtpk(P[BASE + 4], P[BASE + 5]), b1 = cvtpk(P[BASE + 6], P[BASE + 7]);                              \
    auto r0 = __builtin_amdgcn_permlane32_swap(a0, b0, false, false); auto r1 = __builtin_amdgcn_permlane32_swap(a1, b1, false, false); \
    u32x4 w = {r0[0], r1[0], r0[1], r1[1]}; OUT = *reinterpret_cast<bf16x8*>(&w); } while (0)
  PK4(p0, 0, pa0); PK4(p0, 8, pa1); PK4(p1, 0, pa2); PK4(p1, 8, pa3);
#undef PK4
}
__device__ __forceinline__ void qkt(f32x16& p0, f32x16& p1, const bf16* Ks, const bf16x8* qr, int r32, int hi) {
  p0 = f32x16{}; p1 = f32x16{};
  for (int d0 = 0; d0 < 8; ++d0) { int cb = (d0 * 16 + hi * 8) * 2;
    bf16x8 b0 = *reinterpret_cast<const bf16x8*>((const char*)Ks + KSWZ(r32, cb));
    bf16x8 b1 = *reinterpret_cast<const bf16x8*>((const char*)Ks + KSWZ(32 + r32, cb));
    p0 = __builtin_amdgcn_mfma_f32_32x32x16_bf16(b0, qr[d0], p0, 0, 0, 0);
    p1 = __builtin_amdgcn_mfma_f32_32x32x16_bf16(b1, qr[d0], p1, 0, 0, 0); }
}
__device__ __forceinline__ int v_st(int k, int c) { const int kk = (k & ~0xC) | ((k & 4) << 1) | ((k & 8) >> 1); return ((kk >> 3) * 4 + (c >> 5)) * 512 + ((kk & 7) * 32 + (c & 31)) * 2; }
__device__ __forceinline__ int v_rd_base(int lane) { return ((lane & 3) << 3) | (((lane >> 2) & 3) << 6) | (((lane >> 4) & 1) << 5) | (((lane >> 5) & 1) << 8); }
constexpr int v_rd_off(int d0, int ks, int half) { return d0 * 512 + ks * 4096 + half * 2048; }
template <int OFF> __device__ __forceinline__ s16x4 tr_read(int vb) {
  s16x4 r; asm volatile("ds_read_b64_tr_b16 %0, %1 offset:%2" : "=&v"(r) : "v"(vb), "i"(OFF) : "memory"); return r;
}
template <int D0> __device__ __forceinline__ void pv_one(f32x16& od, int vb, bf16x8 pa0, bf16x8 pa1, bf16x8 pa2, bf16x8 pa3) {
  const s16x4 l0 = tr_read<v_rd_off(D0, 0, 0)>(vb), h0 = tr_read<v_rd_off(D0, 0, 1)>(vb), l1 = tr_read<v_rd_off(D0, 1, 0)>(vb), h1 = tr_read<v_rd_off(D0, 1, 1)>(vb);
  const s16x4 l2 = tr_read<v_rd_off(D0, 2, 0)>(vb), h2 = tr_read<v_rd_off(D0, 2, 1)>(vb), l3 = tr_read<v_rd_off(D0, 3, 0)>(vb), h3 = tr_read<v_rd_off(D0, 3, 1)>(vb);
  asm volatile("s_waitcnt lgkmcnt(0)" ::: "memory"); SBAR();
#define PK(L, H) (bf16x8){L[0], L[1], L[2], L[3], H[0], H[1], H[2], H[3]}
  od = __builtin_amdgcn_mfma_f32_32x32x16_bf16(pa0, PK(l0, h0), od, 0, 0, 0);
  od = __builtin_amdgcn_mfma_f32_32x32x16_bf16(pa1, PK(l1, h1), od, 0, 0, 0);
  od = __builtin_amdgcn_mfma_f32_32x32x16_bf16(pa2, PK(l2, h2), od, 0, 0, 0);
  od = __builtin_amdgcn_mfma_f32_32x32x16_bf16(pa3, PK(l3, h3), od, 0, 0, 0);
#undef PK
}
__device__ __forceinline__ void pv_d0(f32x16* o, int vb, bf16x8 pa0, bf16x8 pa1, bf16x8 pa2, bf16x8 pa3) {
  pv_one<0>(o[0], vb, pa0, pa1, pa2, pa3); pv_one<1>(o[1], vb, pa0, pa1, pa2, pa3); pv_one<2>(o[2], vb, pa0, pa1, pa2, pa3); pv_one<3>(o[3], vb, pa0, pa1, pa2, pa3);
}

template <typename TQ>
__device__ __forceinline__ void attn_dense_body(const TQ* __restrict__ Qb, const bf16* __restrict__ Kh, const bf16* __restrict__ Vh,
                                                bf16* __restrict__ Ob, int seq, char* lds) {
  using St = Stage<bf16>; using SQ = Stage<TQ>;
  const int tid = mk_tid(), wid = tid >> 6, lane = tid & 63, r32 = lane & 31, hi = lane >> 5;
  bf16* V_lds = (bf16*)lds; bf16* K_lds = (bf16*)(lds + 2 * SHM_V);
  float* ws = (float*)(lds + 2 * SHM_V + 2 * SHM_K) + wid * 64; float* li_l = ws; float* al_l = ws + 32;
  float m_reg = -1e30f, l_reg = 0; f32x16 o[4] = {}; bf16x8 qr[8];
  const TQ* Qw = Qb + (long)(wid * QBLK + r32) * LDQ + hi * 8;
#pragma unroll
  for (int d0 = 0; d0 < 8; ++d0) qr[d0] = SQ::tobf(SQ::ld8(Qw + d0 * 16));
  const int sr = tid >> 4, sc = (tid & 15) * 8, vst0 = v_st(sr, sc), vst1 = v_st(32 + sr, sc);
  const int vb0 = (int)(uintptr_t)V_lds + v_rd_base(lane);
  struct { typename St::T vs0, vs1, ks0, ks1; } sr_[SDEPTH];
#define SLOAD(i, k0) do { sr_[i].vs0 = St::ld8(&Vh[(long)((k0) + sr) * LDK + sc]); sr_[i].vs1 = St::ld8(&Vh[(long)((k0) + 32 + sr) * LDK + sc]); \
    sr_[i].ks0 = St::ld8(&Kh[(long)((k0) + sr) * LDK + sc]); sr_[i].ks1 = St::ld8(&Kh[(long)((k0) + 32 + sr) * LDK + sc]); } while (0)
#define SWRITE(b, i) do { *(bf16x8*)((char*)V_lds + (b) * SHM_V + vst0) = St::tobf(sr_[i].vs0);          \
    *(bf16x8*)((char*)V_lds + (b) * SHM_V + vst1) = St::tobf(sr_[i].vs1); int kc = sc * 2;               \
    *(bf16x8*)((char*)K_lds + (b) * SHM_K + KSWZ(sr, kc)) = St::tobf(sr_[i].ks0);                       \
    *(bf16x8*)((char*)K_lds + (b) * SHM_K + KSWZ(32 + sr, kc)) = St::tobf(sr_[i].ks1); } while (0)
#define SWAIT() do { if constexpr (SDEPTH == 2) asm volatile("s_waitcnt vmcnt(4)" ::: "memory"); else asm volatile("s_waitcnt vmcnt(0)" ::: "memory"); } while (0)
#define RESC(a) do { if (__any((a) < 1.f)) { if (hi == 0) al_l[r32] = (a); asm volatile("s_waitcnt lgkmcnt(0)" ::: "memory"); \
    for (int d = 0; d < 4; ++d) for (int r = 0; r < 16; ++r) o[d][r] *= al_l[crow(r, hi)]; } } while (0)
  f32x16 pA0, pA1, pB0, pB1; float mnA, mnB, alA, alB; bf16x8 pa0, pa1, pa2, pa3; const int NT = seq / KVBLK;
  constexpr int SE = 0, SO = SDEPTH - 1;
  SLOAD(SE, 0); asm volatile("s_waitcnt vmcnt(0)" ::: "memory"); SWRITE(0, SE); __syncthreads();
  qkt(pA0, pA1, K_lds, qr, r32, hi); partialSM(pA0, pA1, m_reg, mnA, alA);
  SLOAD(SO, KVBLK); if constexpr (SDEPTH == 2) { if (2 < NT) SLOAD(SE, 2 * KVBLK); }
  SWAIT(); SWRITE(1, SO); __syncthreads();
  for (int j = 1; j + 1 < NT; j += 2) {
    SBAR(); qkt(pB0, pB1, (bf16*)((char*)K_lds + SHM_K), qr, r32, hi);
    finishSM(pA0, pA1, alA, l_reg, pa0, pa1, pa2, pa3); SBAR();
    SLOAD(SO, (j + SDEPTH) * KVBLK); SBAR();
    pv_d0(o, vb0, pa0, pa1, pa2, pa3); partialSM(pB0, pB1, m_reg, mnB, alB);
    __syncthreads(); SWAIT(); SWRITE(0, SE);
    RESC(alB); __syncthreads();
    SBAR(); qkt(pA0, pA1, K_lds, qr, r32, hi);
    finishSM(pB0, pB1, alB, l_reg, pa0, pa1, pa2, pa3); SBAR();
    if (SDEPTH == 1 || j + 3 < NT) SLOAD(SE, (j + 1 + SDEPTH) * KVBLK); SBAR();
    pv_d0(o, vb0 + (int)SHM_V, pa0, pa1, pa2, pa3); partialSM(pA0, pA1, m_reg, mnA, alA);
    __syncthreads(); SWAIT(); SWRITE(1, SO);
    RESC(alA); __syncthreads();
  }
  SBAR(); qkt(pB0, pB1, (bf16*)((char*)K_lds + SHM_K), qr, r32, hi);
  finishSM(pA0, pA1, alA, l_reg, pa0, pa1, pa2, pa3); SBAR();
  pv_d0(o, vb0, pa0, pa1, pa2, pa3); partialSM(pB0, pB1, m_reg, mnB, alB);
  __syncthreads(); RESC(alB);
  finishSM(pB0, pB1, alB, l_reg, pa0, pa1, pa2, pa3); SBAR();
  pv_d0(o, vb0 + (int)SHM_V, pa0, pa1, pa2, pa3);
  if (hi == 0) li_l[r32] = l_reg; asm volatile("s_waitcnt lgkmcnt(0)" ::: "memory");
  float rli[16];
#pragma unroll
  for (int r = 0; r < 16; ++r) rli[r] = __builtin_amdgcn_rcpf(li_l[crow(r, hi)]);
  bf16* Ow = Ob + (long)(wid * QBLK) * LDO;
  __syncthreads();
  bf16* Ot = (bf16*)(lds + wid * 8192);
#pragma unroll
  for (int r = 0; r < 16; ++r) { int orow = crow(r, hi);
    for (int d0 = 0; d0 < 4; ++d0) Ot[orow * 128 + d0 * 32 + r32] = f2bf(o[d0][r] * rli[r]); }
  asm volatile("s_waitcnt lgkmcnt(0)" ::: "memory");
#pragma unroll
  for (int k = 0; k < 8; ++k) { const int pi = k * 64 + lane, orow = pi >> 4, c16 = pi & 15;
    *reinterpret_cast<u32x4*>(Ow + (long)orow * LDO + c16 * 8) = *reinterpret_cast<const u32x4*>(Ot + orow * 128 + c16 * 8); }
#undef SLOAD
#undef SWRITE
#undef SWAIT
#undef RESC
}
}
struct Params { const float* in[29]; float* out; unsigned char* ws; int ph_lo, ph_hi; };
typedef const __attribute__((address_space(4))) Params* PP;
__device__ __forceinline__ PP launder(PP p) {
    const unsigned long long v = (unsigned long long)p; unsigned lo = (unsigned)v, hi = (unsigned)(v >> 32);
    asm volatile("" : "+s"(lo), "+s"(hi));
    return (PP)(((unsigned long long)hi << 32) | lo);
}
enum { I_X = 0, I_C, I_CTX, I_CCTX, I_MODW, I_MODB, I_LNG, I_LNB, I_HGWIN, I_HGWOUT, I_HGLB, I_HGNORM, I_ATWQKV, I_ATWOUT, I_ATQN, I_ATKN,
       I_SSMWIN, I_SSMCW, I_SSMCB, I_SSMDTB, I_SSMALOG, I_SSMD, I_SSMNORM, I_SSMWOUT, I_FFNWG, I_FFNWU, I_FFNCW, I_FFNCB, I_FFNWD };

template <class TT> __device__ __forceinline__ TT* wsp(PP p, size_t off) { return (TT*)(p->ws + off); }
__device__ __forceinline__ const float* modv(PP p, int l, int s, int part) { return wsp<const float>(p, WS_MODV) + ((size_t)(l * 2 + s) * MODN + (size_t)part * D); }
__device__ __forceinline__ const float* xin_row(PP p, int r) { return r < TL ? p->in[I_X] + (size_t)r * D : p->in[I_CTX] + (size_t)(r - TL) * D; }

template <class F> struct EpiFn {
    static constexpr bool PERM = true, AFTER_DRAIN = false;
    F f; bf16_t* part; int N;
    template <int KD> __device__ __forceinline__ void tile(const f32x4 (&acc)[2][2][4][2], const pg8::Unit& u, int wr, int wc, int fr, int fq) const {
        const int row0 = u.pm * 256 + wr * 64 + fr;
#pragma unroll
        for (int bj = 0; bj < 2; ++bj) {
            const int col = u.pn * 256 + bj * 128 + wc * 32 + 8 * fq;
#pragma unroll
            for (int ai = 0; ai < 2; ++ai)
#pragma unroll
                for (int m = 0; m < 4; ++m) f.template store<KD>(row0 + ai * 128 + m * 16, col, acc[ai][bj][m][0], acc[ai][bj][m][1]);
        }
    }
    __device__ __forceinline__ void operator()(const f32x4 (&acc)[2][2][4][2], const pg8::Unit& u, int wr, int wc, int fr, int fq) const {
        if (u.sk >= 0) {
            const int rl0 = wr * 64 + fr;
#pragma unroll
            for (int bj = 0; bj < 2; ++bj) {
                const int col = u.pn * 256 + bj * 128 + wc * 32 + 8 * fq;
#pragma unroll
                for (int ai = 0; ai < 2; ++ai)
#pragma unroll
                    for (int m = 0; m < 4; ++m) st_bf16x8_n(part + ((size_t)(u.sk * 256 + rl0 + ai * 128 + m * 16)) * N + col, acc[ai][bj][m][0], acc[ai][bj][m][1]);
            }
            return;
        }
        const int kd = f.kind(u.pn * 256);
        if (F::NK == 1 || kd == 0) tile<0>(acc, u, wr, wc, fr, fq);
        else if (F::NK == 2 || kd == 1) tile<1>(acc, u, wr, wc, fr, fq);
        else if (F::NK == 3 || kd == 2) tile<2>(acc, u, wr, wc, fr, fq);
        else tile<3>(acc, u, wr, wc, fr, fq);
    }
};
struct FBf16 { bf16_t* O; int ld;
    static constexpr int NK = 1;
    __device__ __forceinline__ int kind(int) const { return 0; }
    template <int KD> __device__ __forceinline__ void store(int row, int col, f32x4 v0, f32x4 v1) const { st_bf16x8(O + (size_t)row * ld + col, v0, v1); } };
struct FHgIn { bf16_t* q; float* lf; bf16_t* k; bf16_t* v; bf16_t* sg; const float* lb;
    static constexpr int NK = 4;
    __device__ __forceinline__ int kind(int col0) const { return col0 < 2048 ? 0 : col0 < 6144 ? 1 : col0 < 10240 ? 2 : 3; }
    template <int KD> __device__ __forceinline__ void store(int row, int col, f32x4 v0, f32x4 v1) const {
        if (KD == 0) {
            f32x4 a, b;
#pragma unroll
            for (int i = 0; i < 4; ++i) { a[i] = siluf_(v0[i]) * 0.08838834764831845f; b[i] = siluf_(v1[i]) * 0.08838834764831845f; }
            st_bf16x8(q + (size_t)row * 2048 + col, a, b);
        } else if (KD == 1) {
            const int cc = col - 2048, d = cc >> 11, c = cc & 2047;
            const float* lp = lb + d * 4096 + c;
            f32x4 fa, fb, ka, kb;
#pragma unroll
            for (int i = 0; i < 8; ++i) {
                const float z = i < 4 ? v0[i & 3] : v1[i & 3];
                const float lbv = lp[i], la = lp[8192 + i], l1 = lp[16384 + i];
                const float e = __expf(-fabsf(z)), r1 = 1.0f / (1.0f + e);
                const float ls = fminf(z, 0.f) - __logf(1.0f + e);
                const float bb = l1 + ls, mx = fmaxf(la, bb);
                const float lfv = mx + __logf(1.0f + __expf(-fabsf(la - bb)));
                const float kv = (1.0f - lbv) * (z >= 0.f ? e * r1 : r1);
                if (i < 4) { fa[i & 3] = lfv; ka[i & 3] = kv; } else { fb[i & 3] = lfv; kb[i & 3] = kv; }
            }
            const size_t o = ((size_t)d * T + row) * 2048 + c;
            *(f32x4*)(lf + o) = fa; *(f32x4*)(lf + o + 4) = fb; st_bf16x8(k + o, ka, kb);
        } else if (KD == 2) {
            st_bf16x8(v + (size_t)row * 4096 + (col - 6144), v0, v1);
        } else {
            f32x4 a, b;
#pragma unroll
            for (int i = 0; i < 4; ++i) { a[i] = siluf_(v0[i]); b[i] = siluf_(v1[i]); }
            st_bf16x8(sg + (size_t)row * 4096 + (col - 10240), a, b);
        }
    } };
struct FAtIn { bf16_t* q; bf16_t* k; bf16_t* v;
    static constexpr int NK = 3;
    __device__ __forceinline__ int kind(int col0) const { return col0 < 4096 ? 0 : col0 < 5120 ? 1 : 2; }
    template <int KD> __device__ __forceinline__ void store(int row, int col, f32x4 v0, f32x4 v1) const {
        if (KD == 0) st_bf16x8(q + (size_t)row * 4096 + col, v0, v1);
        else if (KD == 1) st_bf16x8(k + (size_t)row * 1024 + (col - 4096), v0, v1);
        else st_bf16x8(v + (size_t)row * 1024 + (col - 5120), v0, v1);
    } };
struct FMbIn { bf16_t* z; bf16_t* xbc; float* dt;
    static constexpr int NK = 3;
    __device__ __forceinline__ int kind(int col0) const { return col0 < 8192 ? 0 : col0 < 18432 ? 1 : 2; }
    template <int KD> __device__ __forceinline__ void store(int row, int col, f32x4 v0, f32x4 v1) const {
        if (KD == 0) st_bf16x8(z + (size_t)row * 8192 + col, v0, v1);
        else if (KD == 1) st_bf16x8(xbc + (size_t)row * 10240 + (col - 8192), v0, v1);
        else { float* o = dt + (size_t)row * 256 + (col - 18432); *(f32x4*)o = v0; *(f32x4*)(o + 4) = v1; }
    } };

template <class F> __device__ __forceinline__ void run_gemm(PP p, LAS unsigned char* lds, const bf16_t* A, const bf16_t* Bt, int M, int N, int K, const F& f) {
    pg8::Gemm g{A, Bt, M, N, K}; pg8::TailOrder S; S.init(TL, N, K, (int)gridDim.x, (int)mk_bid(), M > TL);
    EpiFn<F> E{f, wsp<bf16_t>(p, WS_PART), N};
    pg8::gemm_phase<EpiFn<F>, pg8::TailOrder>(lds, g, S, E);
}
template <class F> __device__ __forceinline__ void run_ctx_reduce(PP p, int N, int K, const F& f) {
    const int tid = mk_tid(), G = gridDim.x, SK = pg8::TailOrder::pick_sk(N / 256, K / 64), ng = N / 8;
    const bf16_t* part = wsp<const bf16_t>(p, WS_PART);
    for (int idx = mk_bid() * NT + tid; idx < 256 * ng; idx += G * NT) {
        const int row = idx / ng, col = (idx % ng) * 8;
        f32x4 v0 = {0.f, 0.f, 0.f, 0.f}, v1 = {0.f, 0.f, 0.f, 0.f};
        for (int s0 = 0; s0 < SK; s0 += 8) {
            u32x4 raw[8];
#pragma unroll
            for (int i = 0; i < 8; ++i) { const int s = s0 + i < SK ? s0 + i : SK - 1; raw[i] = *(const u32x4*)(part + ((size_t)(s * 256 + row)) * N + col); }
#pragma unroll
            for (int i = 0; i < 8; ++i) if (s0 + i < SK) {
                v0 += (f32x4){bf_lo(raw[i].x), bf_hi(raw[i].x), bf_lo(raw[i].y), bf_hi(raw[i].y)}; v1 += (f32x4){bf_lo(raw[i].z), bf_hi(raw[i].z), bf_lo(raw[i].w), bf_hi(raw[i].w)};
            }
        }
        const int kd = f.kind(col & ~255);
        if (F::NK == 1 || kd == 0) f.template store<0>(TL + row, col, v0, v1);
        else if (F::NK == 2 || kd == 1) f.template store<1>(TL + row, col, v0, v1);
        else if (F::NK == 3 || kd == 2) f.template store<2>(TL + row, col, v0, v1);
        else f.template store<3>(TL + row, col, v0, v1);
    }
}

__device__ __forceinline__ float dpp_ror1(float x) { return __int_as_float(__builtin_amdgcn_update_dpp(0, __float_as_int(x), 0x121, 0xF, 0xF, false)); }
__device__ __forceinline__ float dpp_ror15(float x) { return __int_as_float(__builtin_amdgcn_update_dpp(0, __float_as_int(x), 0x12F, 0xF, 0xF, false)); }
struct EpiGu {
    static constexpr bool PERM = true, AFTER_DRAIN = false;
    bf16_t* hid; bf16_t* part; float* edge; const float* cw; const float* cb; LAS unsigned char* halo;
    __device__ __forceinline__ void operator()(const f32x4 (&acc)[2][2][4][2], const pg8::Unit& u, int wr, int wc, int fr, int fq) const {
        if (u.sk >= 0) {
            const int rl0 = wr * 64 + fr;
#pragma unroll
            for (int bj = 0; bj < 2; ++bj) {
                const int col = u.pn * 256 + bj * 128 + wc * 32 + 8 * fq;
#pragma unroll
                for (int ai = 0; ai < 2; ++ai)
#pragma unroll
                    for (int m = 0; m < 4; ++m) st_bf16x8_n(part + ((size_t)(u.sk * 256 + rl0 + ai * 128 + m * 16)) * 8192 + col, acc[ai][bj][m][0], acc[ai][bj][m][1]);
            }
            return;
        }
        const int hc = u.pn * 128 + wc * 32 + 8 * fq;
        LAS float* H = (LAS float*)halo;
        const int hcol = wc * 32 + 8 * fq;
#pragma unroll
        for (int ai = 0; ai < 2; ++ai) {
            if (fr == 0)  { *(LAS f32x4*)(H + ((ai * 2 + wr) * 2 + 0) * 128 + hcol) = acc[ai][0][0][0]; *(LAS f32x4*)(H + ((ai * 2 + wr) * 2 + 0) * 128 + hcol + 4) = acc[ai][0][0][1]; }
            if (fr == 15) { *(LAS f32x4*)(H + ((ai * 2 + wr) * 2 + 1) * 128 + hcol) = acc[ai][0][3][0]; *(LAS f32x4*)(H + ((ai * 2 + wr) * 2 + 1) * 128 + hcol + 4) = acc[ai][0][3][1]; }
        }
        asm volatile("s_waitcnt lgkmcnt(0)\n\ts_barrier\n\ts_barrier" ::: "memory");
        float w0[8], w1[8], w2[8], bb[8];
        { const f32x4 a0 = *(const f32x4*)(cw + hc), a1 = *(const f32x4*)(cw + hc + 4), b0 = *(const f32x4*)(cw + D + hc), b1 = *(const f32x4*)(cw + D + hc + 4);
          const f32x4 c0 = *(const f32x4*)(cw + 2 * D + hc), c1 = *(const f32x4*)(cw + 2 * D + hc + 4), d0 = *(const f32x4*)(cb + hc), d1 = *(const f32x4*)(cb + hc + 4);
#pragma unroll
          for (int j = 0; j < 4; ++j) { w0[j] = a0[j]; w0[4 + j] = a1[j]; w1[j] = b0[j]; w1[4 + j] = b1[j]; w2[j] = c0[j]; w2[4 + j] = c1[j]; bb[j] = d0[j]; bb[4 + j] = d1[j]; } }
        const int row0 = u.pm * 256 + wr * 64 + fr;
#pragma unroll
        for (int ai = 0; ai < 2; ++ai) {
            const bool hasp = (wr == 1) || (ai == 1), hasn = (wr == 0) || (ai == 0);
            const int pb = wr == 1 ? (ai * 2 + 0) : ((ai - 1) * 2 + 1), nb = wr == 0 ? (ai * 2 + 1) : ((ai + 1) * 2 + 0);
            float hp[8], hn[8];
            { f32x4 x0 = {0.f, 0.f, 0.f, 0.f}, x1 = x0, y0 = x0, y1 = x0;
              if (hasp) { x0 = *(LAS const f32x4*)(H + (pb * 2 + 1) * 128 + hcol); x1 = *(LAS const f32x4*)(H + (pb * 2 + 1) * 128 + hcol + 4); }
              if (hasn) { y0 = *(LAS const f32x4*)(H + (nb * 2 + 0) * 128 + hcol); y1 = *(LAS const f32x4*)(H + (nb * 2 + 0) * 128 + hcol + 4); }
#pragma unroll
              for (int j = 0; j < 4; ++j) { hp[j] = x0[j]; hp[4 + j] = x1[j]; hn[j] = y0[j]; hn[4 + j] = y1[j]; } }
#pragma unroll
            for (int m = 0; m < 4; ++m) {
                float h[8];
#pragma unroll
                for (int j = 0; j < 8; ++j) {
                    const float a = j < 4 ? acc[ai][0][m][0][j & 3] : acc[ai][0][m][1][j & 3], up = j < 4 ? acc[ai][1][m][0][j & 3] : acc[ai][1][m][1][j & 3];
                    const float am = m > 0 ? (j < 4 ? acc[ai][0][m > 0 ? m - 1 : 0][0][j & 3] : acc[ai][0][m > 0 ? m - 1 : 0][1][j & 3]) : 0.f;
                    const float ap = m < 3 ? (j < 4 ? acc[ai][0][m < 3 ? m + 1 : 3][0][j & 3] : acc[ai][0][m < 3 ? m + 1 : 3][1][j & 3]) : 0.f;
                    const float p1 = dpp_ror1(a), p2 = m > 0 ? dpp_ror1(am) : hp[j];
                    const float n1 = dpp_ror15(a), n2 = m < 3 ? dpp_ror15(ap) : hn[j];
                    const float prev = fr > 0 ? p1 : p2, next = fr < 15 ? n1 : n2;
                    h[j] = siluf_(bb[j] + w0[j] * prev + w1[j] * a + w2[j] * next) * up;
                }
                u32x4 w; w.x = cvt_pk_bf16(h[0], h[1]); w.y = cvt_pk_bf16(h[2], h[3]); w.z = cvt_pk_bf16(h[4], h[5]); w.w = cvt_pk_bf16(h[6], h[7]);
                *(u32x4*)(hid + (size_t)(row0 + ai * 128 + m * 16) * D + hc) = w;
            }
        }
        float* E = edge + (size_t)u.pm * 6 * D + hc;
        if (wr == 0 && fr < 2)  { *(f32x4*)(E + (size_t)fr * D) = acc[0][0][0][0]; *(f32x4*)(E + (size_t)fr * D + 4) = acc[0][0][0][1]; }
        if (wr == 0 && fr == 0) { *(f32x4*)(E + (size_t)4 * D) = acc[0][1][0][0]; *(f32x4*)(E + (size_t)4 * D + 4) = acc[0][1][0][1]; }
        if (wr == 1 && fr >= 14) { *(f32x4*)(E + (size_t)(fr - 12) * D) = acc[1][0][3][0]; *(f32x4*)(E + (size_t)(fr - 12) * D + 4) = acc[1][0][3][1]; }
        if (wr == 1 && fr == 15) { *(f32x4*)(E + (size_t)5 * D) = acc[1][1][3][0]; *(f32x4*)(E + (size_t)5 * D + 4) = acc[1][1][3][1]; }
    }
};
__device__ __forceinline__ void run_gemm_gu(PP p, LAS unsigned char* lds, int l, int M) {
    pg8::Gemm g{wsp<const bf16_t>(p, WS_H), wsp<const bf16_t>(p, WS_GU + l * SZ_GU), M, 8192, D}; pg8::TailOrder S; S.init(TL, 8192, D, (int)gridDim.x, (int)mk_bid(), M > TL);
    EpiGu E{wsp<bf16_t>(p, WS_HID), wsp<bf16_t>(p, WS_PART), wsp<float>(p, WS_EDGE), p->in[I_FFNCW] + (size_t)l * 3 * D, p->in[I_FFNCB] + (size_t)l * D, lds + LDS_HALO};
    pg8::gemm_phase<EpiGu, pg8::TailOrder>(lds, g, S, E);
}

struct WMat { const float* src; bf16_t* dst; int K, N, ldn, il; };
__device__ __forceinline__ WMat wmat(PP p, int id) {
    WMat w; w.il = 0;
    if (id < 2)       { w.src = p->in[I_HGWIN] + (size_t)id * D * HG_PROJ; w.dst = wsp<bf16_t>(p, WS_HGIN + id * SZ_HGIN); w.K = D; w.N = HG_PROJ; w.ldn = HG_PROJ; }
    else if (id < 4)  { const int j = id - 2; w.src = p->in[I_HGWOUT] + (size_t)j * D * D; w.dst = wsp<bf16_t>(p, WS_HGOUT + j * SZ_SQ); w.K = D; w.N = D; w.ldn = D; }
    else if (id == 4) { w.src = p->in[I_ATWQKV]; w.dst = wsp<bf16_t>(p, WS_ATQKV); w.K = D; w.N = AT_PROJ; w.ldn = AT_PROJ; }
    else if (id == 5) { w.src = p->in[I_ATWOUT]; w.dst = wsp<bf16_t>(p, WS_ATOUT); w.K = D; w.N = D; w.ldn = D; }
    else if (id == 6) { w.src = p->in[I_SSMWIN]; w.dst = wsp<bf16_t>(p, WS_SSMIN); w.K = D; w.N = SSM_PROJ; w.ldn = SSM_PROJ; }
    else if (id == 7) { w.src = p->in[I_SSMWOUT]; w.dst = wsp<bf16_t>(p, WS_SSMOUT); w.K = 8192; w.N = D; w.ldn = D; }
    else if (id < 12) { const int l = id - 8; w.src = p->in[I_FFNWG] + (size_t)l * D * D; w.dst = wsp<bf16_t>(p, WS_GU + l * SZ_GU); w.K = D; w.N = D; w.ldn = D; w.il = 1; }
    else if (id < 16) { const int l = id - 12; w.src = p->in[I_FFNWU] + (size_t)l * D * D; w.dst = wsp<bf16_t>(p, WS_GU + l * SZ_GU); w.K = D; w.N = D; w.ldn = D; w.il = 2; }
    else              { const int l = id - 16; w.src = p->in[I_FFNWD] + (size_t)l * D * D; w.dst = wsp<bf16_t>(p, WS_FD + l * SZ_SQ); w.K = D; w.N = D; w.ldn = D; }
    return w;
}
constexpr int N_WMAT = 20;
__device__ __forceinline__ void wt_tile(const WMat& w, int tk, int tn, LAS unsigned* T32  , int tid) {
    const int k0 = tk * 128, n0 = tn * 64;
    const int r = tid >> 4, c4 = (tid & 15) * 4;
#pragma unroll
    for (int i = 0; i < 2; ++i) {
        const int kk = 2 * r + 64 * i;
        const f32x4 a = *(const f32x4*)(w.src + (size_t)(k0 + kk) * w.ldn + n0 + c4);
        const f32x4 b = *(const f32x4*)(w.src + (size_t)(k0 + kk + 1) * w.ldn + n0 + c4);
#pragma unroll
        for (int j = 0; j < 4; ++j) T32[(c4 + j) * 65 + (kk >> 1)] = cvt_pk_bf16(a[j], b[j]);
    }
    __syncthreads();
    const int n = tid >> 3, q = tid & 7;
    u32x4 o0, o1;
    o0.x = T32[n * 65 + q * 8 + 0]; o0.y = T32[n * 65 + q * 8 + 1]; o0.z = T32[n * 65 + q * 8 + 2]; o0.w = T32[n * 65 + q * 8 + 3];
    o1.x = T32[n * 65 + q * 8 + 4]; o1.y = T32[n * 65 + q * 8 + 5]; o1.z = T32[n * 65 + q * 8 + 6]; o1.w = T32[n * 65 + q * 8 + 7];
    const int nr = n0 + n, orow = w.il ? 256 * (nr >> 7) + (nr & 127) + (w.il == 2 ? 128 : 0) : nr;
    bf16_t* dp = w.dst + (size_t)orow * w.K + k0 + q * 16;
    *(u32x4*)dp = o0; *(u32x4*)(dp + 8) = o1;
    __syncthreads();
}
__device__ __forceinline__ void phase_prologue1(PP p, LAS unsigned char* lds) {
    const int tid = mk_tid(), G = gridDim.x, b = mk_bid();
    LAS unsigned* T32 = (LAS unsigned*)lds;
    for (int id = 0; id < N_WMAT; ++id) {
        const WMat w = wmat(p, id);
        const int nk = w.K / 128, nn = w.N / 64, ntile = nk * nn;
        for (int t = b; t < ntile; t += G) wt_tile(w, t % nk, t / nk, T32, tid);
    }
    LAS float* cs = (LAS float*)(lds + 32768);
    for (int task = b; task < 4 * 32 * 12; task += G) {
        const int cb = task % 12, ks = (task / 12) % 32, l = task / (12 * 32);
        __syncthreads();
        if (tid < 256) { const int s = tid >> 7, i = tid & 127; const float cv = (s == 0 ? p->in[I_C] : p->in[I_CCTX])[ks * 128 + i]; cs[tid] = siluf_(cv); }
        __syncthreads();
        const int j0 = cb * 2048 + tid * 4;
        const float* wp = p->in[I_MODW] + ((size_t)l * D + (size_t)ks * 128) * MODN + j0;
        f32x4 al = {0.f, 0.f, 0.f, 0.f}, ac = {0.f, 0.f, 0.f, 0.f};
#pragma unroll 8
        for (int i = 0; i < 128; ++i) { const f32x4 wv = *(const f32x4*)(wp + (size_t)i * MODN); al += cs[i] * wv; ac += cs[128 + i] * wv; }
        float* pp = wsp<float>(p, WS_MODP) + ((size_t)(ks * 4 + l) * 2) * MODN + j0;
        *(f32x4*)pp = al; *(f32x4*)(pp + MODN) = ac;
    }
    if (b == 0 && tid < 32) {
        const int j = tid; double th = 1.0;
        for (int i = 0; i < j; ++i) th *= 0.7498942093324559;
        const double t2 = th * th; double ct = 1.0, st = th, tc = 1.0, ts = th;
        for (int n = 1; n <= 14; ++n) { tc *= -t2 / (double)((2 * n - 1) * (2 * n)); ts *= -t2 / (double)((2 * n) * (2 * n + 1)); ct += tc; st += ts; }
        double cc = 1.0, ss = 0.0; float* o = wsp<float>(p, WS_ROPE);
        for (int pos = 0; pos < 256; ++pos) { o[(size_t)(pos * 32 + j) * 2] = (float)cc; o[(size_t)(pos * 32 + j) * 2 + 1] = (float)ss; const double nc = cc * ct - ss * st, ns = ss * ct + cc * st; cc = nc; ss = ns; }
    }
    for (int i = b * NT + tid; i < 2 * 2048; i += G * NT) {
        const int d = i >> 11, c = i & 2047;
        const float r0 = p->in[I_HGLB][(size_t)(d * 2 + 0) * 2048 + c], r1 = p->in[I_HGLB][(size_t)(d * 2 + 1) * 2048 + c];
        const float m = fmaxf(r0, r1), e0 = __expf(r0 - m), e1 = __expf(r1 - m);
        float* o = wsp<float>(p, WS_LB);
        const float lb1 = e1 / (e0 + e1);
        o[(size_t)(d * 2 + 0) * 2048 + c] = 0.f; o[8192 + (size_t)(d * 2 + 0) * 2048 + c] = -__builtin_inff(); o[16384 + (size_t)(d * 2 + 0) * 2048 + c] = 0.f;
        o[(size_t)(d * 2 + 1) * 2048 + c] = lb1; o[8192 + (size_t)(d * 2 + 1) * 2048 + c] = __logf(lb1); o[16384 + (size_t)(d * 2 + 1) * 2048 + c] = __logf(1.0f - lb1);
    }
}
__device__ __forceinline__ void phase_modreduce(PP p) {
    const int tid = mk_tid(), G = gridDim.x, b = mk_bid();
    for (int i = b * NT + tid; i < 4 * 2 * MODN; i += G * NT) {
        const int j = i % MODN, l = i / (2 * MODN);
        float s = p->in[I_MODB][(size_t)l * MODN + j];
        const float* pp = wsp<const float>(p, WS_MODP) + i;
#pragma unroll 8
        for (int ks = 0; ks < 32; ++ks) s += pp[(size_t)ks * 4 * 2 * MODN];
        wsp<float>(p, WS_MODV)[i] = s;
    }
}
__device__ __forceinline__ void phase_mod0(PP p) {
    const int tid = mk_tid(), G = gridDim.x, b = mk_bid();
    bf16_t* H = wsp<bf16_t>(p, WS_H);
    const int c = ((b * NT + tid) & 511) * 8, r00 = (b * NT + tid) >> 9, rs = (G * NT) >> 9;
    for (int s = 0; s < 2; ++s) {
        const float* sh = modv(p, 0, s, 0) + c; const float* sc = modv(p, 0, s, 1) + c;
        const f32x4 h0 = *(const f32x4*)sh, h1 = *(const f32x4*)(sh + 4), c0 = 1.0f + *(const f32x4*)sc, c1 = 1.0f + *(const f32x4*)(sc + 4);
        const int rlo = s == 0 ? 0 : TL, rhi = s == 0 ? TL : T;
        for (int r = rlo + r00; r < rhi; r += 4 * rs) {
            f32x4 x0[4], x1[4];
#pragma unroll
            for (int u = 0; u < 4; ++u) { const int ru = r + u * rs < rhi ? r + u * rs : r; const float* xr = xin_row(p, ru) + c; x0[u] = *(const f32x4*)xr; x1[u] = *(const f32x4*)(xr + 4); }
#pragma unroll
            for (int u = 0; u < 4; ++u) if (r + u * rs < rhi) st_bf16x8(H + (size_t)(r + u * rs) * D + c, x0[u] * c0 + h0, x1[u] * c1 + h1);
        }
    }
}

constexpr float XQ_MAGIC = 12615680.0f;
__device__ __forceinline__ float xq_lo(unsigned w) { return __uint_as_float((w & 0xffffu) | 0x4B400000u) - XQ_MAGIC; }
__device__ __forceinline__ float xq_hi(unsigned w) { return __uint_as_float((w >> 16) | 0x4B400000u) - XQ_MAGIC; }
__device__ __forceinline__ unsigned xq_pack(float y0, float y1, float inv) { return (__float_as_uint(fmaf(y0, inv, XQ_MAGIC)) & 0xffffu) | (__float_as_uint(fmaf(y1, inv, XQ_MAGIC)) << 16); }
__device__ __forceinline__ float amax4(float m, f32x4 y) { return fmaxf(fmaxf(m, fmaxf(fabsf(y[0]), fabsf(y[1]))), fmaxf(fabsf(y[2]), fabsf(y[3]))); }
template <class Op> __device__ __forceinline__ float ln_reduce8(const float (&s)[8], int lane, Op op) {
    float t[4], u[2];
    { const bool hi = lane & 32;
#pragma unroll
      for (int k = 0; k < 4; ++k) { const float send = hi ? s[k] : s[4 + k], keep = hi ? s[4 + k] : s[k]; t[k] = op(keep, xch32(send, lane)); } }
    { const bool hi = lane & 16;
#pragma unroll
      for (int k = 0; k < 2; ++k) { const float send = hi ? t[k] : t[2 + k], keep = hi ? t[2 + k] : t[k]; u[k] = op(keep, xch16(send, lane)); } }
    float w;
    { const bool hi = lane & 8; const float send = hi ? u[0] : u[1], keep = hi ? u[1] : u[0]; w = op(keep, dpp_mov<0x128>(send)); }
    w = op(w, dpp_mov<0xB1>(w)); w = op(w, dpp_mov<0x4E>(w)); w = op(w, dpp_mov<0x141>(w));
    return w;
}
typedef OpSum LnSum; typedef OpMax LnMax;
template <bool FIRST> struct LnRaw { u32x4 x[FIRST ? 16 : 8]; u32x4 o[8]; float xs; };
__device__ __forceinline__ float sum8_(f32x4 a, f32x4 b) { return ((a[0] + a[1]) + (a[2] + a[3])) + ((b[0] + b[1]) + (b[2] + b[3])); }
template <bool FIRST, bool LAST> __device__ __forceinline__ void ln_latent(PP p, LAS unsigned char* lds, int l, int which) {
    const int tid = mk_tid(), lane = tid & 63, wid = __builtin_amdgcn_readfirstlane(tid >> 6), G = gridDim.x, b = mk_bid();
    const unsigned c = (unsigned)(wid & 7) * 512u + (unsigned)lane * 8u; const int NB = TL / 8;
    LAS float* red = (LAS float*)(lds + 98304);
    const bf16_t* OB = wsp<const bf16_t>(p, WS_OB); bf16_t* XQ = wsp<bf16_t>(p, WS_X); float* XS = (float*)(p->ws + WS_X + (size_t)T * D * 2); bf16_t* H = wsp<bf16_t>(p, WS_H);
    LAS const float* vg = (LAS const float*)lds;
    const int k = (wid & 7) * 64 + lane;
#define LNV(vi, hf) (*(const LAS f32x4*)(vg + (vi) * D + (hf) * 2048 + k * 4))
    auto load = [&](int bt, LnRaw<FIRST>& w) {
        const int r0 = (bt < NB ? bt : NB - 1) * 8;
#pragma unroll
        for (int j = 0; j < 8; ++j) {
            const size_t ro = (size_t)(r0 + j) * D;
            w.o[j] = *(const u32x4*)(OB + ro + c);
            if (FIRST) { const float* xr = p->in[I_X] + ro; w.x[2 * j] = *(const u32x4*)(xr + c); w.x[2 * j + 1] = *(const u32x4*)(xr + c + 4u); }
            else w.x[j] = *(const u32x4*)(XQ + ro + c);
        }
        if (!FIRST) w.xs = XS[r0 + (lane & 7)];
    };
    auto exchange = [&](int k, float wv, float (&tot)[8], bool is_max) {
        if ((lane & 7) == 0) red[(k * 8 + wid) * 8 + (lane >> 3)] = wv;
        lds_barrier();
        f32x4 a0 = *(const LAS f32x4*)(red + k * 64), a1 = *(const LAS f32x4*)(red + k * 64 + 4);
#pragma unroll
        for (int w = 1; w < 8; ++w) {
            const f32x4 c0 = *(const LAS f32x4*)(red + (k * 8 + w) * 8), c1 = *(const LAS f32x4*)(red + (k * 8 + w) * 8 + 4);
            if (is_max) {
#pragma unroll
                for (int e = 0; e < 4; ++e) { a0[e] = fmaxf(a0[e], c0[e]); a1[e] = fmaxf(a1[e], c1[e]); }
            } else { a0 += c0; a1 += c1; }
        }
#pragma unroll
        for (int j = 0; j < 8; ++j) tot[j] = j < 4 ? a0[j & 3] : a1[j & 3];
    };
    auto process = [&](int bt, const LnRaw<FIRST>& w, bool valid) {
        int r0 = (bt < NB ? bt : NB - 1) * 8;
        asm volatile("" : "+s"(r0));
        f32x4 v0[8], v1[8]; float s[8], tot[8];
        const f32x4 gt0 = LNV(0, 0), gt1 = LNV(0, 1);
#pragma unroll
        for (int j = 0; j < 8; ++j) {
            const u32x4 ow = w.o[j];
            const f32x4 o0 = {bf_lo(ow.x), bf_hi(ow.x), bf_lo(ow.y), bf_hi(ow.y)}, o1 = {bf_lo(ow.z), bf_hi(ow.z), bf_lo(ow.w), bf_hi(ow.w)};
            if (FIRST) {
                v0[j] = ALPHA * __builtin_bit_cast(f32x4, w.x[2 * j]) + gt0 * o0; v1[j] = ALPHA * __builtin_bit_cast(f32x4, w.x[2 * j + 1]) + gt1 * o1;
            } else {
                const float as = ALPHA * __uint_as_float(__builtin_amdgcn_readlane(__float_as_uint(w.xs), j));
                const u32x4 xw = w.x[j];
                const f32x4 q0 = {xq_lo(xw.x), xq_hi(xw.x), xq_lo(xw.y), xq_hi(xw.y)}, q1 = {xq_lo(xw.z), xq_hi(xw.z), xq_lo(xw.w), xq_hi(xw.w)};
                v0[j] = as * q0 + gt0 * o0; v1[j] = as * q1 + gt1 * o1;
            }
            s[j] = sum8_(v0[j], v1[j]);
        }
        exchange(0, ln_reduce8(s, lane, LnSum()), tot, false);
#pragma unroll
        for (int j = 0; j < 8; ++j) { const float mean = tot[j] * (1.0f / D); v0[j] = v0[j] - mean; v1[j] = v1[j] - mean; s[j] = sum8_(v0[j] * v0[j], v1[j] * v1[j]); }
        exchange(1, ln_reduce8(s, lane, LnSum()), tot, false);
        const f32x4 g0 = LNV(1, 0), g1 = LNV(1, 1), b0 = LNV(2, 0), b1 = LNV(2, 1);
#pragma unroll
        for (int j = 0; j < 8; ++j) {
            const float rstd = rsqrtf(tot[j] * (1.0f / D) + LN_EPS);
            v0[j] = v0[j] * (rstd * g0) + b0; v1[j] = v1[j] * (rstd * g1) + b1;
            if (!LAST) s[j] = amax4(amax4(0.f, v0[j]), v1[j]);
        }
        if (LAST) {
            if (valid) {
#pragma unroll
                for (int j = 0; j < 8; ++j) { float* o = p->out + (size_t)(r0 + j) * D; *(f32x4*)(o + c) = v0[j]; *(f32x4*)(o + c + 4u) = v1[j]; }
            }
        } else {
            exchange(2, ln_reduce8(s, lane, LnMax()), tot, true);
            if (valid) {
                const f32x4 sc0 = 1.0f + LNV(3, 0), sc1 = 1.0f + LNV(3, 1), sh0 = LNV(4, 0), sh1 = LNV(4, 1);
                float mine = 0.f;
#pragma unroll
                for (int j = 0; j < 8; ++j) {
                    const float M = fmaxf(tot[j], 1e-20f), inv = 32767.0f / M;
                    mine = lane == j ? M * (1.0f / 32767.0f) : mine;
                    const size_t ro = (size_t)(r0 + j) * D;
                    u32x4 xw; xw.x = xq_pack(v0[j][0], v0[j][1], inv); xw.y = xq_pack(v0[j][2], v0[j][3], inv); xw.z = xq_pack(v1[j][0], v1[j][1], inv); xw.w = xq_pack(v1[j][2], v1[j][3], inv);
                    *(u32x4*)(XQ + ro + c) = xw;
                    st_bf16x8(H + ro + c, v0[j] * sc0 + sh0, v1[j] * sc1 + sh1);
                }
                if (wid == 0 && lane < 8) XS[r0 + lane] = mine;
            }
        }
    };
    const int nmine = b < NB ? (NB - b + G - 1) / G : 0;
    if (FIRST) {
        LnRaw<FIRST> ra;
        for (int i = 0; i < nmine; ++i) { load(b + i * G, ra); process(b + i * G, ra, true); }
    } else {
        LnRaw<FIRST> ra, rb;
        load(b, ra);
#pragma unroll 1
        for (int i = 0; i < nmine; i += 2) {
            load(b + (i + 1) * G, rb); process(b + i * G, ra, true);
            load(b + (i + 2) * G, ra); process(b + (i + 1) * G, rb, i + 1 < nmine);
        }
    }
}
#undef LNV
__device__ __forceinline__ void phase_ln(PP p, LAS unsigned char* lds, int l, int which  ) {
    const int tid = mk_tid(), lane = tid & 63, wid = tid >> 6, G = gridDim.x, b = mk_bid();
    LAS float* vg = (LAS float*)lds;
    const bool last = (l == DEPTH - 1 && which == 1), first = (l == 0 && which == 0);
    const bf16_t* OB = wsp<const bf16_t>(p, WS_OB); bf16_t* XQ = wsp<bf16_t>(p, WS_X); float* XS = (float*)(p->ws + WS_X + (size_t)T * D * 2); bf16_t* H = wsp<bf16_t>(p, WS_H);
    const float* lg = p->in[I_LNG] + (size_t)(l * 2 + which) * D; const float* lbv = p->in[I_LNB] + (size_t)(l * 2 + which) * D;
    for (int s = 0; s < 2; ++s) {
        if (s == 1 && l == DEPTH - 1) break;
        __syncthreads();
        const float* gt = modv(p, l, s, which == 0 ? 2 : 5);
        const float* sc = last ? nullptr : (which == 0 ? modv(p, l, s, 4) : modv(p, l + 1, s, 1));
        const float* sh = last ? nullptr : (which == 0 ? modv(p, l, s, 3) : modv(p, l + 1, s, 0));
        for (int i = tid; i < D; i += NT) { const int ps = ((i >> 2) & 1) * 2048 + (i >> 3) * 4 + (i & 3); vg[ps] = gt[i]; vg[D + ps] = lg[i]; vg[2 * D + ps] = lbv[i]; vg[3 * D + ps] = sc ? sc[i] : 0.f; vg[4 * D + ps] = sh ? sh[i] : 0.f; }
        __syncthreads();
        if (s == 0) { if (first) ln_latent<true, false>(p, lds, l, which); else if (last) ln_latent<false, true>(p, lds, l, which); else ln_latent<false, false>(p, lds, l, which); continue; }
#define LN_VEC(vi, k, hf) (*(const LAS f32x4*)(vg + (vi) * D + (hf) * 2048 + (k) * 4))
        auto load_piece = [&](int r, int c, int k, float as, f32x4& v0, f32x4& v1) {
            const bf16_t* part = wsp<const bf16_t>(p, WS_PART) + (size_t)(r - TL) * D + c;
            u32x4 pw[16];
#pragma unroll
            for (int sk = 0; sk < 16; ++sk) pw[sk] = *(const u32x4*)(part + (size_t)sk * 256 * D);
            f32x4 o0 = {0.f, 0.f, 0.f, 0.f}, o1 = o0;
#pragma unroll
            for (int sk = 0; sk < 16; ++sk) { o0 += (f32x4){bf_lo(pw[sk].x), bf_hi(pw[sk].x), bf_lo(pw[sk].y), bf_hi(pw[sk].y)}; o1 += (f32x4){bf_lo(pw[sk].z), bf_hi(pw[sk].z), bf_lo(pw[sk].w), bf_hi(pw[sk].w)}; }
            if (first) {
                const float* xr = xin_row(p, r) + c;
                v0 = ALPHA * *(const f32x4*)xr + LN_VEC(0, k, 0) * o0; v1 = ALPHA * *(const f32x4*)(xr + 4) + LN_VEC(0, k, 1) * o1;
            } else {
                const u32x4 xw = *(const u32x4*)(XQ + (size_t)r * D + c);
                const f32x4 q0 = {xq_lo(xw.x), xq_hi(xw.x), xq_lo(xw.y), xq_hi(xw.y)}, q1 = {xq_lo(xw.z), xq_hi(xw.z), xq_lo(xw.w), xq_hi(xw.w)};
                v0 = as * q0 + LN_VEC(0, k, 0) * o0; v1 = as * q1 + LN_VEC(0, k, 1) * o1;
            }
        };
        auto store_piece = [&](int r, int c, int k, f32x4 y0, f32x4 y1, float inv) {
            u32x4 xw; xw.x = xq_pack(y0[0], y0[1], inv); xw.y = xq_pack(y0[2], y0[3], inv); xw.z = xq_pack(y1[0], y1[1], inv); xw.w = xq_pack(y1[2], y1[3], inv);
            *(u32x4*)(XQ + (size_t)r * D + c) = xw;
            st_bf16x8(H + (size_t)r * D + c, y0 * (1.0f + LN_VEC(3, k, 0)) + LN_VEC(4, k, 0), y1 * (1.0f + LN_VEC(3, k, 1)) + LN_VEC(4, k, 1));
        };
        if (s == 1) {
            if (l < DEPTH - 1) {
                LAS float* red = vg + 5 * D;
                for (int rr = b; rr < TC; rr += G) {
                    const int r = TL + rr, c = wid * 512 + lane * 8, k = wid * 64 + lane;
                    f32x4 v0, v1;
                    load_piece(r, c, k, first ? 0.f : ALPHA * XS[r], v0, v1);
                    const float ws_ = wave_sum(((v0[0] + v0[1]) + (v0[2] + v0[3])) + ((v1[0] + v1[1]) + (v1[2] + v1[3]))); if (lane == 0) red[wid] = ws_;
                    __syncthreads();
                    float tot = 0.f;
#pragma unroll
                    for (int w = 0; w < 8; ++w) tot += red[w];
                    const float mean = tot * (1.0f / D);
                    const f32x4 d0 = v0 - mean, d1 = v1 - mean;
                    const float wq = wave_sum(((d0[0] * d0[0] + d0[1] * d0[1]) + (d0[2] * d0[2] + d0[3] * d0[3])) + ((d1[0] * d1[0] + d1[1] * d1[1]) + (d1[2] * d1[2] + d1[3] * d1[3]))); if (lane == 0) red[8 + wid] = wq;
                    __syncthreads();
                    float qt = 0.f;
#pragma unroll
                    for (int w = 0; w < 8; ++w) qt += red[8 + w];
                    const float rstd = rsqrtf(qt * (1.0f / D) + LN_EPS);
                    const f32x4 y0 = d0 * rstd * LN_VEC(1, k, 0) + LN_VEC(2, k, 0), y1 = d1 * rstd * LN_VEC(1, k, 1) + LN_VEC(2, k, 1);
                    const float wm = wave_max(amax4(amax4(0.f, y0), y1)); if (lane == 0) red[16 + wid] = wm;
                    __syncthreads();
                    float M = 1e-20f;
#pragma unroll
                    for (int w = 0; w < 8; ++w) M = fmaxf(M, red[16 + w]);
                    if (tid == 0) XS[r] = M * (1.0f / 32767.0f);
                    store_piece(r, c, k, y0, y1, 32767.0f / M);
                }
            }
            continue;
        }
#undef LN_VEC
    }
}

__device__ __forceinline__ void phase_ffn_fix(PP p, int l, bool ctx_out) {
    const int tid = mk_tid(), G = gridDim.x, b = mk_bid();
    bf16_t* HID = wsp<bf16_t>(p, WS_HID); const float* edge = wsp<const float>(p, WS_EDGE); const bf16_t* part = wsp<const bf16_t>(p, WS_PART);
    const float* cw = p->in[I_FFNCW] + (size_t)l * 3 * D; const float* cb = p->in[I_FFNCB] + (size_t)l * D;
    for (int idx = b * NT + tid; idx < 64 * 2 * 512; idx += G * NT) {
        const int c = (idx & 511) * 8, e = (idx >> 9) & 1, pm = idx >> 10;
        const float* E = edge + (size_t)pm * 6 * D + c;
        float h[8];
#pragma unroll
        for (int j = 0; j < 8; ++j) {
            float a, ap, an, uu;
            if (e == 0) { a = E[j]; an = E[D + j]; ap = pm > 0 ? edge[((size_t)(pm - 1) * 6 + 3) * D + c + j] : 0.f; uu = E[4 * D + j]; }
            else { a = E[3 * D + j]; ap = E[2 * D + j]; an = pm < 63 ? edge[((size_t)(pm + 1) * 6 + 0) * D + c + j] : 0.f; uu = E[5 * D + j]; }
            h[j] = siluf_(cb[c + j] + cw[c + j] * ap + cw[D + c + j] * a + cw[2 * D + c + j] * an) * uu;
        }
        u32x4 w; w.x = cvt_pk_bf16(h[0], h[1]); w.y = cvt_pk_bf16(h[2], h[3]); w.z = cvt_pk_bf16(h[4], h[5]); w.w = cvt_pk_bf16(h[6], h[7]);
        *(u32x4*)(HID + (size_t)(pm * 256 + (e ? 255 : 0)) * D + c) = w;
    }
    if (ctx_out) {
        constexpr int SK = 8;
        for (int idx = b * NT + tid; idx < TC * 512; idx += G * NT) {
            const int c = (idx & 511) * 8, t = idx >> 9, ic = 256 * (c >> 7) + (c & 127);
            auto sum8 = [&](int tt, int col, float (&o)[8]) {
                f32x4 x = {0.f, 0.f, 0.f, 0.f}, y = x;
#pragma unroll
                for (int s = 0; s < SK; ++s) { float o8[8]; ld8bf(part + ((size_t)(s * 256 + tt)) * 8192 + col, o8); x += (f32x4){o8[0], o8[1], o8[2], o8[3]}; y += (f32x4){o8[4], o8[5], o8[6], o8[7]}; }
                o[0] = x[0]; o[1] = x[1]; o[2] = x[2]; o[3] = x[3]; o[4] = y[0]; o[5] = y[1]; o[6] = y[2]; o[7] = y[3];
            };
            float prev[8], cur[8], nxt[8], u[8], h[8];
#pragma unroll
            for (int j = 0; j < 8; ++j) { prev[j] = 0.f; nxt[j] = 0.f; }
            if (t > 0) sum8(t - 1, ic, prev);
            sum8(t, ic, cur);
            if (t + 1 < TC) sum8(t + 1, ic, nxt);
            sum8(t, ic + 128, u);
#pragma unroll
            for (int j = 0; j < 8; ++j) h[j] = siluf_(cb[c + j] + cw[c + j] * prev[j] + cw[D + c + j] * cur[j] + cw[2 * D + c + j] * nxt[j]) * u[j];
            u32x4 w; w.x = cvt_pk_bf16(h[0], h[1]); w.y = cvt_pk_bf16(h[2], h[3]); w.z = cvt_pk_bf16(h[4], h[5]); w.w = cvt_pk_bf16(h[6], h[7]);
            *(u32x4*)(HID + (size_t)(TL + t) * D + c) = w;
        }
    }
}
template <int CC> __device__ __forceinline__ size_t frag_off(int row, int col) { return ((size_t)((row >> 4) * (CC / 32) + (col >> 5)) * 64 + ((col & 31) >> 3) * 16 + (row & 15)) * 8 + (col & 7); }
__device__ __forceinline__ int hg_chunk_row(int c) { return c < 256 ? c * 64 : TL + (c - 256) * 64; }
__device__ __forceinline__ int hg_kperm(int k) { const int kl = k & 31, hi = kl >> 4, r = kl & 15; return (k & ~31) + (r >> 2) * 8 + hi * 4 + (r & 3); }
template <int V> struct IC { static constexpr int value = V; };
__device__ __forceinline__ float clamp80(float x) { return fminf(fmaxf(x, -80.f), 80.f); }
__device__ __forceinline__ void phase_hg_prep(PP p, LAS unsigned char* lds) {
    const int tid = mk_tid(), lane = tid & 63, wid = tid >> 6, G = gridDim.x, r16 = lane & 15, q4 = lane >> 4;
    const bf16_t* QB = wsp<const bf16_t>(p, HG_QB); const bf16_t* KB = wsp<const bf16_t>(p, HG_KB); const float* LF = wsp<const float>(p, HG_LF); const bf16_t* V = wsp<const bf16_t>(p, HG_V);
    bf16_t* HA = wsp<bf16_t>(p, HG_A); bf16_t* HQT = wsp<bf16_t>(p, HG_QT); bf16_t* HKT = wsp<bf16_t>(p, HG_KT); float* HD = wsp<float>(p, HG_D); bf16_t* HVT = wsp<bf16_t>(p, HG_VT);
    constexpr int RS = 272;
    constexpr int HP_TOT = 288 * RS, HP_QT = HP_TOT + 2048, HP_A = HP_QT + 16384;
    LAS float* TOT = (LAS float*)(lds + HP_TOT);
    const int k = tid & 127, I = __builtin_amdgcn_readfirstlane(tid >> 7);
    struct HpIn { u32x4 lf[4], q[2], kk[2]; };
    auto load_in = [&](int item, HpIn& v) {
        const int c = item % NCH, h = (item / NCH) & 15, d = item / (NCH * 16), rb = hg_chunk_row(c);
#pragma unroll
        for (int u = 0; u < 4; ++u) { const int pi = tid + 512 * u, row = pi >> 5, cp = pi & 31; v.lf[u] = *(const u32x4*)(LF + ((size_t)d * T + rb + row) * 2048 + h * 128 + cp * 4); }
#pragma unroll
        for (int u = 0; u < 2; ++u) { const int pi = tid + 512 * u, row = pi >> 4, cp = pi & 15;
            v.q[u] = *(const u32x4*)(QB + (size_t)(rb + row) * 2048 + h * 128 + cp * 8); v.kk[u] = *(const u32x4*)(KB + ((size_t)d * T + rb + row) * 2048 + h * 128 + cp * 8); }
    };
    auto process = [&](int item, const HpIn& in, auto dtag) {
        constexpr int d = decltype(dtag)::value;
        const int c = item % NCH, h = (item / NCH) & 15, rb = hg_chunk_row(c);
        (void)rb; (void)h;
        lds_barrier();
#pragma unroll
        for (int u = 0; u < 4; ++u) *(LAS u32x4*)(lds + (tid + 512 * u) * 16) = in.lf[u];
#pragma unroll
        for (int u = 0; u < 2; ++u) { *(LAS u32x4*)(lds + 32768 + (tid + 512 * u) * 16) = in.q[u]; *(LAS u32x4*)(lds + 49152 + (tid + 512 * u) * 16) = in.kk[u]; }
        lds_barrier();
        float b[16], qv[16], kv[16];
        const int tb = d ? 63 - 16 * I : 16 * I;
#pragma unroll
        for (int j = 0; j < 16; ++j) {
            const int to = d ? -j : j;
            b[j] = ((LAS const float*)lds + tb * 128 + k)[to * 128]; qv[j] = bf1(((LAS const bf16_t*)(lds + 32768) + tb * 128 + k)[to * 128]); kv[j] = bf1(((LAS const bf16_t*)(lds + 49152) + tb * 128 + k)[to * 128]);
        }
        lds_barrier();
#pragma unroll
        for (int j = 1; j < 16; ++j) b[j] += b[j - 1];
        TOT[I * 128 + k] = b[15];
        lds_barrier();
        const float t0 = TOT[k], t1 = TOT[128 + k], t2 = TOT[256 + k], t3 = TOT[384 + k];
        const float rI = (I > 0 ? t0 : 0.f) + (I > 1 ? t1 : 0.f) + (I > 2 ? t2 : 0.f), gtot = (t0 + t1) + (t2 + t3);
        if (I == 0) HD[(size_t)item * 128 + k] = __expf(gtot);
        const float off1 = (I == 0 ? t0 : I == 1 ? t1 : I == 2 ? t2 : t3), off2 = off1 + (I == 0 ? t1 : t2), off3 = off2 + t2;
        const float bmid = b[7];
        const int kp = hg_kperm(k);
        const float cq = __expf(rI), ck = __expf(gtot - rI - off1), c2 = __expf(off2 - off1), c3 = __expf(off3 - off1);
        unsigned short kt16[16];
        LAS bf16_t* pQD = (LAS bf16_t*)(lds + (size_t)(16 * I) * RS) + k;
        LAS bf16_t* pKD = (LAS bf16_t*)(lds + (size_t)(64 + 16 * I) * RS) + k;
        LAS bf16_t* pQO = (LAS bf16_t*)(lds + (size_t)(I >= 1 ? 128 + 16 * (I - 1) : 272) * RS) + k;
        LAS bf16_t* pK1 = (LAS bf16_t*)(lds + (size_t)(I == 0 ? 176 : I == 1 ? 208 : I == 2 ? 256 : 272) * RS) + k;
        LAS bf16_t* pK2 = (LAS bf16_t*)(lds + (size_t)(I == 0 ? 192 : I == 1 ? 240 : 272) * RS) + k;
        LAS bf16_t* pK3 = (LAS bf16_t*)(lds + (size_t)(I == 0 ? 224 : 272) * RS) + k;
        LAS bf16_t* pQT = (LAS bf16_t*)(lds + HP_QT) + frag_off<128>(tb, kp);
#pragma unroll
        for (int j = 0; j < 16; ++j) {
            const float eb = __expf(b[j]), e1 = __expf(off1 - b[j]);
            pQT[d ? -8 * j : 8 * j] = f2bf_n(qv[j] * (cq * eb));
            kt16[j] = f2bf_n(kv[j] * (ck * e1));
            pQD[j * (RS / 2)] = f2bf_n(qv[j] * __expf(clamp80(b[j] - bmid)));
            pKD[j * (RS / 2)] = f2bf_n(kv[j] * __expf(clamp80(bmid - b[j])));
            pQO[j * (RS / 2)] = f2bf_n(qv[j] * eb);
            pK1[j * (RS / 2)] = f2bf_n(kv[j] * e1);
            pK2[j * (RS / 2)] = f2bf_n(kv[j] * (c2 * e1));
            pK3[j * (RS / 2)] = f2bf_n(kv[j] * (c3 * e1));
        }
        {
            u32x4 w0, w1;
#define KT_(i) ((unsigned)(d ? kt16[15 - (i)] : kt16[(i)]))
            w0.x = KT_(0) | (KT_(1) << 16); w0.y = KT_(2) | (KT_(3) << 16); w0.z = KT_(4) | (KT_(5) << 16); w0.w = KT_(6) | (KT_(7) << 16);
            w1.x = KT_(8) | (KT_(9) << 16); w1.y = KT_(10) | (KT_(11) << 16); w1.z = KT_(12) | (KT_(13) << 16); w1.w = KT_(14) | (KT_(15) << 16);
#undef KT_
            const int s0 = d ? 48 - 16 * I : 16 * I;
            *(u32x4*)(HKT + (size_t)item * 8192 + frag_off<64>(k, s0)) = w0; *(u32x4*)(HKT + (size_t)item * 8192 + frag_off<64>(k, s0 + 8)) = w1;
        }
        lds_barrier();
        { const u32x4 x0 = *(LAS const u32x4*)(lds + HP_QT + tid * 16), x1 = *(LAS const u32x4*)(lds + HP_QT + 8192 + tid * 16);
          *(u32x4*)(HQT + (size_t)item * 8192 + tid * 8) = x0; *(u32x4*)(HQT + (size_t)item * 8192 + 4096 + tid * 8) = x1; }
#pragma unroll 1
        for (int tile = wid; tile < 16; tile += 8) {
            const int Iq = tile >> 2, J = tile & 3;
            f32x4 acc = {0.f, 0.f, 0.f, 0.f};
            if (J <= Iq) {
                const int arow = (J == Iq) ? 16 * Iq : 128 + 16 * (Iq - 1);
                const int brow = (J == Iq) ? 64 + 16 * Iq : (Iq == 1 ? 176 : Iq == 2 ? 192 : 224) + 16 * J;
#pragma unroll
                for (int kk = 0; kk < 4; ++kk) {
                    const bf16x8 av = *(const LAS bf16x8*)(lds + (size_t)(arow + r16) * RS + kk * 64 + q4 * 16);
                    const bf16x8 bv = *(const LAS bf16x8*)(lds + (size_t)(brow + r16) * RS + kk * 64 + q4 * 16);
                    acc = __builtin_amdgcn_mfma_f32_16x16x32_bf16(av, bv, acc, 0, 0, 0);
                }
                if (J == Iq) {
#pragma unroll
                    for (int i = 0; i < 4; ++i) acc[i] = (r16 <= 4 * q4 + i) ? acc[i] : 0.f;
                }
            }
#pragma unroll
            for (int i = 0; i < 4; ++i) {
                const int tau = 16 * Iq + 4 * q4 + i, sig = 16 * J + r16, t = d ? 63 - tau : tau, s = d ? 63 - sig : sig;
                ((LAS bf16_t*)(lds + HP_A))[frag_off<64>(t, s)] = f2bf_n(acc[i]);
            }
        }
        lds_barrier();
        *(u32x4*)(HA + (size_t)item * 4096 + tid * 8) = *(LAS const u32x4*)(lds + HP_A + tid * 16);
    };
    const int NI = 32 * NCH, i0 = mk_bid();
    HpIn va, vb;
    auto run = [&](int item, const HpIn& in) { if (item < NCH * 16) process(item, in, IC<0>{}); else process(item, in, IC<1>{}); };
    if (i0 < NI) load_in(i0, va);
#pragma unroll 1
    for (int item = i0; item < NI; item += 2 * G) {
        if (item + G < NI) load_in(item + G, vb);
        run(item, va);
        if (item + 2 * G < NI) load_in(item + 2 * G, va);
        if (item + G < NI) run(item + G, vb);
    }
}
__device__ __forceinline__ int scan_chunk(int j, int d) { return d == 0 ? (j < 4 ? 256 + j : j - 4) : 259 - j; }
constexpr int HS_NF = 45, HS_BUF = HS_NF * 1024, HS_SX = 3 * HS_BUF, HS_OT = HS_SX + 16384;
static_assert(HS_OT + 8192 <= LDS_XB, "HGRN2 scan LDS image");
__device__ __forceinline__ void phase_hg_scan(PP p, LAS unsigned char* lds, bool ctx_out) {
    const int tid = mk_tid(), lane = tid & 63, wid = __builtin_amdgcn_readfirstlane(tid >> 6), G = gridDim.x, r16 = lane & 15, q4 = lane >> 4;
    const int vt = wid & 1, qt = wid >> 1;
    const bf16_t* HA = wsp<const bf16_t>(p, HG_A); const bf16_t* HQT = wsp<const bf16_t>(p, HG_QT); const bf16_t* HKT = wsp<const bf16_t>(p, HG_KT); const float* HD = wsp<const float>(p, HG_D);
    const bf16_t* HV = wsp<const bf16_t>(p, HG_V); bf16_t* HO = wsp<bf16_t>(p, HG_O);
    LAS bf16x8* Sx = (LAS bf16x8*)(lds + HS_SX);
    for (int it = mk_bid(); it < 256; it += G) {
        const int hd = (it & 7) * 4 + (it >> 6), vs = (it >> 3) & 7, d = hd >> 4, h = hd & 15;
        const bool zfa = d ? (wid == 4 || wid == 6) : (wid == 1 || wid == 3);
        auto dma_set = [&](int j, int b) {
            const int c = scan_chunk(j < NCH ? j : NCH - 1, d);
            const size_t itemc = (size_t)hd * NCH + c;
            LAS unsigned char* im = lds + b * HS_BUF;
#define HS_DMA(src, fi) __builtin_amdgcn_global_load_lds((const unsigned*)(src), (LAS unsigned*)(im + (fi) * 1024), 16, 0, 0)
            const bf16_t* dp0 = (const bf16_t*)(HD + itemc * 128) + (lane < 32 ? lane : 31) * 8;
            HS_DMA(zfa ? dp0 : HA + itemc * 4096 + (size_t)wid * 512 + lane * 8, zfa ? 44 : wid);
            HS_DMA(HQT + itemc * 8192 + (size_t)wid * 512 + lane * 8, wid + 8);
            HS_DMA(HQT + itemc * 8192 + (size_t)(wid + 8) * 512 + lane * 8, wid + 16);
            HS_DMA(HKT + itemc * 8192 + (size_t)wid * 512 + lane * 8, wid + 24);
            HS_DMA(HKT + itemc * 8192 + (size_t)(wid + 8) * 512 + lane * 8, wid + 32);
            const bf16_t* vtp = HV + (size_t)(hg_chunk_row(c) + (wid & 3) * 16 + (lane >> 2)) * D + h * 256 + vs * 32 + (lane & 3) * 8;
            const bf16_t* dp = (const bf16_t*)(HD + itemc * 128) + (lane < 32 ? lane : 31) * 8;
            HS_DMA(wid < 4 ? vtp : dp, wid < 4 ? 40 + wid : 44);
#undef HS_DMA
        };
        f32x4 S0 = {0.f, 0.f, 0.f, 0.f}, S1 = {0.f, 0.f, 0.f, 0.f};
        __syncthreads();
        if (zfa) {
#pragma unroll
            for (int b3 = 0; b3 < 3; ++b3) { unsigned zz = 0u; asm volatile("" : "+v"(zz)); *(LAS u32x4*)(lds + b3 * HS_BUF + wid * 1024 + lane * 16) = (u32x4){zz, zz, zz, zz}; }
        }
        dma_set(0, 0); dma_set(1, 1);
        { unsigned zz = 0u; asm volatile("" : "+v"(zz)); ((LAS u32x4*)(lds + HS_SX))[(vt * 4 + qt) * 64 + lane] = (u32x4){zz, zz, zz, zz}; }
        asm volatile("s_waitcnt vmcnt(6)" ::: "memory");
        lds_barrier();
        int buf = 0, ib = 0;
        auto flush_o = [&](int j) {
            const int c = scan_chunk(j, d);
            if (ctx_out || c < 256) {
                const int row = 16 * wid + (lane >> 2), piece = lane & 3;
                const u32x4 v = *(LAS const u32x4*)(lds + HS_OT + (j & 1) * 4096 + row * 64 + piece * 16);
                *(u32x4*)(HO + ((size_t)d * T + hg_chunk_row(c) + row) * D + h * 256 + vs * 32 + piece * 8) = v;
            }
        };
#pragma unroll 1
        for (int j = 0; j < NCH; ++j) {
            if (j > 0 && wid < 4) flush_o(j - 1);
            { const int ib2 = ib >= 1 ? ib - 1 : 2; dma_set(j + 2, ib2); }
            LAS const unsigned char* im = lds + ib * HS_BUF;
#define HS_FR(fi) (*(LAS const bf16x8*)(im + (fi) * 1024 + lane * 16))
            const unsigned vtb = (unsigned)(size_t)(im + 40 * 1024) + (unsigned)(((lane >> 4) * 8 + ((lane & 15) >> 2)) * 64 + (vt * 16 + 4 * (lane & 3)) * 2);
            s16x4 t00, t01, t10, t11;
            asm volatile("ds_read_b64_tr_b16 %0, %1" : "=&v"(t00) : "v"(vtb) : "memory");
            asm volatile("ds_read_b64_tr_b16 %0, %1 offset:256" : "=&v"(t01) : "v"(vtb) : "memory");
            asm volatile("ds_read_b64_tr_b16 %0, %1 offset:2048" : "=&v"(t10) : "v"(vtb) : "memory");
            asm volatile("ds_read_b64_tr_b16 %0, %1 offset:2304" : "=&v"(t11) : "v"(vtb) : "memory");
            const bf16x8 a0 = HS_FR(qt * 2), a1 = HS_FR(qt * 2 + 1);
            bf16x8 sb[4], qf[4];
#pragma unroll
            for (int kk = 0; kk < 4; ++kk) { sb[kk] = Sx[((buf * 2 + vt) * 4 + kk) * 64 + lane]; qf[kk] = HS_FR(8 + qt * 4 + kk); }
            const bf16x8 k00 = HS_FR(24 + (2 * qt) * 2), k01 = HS_FR(24 + (2 * qt) * 2 + 1), k10 = HS_FR(24 + (2 * qt + 1) * 2), k11 = HS_FR(24 + (2 * qt + 1) * 2 + 1);
            const f32x4 dv0 = *(LAS const f32x4*)(im + 44 * 1024 + ((2 * qt) * 16 + 4 * q4) * 4), dv1 = *(LAS const f32x4*)(im + 44 * 1024 + ((2 * qt + 1) * 16 + 4 * q4) * 4);
#undef HS_FR
            asm volatile("s_waitcnt lgkmcnt(0)" ::: "memory");
            __builtin_amdgcn_sched_barrier(0);
            const bf16x8 bv0 = {t00[0], t00[1], t00[2], t00[3], t01[0], t01[1], t01[2], t01[3]}, bv1 = {t10[0], t10[1], t10[2], t10[3], t11[0], t11[1], t11[2], t11[3]};
            f32x4 accq = {0.f, 0.f, 0.f, 0.f}, acca = {0.f, 0.f, 0.f, 0.f};
#pragma unroll
            for (int kk = 0; kk < 4; ++kk) accq = __builtin_amdgcn_mfma_f32_16x16x32_bf16(qf[kk], sb[kk], accq, 0, 0, 0);
            acca = __builtin_amdgcn_mfma_f32_16x16x32_bf16(a0, bv0, acca, 0, 0, 0); acca = __builtin_amdgcn_mfma_f32_16x16x32_bf16(a1, bv1, acca, 0, 0, 0);
            S0 = dv0 * S0; S1 = dv1 * S1;
            S0 = __builtin_amdgcn_mfma_f32_16x16x32_bf16(k00, bv0, S0, 0, 0, 0); S0 = __builtin_amdgcn_mfma_f32_16x16x32_bf16(k01, bv1, S0, 0, 0, 0);
            S1 = __builtin_amdgcn_mfma_f32_16x16x32_bf16(k10, bv0, S1, 0, 0, 0); S1 = __builtin_amdgcn_mfma_f32_16x16x32_bf16(k11, bv1, S1, 0, 0, 0);
            u32x4 sw; sw.x = cvt_pk_bf16_n(S0[0], S0[1]); sw.y = cvt_pk_bf16_n(S0[2], S0[3]); sw.z = cvt_pk_bf16_n(S1[0], S1[1]); sw.w = cvt_pk_bf16_n(S1[2], S1[3]);
            ((LAS u32x4*)(lds + HS_SX))[(((buf ^ 1) * 2 + vt) * 4 + qt) * 64 + lane] = sw;
            const f32x4 acc = accq + acca;
#pragma unroll
            for (int i = 0; i < 4; ++i) ((LAS bf16_t*)(lds + HS_OT + (j & 1) * 4096))[(qt * 16 + 4 * q4 + i) * 32 + vt * 16 + r16] = f2bf_n(acc[i]);
            asm volatile("s_waitcnt vmcnt(6)" ::: "memory");
            lds_barrier();
            buf ^= 1; ib = ib == 2 ? 0 : ib + 1;
        }
        if (wid < 4) flush_o(NCH - 1);
        asm volatile("s_waitcnt vmcnt(0)" ::: "memory");
        __syncthreads();
    }
}
struct HrRaw { u32x4 a[4], b[4], g[4]; };
__device__ __forceinline__ void unpack8u(u32x4 w, float (&o)[8]) { o[0] = bf_lo(w.x); o[1] = bf_hi(w.x); o[2] = bf_lo(w.y); o[3] = bf_hi(w.y); o[4] = bf_lo(w.z); o[5] = bf_hi(w.z); o[6] = bf_lo(w.w); o[7] = bf_hi(w.w); }
__device__ __forceinline__ void phase_hg_readout(PP p, LAS unsigned char* lds, int j, bool ctx_out) {
    const int tid = mk_tid(), lane = tid & 63, wid = __builtin_amdgcn_readfirstlane(tid >> 6), G = gridDim.x, bid = mk_bid();
    const bf16_t* O0 = wsp<const bf16_t>(p, HG_O); const bf16_t* O1 = O0 + (size_t)T * D; const bf16_t* SG = wsp<const bf16_t>(p, HG_SG);
    bf16_t* Y = wsp<bf16_t>(p, WS_YB); const float* ng = p->in[I_HGNORM] + (size_t)j * D;
    {
        const unsigned c = (unsigned)(wid & 7) * 512u + (unsigned)lane * 8u; const int NB = TL / 4;
        const f32x4 n0 = *(const f32x4*)(ng + c), n1 = *(const f32x4*)(ng + c + 4u);
        LAS float* red = (LAS float*)lds;
        auto load = [&](int bt, HrRaw& w) {
            const int r0 = (bt < NB ? bt : NB - 1) * 4;
#pragma unroll
            for (int q = 0; q < 4; ++q) { const size_t ro = (size_t)(r0 + q) * D; w.a[q] = *(const u32x4*)(O0 + ro + c); w.b[q] = *(const u32x4*)(O1 + ro + c); w.g[q] = *(const u32x4*)(SG + ro + c); }
        };
        auto process = [&](int bt, const HrRaw& w, bool valid, int buf) {
            int r0 = (bt < NB ? bt : NB - 1) * 4;
            asm volatile("" : "+s"(r0));
            float v[4][8], s[4];
#pragma unroll
            for (int q = 0; q < 4; ++q) {
                float a[8], b[8]; unpack8u(w.a[q], a); unpack8u(w.b[q], b);
                float ss = 0.f;
#pragma unroll
                for (int e = 0; e < 8; ++e) { v[q][e] = a[e] + b[e]; ss += v[q][e] * v[q][e]; }
                s[q] = ss;
            }
            float t2[2], wv;
            { const bool hi = lane & 32;
#pragma unroll
              for (int k = 0; k < 2; ++k) { const float send = hi ? s[k] : s[2 + k], keep = hi ? s[2 + k] : s[k]; t2[k] = keep + xch32(send, lane); } }
            { const bool hi = lane & 16; const float send = hi ? t2[0] : t2[1], keep = hi ? t2[1] : t2[0]; wv = keep + xch16(send, lane); }
            wv = row16_all(wv, OpSum());
            if ((lane & 15) == 0) red[(buf * 8 + wid) * 4 + (lane >> 4)] = wv;
            lds_barrier();
            f32x4 tot = *(const LAS f32x4*)(red + buf * 32);
#pragma unroll
            for (int w8 = 1; w8 < 8; ++w8) tot += *(const LAS f32x4*)(red + (buf * 8 + w8) * 4);
            if (valid) {
#pragma unroll
                for (int q = 0; q < 4; ++q) {
                    const float rs = rsqrtf(tot[q] * (1.0f / D) + RMS_EPS);
                    float g[8]; unpack8u(w.g[q], g);
                    f32x4 o0, o1;
#pragma unroll
                    for (int e = 0; e < 4; ++e) { o0[e] = v[q][e] * rs * n0[e] * g[e]; o1[e] = v[q][4 + e] * rs * n1[e] * g[4 + e]; }
                    st_bf16x8(Y + (size_t)(r0 + q) * D + c, o0, o1);
                }
            }
        };
        const int nmine = bid < NB ? (NB - bid + G - 1) / G : 0;
        HrRaw ra, rb;
        __syncthreads();
        load(bid, ra);
#pragma unroll 1
        for (int i = 0; i < nmine; i += 2) {
            load(bid + (i + 1) * G, rb); process(bid + i * G, ra, true, 0);
            load(bid + (i + 2) * G, ra); process(bid + (i + 1) * G, rb, i + 1 < nmine, 1);
        }
    }
    if (ctx_out) {
        LAS float* red = (LAS float*)lds;
        for (int rr = mk_bid(); rr < TC; rr += G) {
            const int r = TL + rr, c = wid * 512 + lane * 8;
            float a[8], b[8], v[8], g[8], o[8]; float ss = 0.f;
            ld8bf(O0 + (size_t)r * D + c, a); ld8bf(O1 + (size_t)r * D + c, b); ld8bf(SG + (size_t)r * D + c, g);
#pragma unroll
            for (int e = 0; e < 8; ++e) { v[e] = a[e] + b[e]; ss += v[e] * v[e]; }
            const float ws_ = wave_sum(ss);
            __syncthreads();
            if (lane == 0) red[wid] = ws_;
            __syncthreads();
            float tot = 0.f;
#pragma unroll
            for (int w = 0; w < 8; ++w) tot += red[w];
            const float rs = rsqrtf(tot * (1.0f / D) + RMS_EPS);
            const f32x4 n0 = *(const f32x4*)(ng + c), n1 = *(const f32x4*)(ng + c + 4);
#pragma unroll
            for (int e = 0; e < 8; ++e) o[e] = v[e] * rs * (e < 4 ? n0[e] : n1[e - 4]) * g[e];
            u32x4 w; w.x = cvt_pk_bf16(o[0], o[1]); w.y = cvt_pk_bf16(o[2], o[3]); w.z = cvt_pk_bf16(o[4], o[5]); w.w = cvt_pk_bf16(o[6], o[7]);
            *(u32x4*)(Y + (size_t)r * D + c) = w;
        }
    }
}

__device__ __forceinline__ void phase_mb_prep(PP p, LAS unsigned char* lds) {
    const int tid = mk_tid(), lane = tid & 63, wid = tid >> 6, G = gridDim.x, r16 = lane & 15, q4 = lane >> 4, bid = mk_bid();
    const bf16_t* XBC = wsp<const bf16_t>(p, MB_XBC); bf16_t* XSo = wsp<bf16_t>(p, MB_XS); const float* DTR = wsp<const float>(p, MB_DT);
    const float* cw = p->in[I_SSMCW]; const float* cb = p->in[I_SSMCB];
    bf16_t* MG = wsp<bf16_t>(p, MB_G); bf16_t* MCP = wsp<bf16_t>(p, MB_CP); bf16_t* MBT = wsp<bf16_t>(p, MB_BT); bf16_t* MXT = wsp<bf16_t>(p, MB_XT); float* MGV = wsp<float>(p, MB_GV); float* MDTC = wsp<float>(p, MB_DTC);
    constexpr int RS = 272;
    for (int item = bid; item < 8 * NCH; item += G) {
        const int c = item % NCH, g = item / NCH, rb = hg_chunk_row(c);
        const int row = tid >> 3, seg = tid & 7;
        {
            const int sg = tid & 15, r32 = tid >> 4, s0 = rb < TL ? 0 : TL, s1 = rb < TL ? TL : T;
            __syncthreads();
#pragma unroll
            for (int op = 0; op < 2; ++op) {
                const int ch = (op == 0 ? 9216 : 8192) + g * 128 + sg * 8;
                const f32x4 wa0 = *(const f32x4*)(cw + ch), wa1 = *(const f32x4*)(cw + ch + 4), wb0 = *(const f32x4*)(cw + 10240 + ch), wb1 = *(const f32x4*)(cw + 10240 + ch + 4);
                const f32x4 wc0 = *(const f32x4*)(cw + 20480 + ch), wc1 = *(const f32x4*)(cw + 20480 + ch + 4), bb0 = *(const f32x4*)(cb + ch), bb1 = *(const f32x4*)(cb + ch + 4);
#pragma unroll
                for (int hr = 0; hr < 2; ++hr) {
                    const int rw = r32 + 32 * hr, t = rb + rw;
                    const float mm = t - 1 >= s0 ? 1.f : 0.f, mp = t + 1 < s1 ? 1.f : 0.f;
                    const u32x4 um = *(const u32x4*)(XBC + (size_t)(t - 1 >= s0 ? t - 1 : t) * 10240 + ch), u0 = *(const u32x4*)(XBC + (size_t)t * 10240 + ch), up = *(const u32x4*)(XBC + (size_t)(t + 1 < s1 ? t + 1 : t) * 10240 + ch);
                    float xm[8], x0[8], xp[8]; unpack8u(um, xm); unpack8u(u0, x0); unpack8u(up, xp);
                    f32x4 h0, h1;
#pragma unroll
                    for (int e = 0; e < 4; ++e) {
                        h0[e] = siluf_(bb0[e] + wa0[e] * (xm[e] * mm) + wb0[e] * x0[e] + wc0[e] * (xp[e] * mp)); h1[e] = siluf_(bb1[e] + wa1[e] * (xm[4 + e] * mm) + wb1[e] * x0[4 + e] + wc1[e] * (xp[4 + e] * mp));
                    }
                    u32x4 hw; hw.x = cvt_pk_bf16(h0[0], h0[1]); hw.y = cvt_pk_bf16(h0[2], h0[3]); hw.z = cvt_pk_bf16(h1[0], h1[1]); hw.w = cvt_pk_bf16(h1[2], h1[3]);
                    *(LAS u32x4*)(lds + (size_t)(op * 64 + rw) * RS + sg * 16) = hw;
                }
            }
            __syncthreads();
        }
        const u32x4 c0 = *(const LAS u32x4*)(lds + (size_t)row * RS + seg * 32), c1 = *(const LAS u32x4*)(lds + (size_t)row * RS + seg * 32 + 16);
        {
            const int blk = seg >> 1, hi = seg & 1;
            bf16_t* cp = MCP + (size_t)item * 8192; const int p0 = blk * 32 + hi * 4;
            *(u32x2*)(cp + frag_off<128>(row, p0)) = (u32x2){c0.x, c0.y}; *(u32x2*)(cp + frag_off<128>(row, p0 + 8)) = (u32x2){c0.z, c0.w};
            *(u32x2*)(cp + frag_off<128>(row, p0 + 16)) = (u32x2){c1.x, c1.y}; *(u32x2*)(cp + frag_off<128>(row, p0 + 24)) = (u32x2){c1.z, c1.w};
        }
        __syncthreads();
#pragma unroll 1
        for (int tile = wid; tile < 16; tile += 8) {
            const int tt = tile >> 2, st = tile & 3;
            f32x4 acc = {0.f, 0.f, 0.f, 0.f};
#pragma unroll
            for (int kk = 0; kk < 4; ++kk) {
                const bf16x8 av = *(const LAS bf16x8*)(lds + (size_t)(tt * 16 + r16) * RS + kk * 64 + q4 * 16);
                const bf16x8 bv = *(const LAS bf16x8*)(lds + (size_t)(64 + st * 16 + r16) * RS + kk * 64 + q4 * 16);
                acc = __builtin_amdgcn_mfma_f32_16x16x32_bf16(av, bv, acc, 0, 0, 0);
            }
#pragma unroll
            for (int i = 0; i < 4; ++i) MG[(size_t)item * 4096 + frag_off<64>(tt * 16 + 4 * q4 + i, st * 16 + r16)] = f2bf_n(acc[i]);
        }
        {
            const int n = tid & 127, part = tid >> 7;
            unsigned w[8];
#pragma unroll
            for (int j = 0; j < 8; ++j) {
                const unsigned lo = *(const LAS bf16_t*)(lds + (size_t)(64 + part * 16 + 2 * j) * RS + n * 2), hi = *(const LAS bf16_t*)(lds + (size_t)(64 + part * 16 + 2 * j + 1) * RS + n * 2);
                w[j] = lo | (hi << 16);
            }
            bf16_t* bp = MBT + (size_t)item * 8192;
            *(u32x4*)(bp + frag_off<64>(n, part * 16)) = (u32x4){w[0], w[1], w[2], w[3]}; *(u32x4*)(bp + frag_off<64>(n, part * 16 + 8)) = (u32x4){w[4], w[5], w[6], w[7]};
        }
    }
    {
        __syncthreads();
        constexpr int RSX = 144, NI = 128 * NCH;
        const int wv = __builtin_amdgcn_readfirstlane(wid), sgx = lane & 7;
        LAS unsigned char* wl = lds + wv * (66 * RSX);
        struct XRaw { u32x4 r[8]; u32x4 h; };
        int hdw = -1; f32x4 wa0, wa1, wb0, wb1, wc0, wc1, bb0, bb1;
        auto loadx = [&](int i, XRaw& w) {
            const int ii = i < NI ? i : NI - 1, c = ii >> 7, hd = ii & 127, rb = hg_chunk_row(c), s0 = rb < TL ? 0 : TL, s1 = rb < TL ? TL : T;
            const bf16_t* src = XBC + hd * 64 + sgx * 8;
#pragma unroll
            for (int k = 0; k < 8; ++k) w.r[k] = *(const u32x4*)(src + (size_t)(rb + k * 8 + (lane >> 3)) * 10240);
            const int hr = (lane & 8) ? (rb + 64 < s1 ? rb + 64 : s1 - 1) : (rb - 1 >= s0 ? rb - 1 : s0);
            w.h = *(const u32x4*)(src + (size_t)hr * 10240);
        };
        auto procx = [&](int i, const XRaw& w) {
#pragma unroll
            for (int k = 0; k < 8; ++k) *(LAS u32x4*)(wl + (1 + k * 8 + (lane >> 3)) * RSX + sgx * 16) = w.r[k];
            if (lane < 16) *(LAS u32x4*)(wl + ((lane & 8) ? 65 : 0) * RSX + sgx * 16) = w.h;
            if (i < NI) {
                const int c = i >> 7, hd = i & 127, rb = hg_chunk_row(c), s0 = rb < TL ? 0 : TL, s1 = rb < TL ? TL : T, ch = hd * 64 + sgx * 8;
                if (hd != hdw) {
                    hdw = hd;
                    wa0 = *(const f32x4*)(cw + ch); wa1 = *(const f32x4*)(cw + ch + 4); wb0 = *(const f32x4*)(cw + 10240 + ch); wb1 = *(const f32x4*)(cw + 10240 + ch + 4);
                    wc0 = *(const f32x4*)(cw + 20480 + ch); wc1 = *(const f32x4*)(cw + 20480 + ch + 4); bb0 = *(const f32x4*)(cb + ch); bb1 = *(const f32x4*)(cb + ch + 4);
                }
                const float mf = rb - 1 >= s0 ? 1.f : 0.f, ml = rb + 64 < s1 ? 1.f : 0.f;
                u32x4 hv[8];
#pragma unroll
                for (int k = 0; k < 8; ++k) {
                    const int rw = k * 8 + (lane >> 3);
                    const u32x4 um = *(const LAS u32x4*)(wl + rw * RSX + sgx * 16), up = *(const LAS u32x4*)(wl + (rw + 2) * RSX + sgx * 16);
                    const float mm = rw > 0 ? 1.f : mf, mp = rw < 63 ? 1.f : ml;
                    float xm[8], x0[8], xp[8]; unpack8u(um, xm); unpack8u(w.r[k], x0); unpack8u(up, xp);
                    f32x4 h0, h1;
#pragma unroll
                    for (int e = 0; e < 4; ++e) {
                        h0[e] = siluf_(bb0[e] + wa0[e] * (xm[e] * mm) + wb0[e] * x0[e] + wc0[e] * (xp[e] * mp)); h1[e] = siluf_(bb1[e] + wa1[e] * (xm[4 + e] * mm) + wb1[e] * x0[4 + e] + wc1[e] * (xp[4 + e] * mp));
                    }
                    hv[k].x = cvt_pk_bf16(h0[0], h0[1]); hv[k].y = cvt_pk_bf16(h0[2], h0[3]); hv[k].z = cvt_pk_bf16(h1[0], h1[1]); hv[k].w = cvt_pk_bf16(h1[2], h1[3]);
                }
#pragma unroll
                for (int k = 0; k < 8; ++k) {
                    const int rw = k * 8 + (lane >> 3);
                    *(LAS u32x4*)(wl + (1 + rw) * RSX + sgx * 16) = hv[k];
                    *(u32x4*)(XSo + (size_t)(rb + rw) * 8192 + ch) = hv[k];
                }
                bf16_t* xp_ = MXT + (size_t)(hd * NCH + c) * 4096;
#pragma unroll
                for (int part = 0; part < 8; ++part) {
                    unsigned wq[4];
#pragma unroll
                    for (int j = 0; j < 4; ++j) {
                        const unsigned lo = *(const LAS bf16_t*)(wl + (1 + part * 8 + 2 * j) * RSX + lane * 2), hi = *(const LAS bf16_t*)(wl + (1 + part * 8 + 2 * j + 1) * RSX + lane * 2);
                        wq[j] = lo | (hi << 16);
                    }
                    *(u32x4*)(xp_ + frag_off<64>(lane, part * 8)) = (u32x4){wq[0], wq[1], wq[2], wq[3]};
                }
            }
        };
        const int i0 = bid * 8 + wv, st = G * 8;
        XRaw xa, xb;
        loadx(i0, xa);
#pragma unroll 1
        for (int i = i0; i < NI; i += 2 * st) { loadx(i + st, xb); procx(i, xa); loadx(i + 2 * st, xa); procx(i + st, xb); }
    }
    for (int item0 = (bid * 8 + wid) * 4; item0 < 256 * NCH; item0 += G * 8 * 4) {
        float dtv[4], gsum[4]; int tt[4];
#pragma unroll
        for (int u = 0; u < 4; ++u) {
            const int item = item0 + u, c = item % NCH, dh = item / NCH, d = dh >> 7, hd = dh & 127, rb = hg_chunk_row(c);
            tt[u] = d ? 63 - lane : lane;
            { const float x = DTR[(size_t)(rb + tt[u]) * 256 + d * 128 + hd] + p->in[I_SSMDTB][d * 128 + hd]; dtv[u] = x > 20.f ? x : __logf(1.0f + __expf(x)); }
            gsum[u] = dtv[u] * -__expf(p->in[I_SSMALOG][d * 128 + hd]);
        }
#pragma unroll
        for (int u = 0; u < 4; ++u) {
#pragma unroll
            for (int o = 1; o < 64; o <<= 1) { const float x = __int_as_float(__builtin_amdgcn_ds_bpermute((lane - o) << 2, __float_as_int(gsum[u]))); if (lane >= o) gsum[u] += x; }
            MGV[(size_t)(item0 + u) * 64 + tt[u]] = gsum[u]; MDTC[(size_t)(item0 + u) * 64 + tt[u]] = dtv[u];
        }
    }
}
__device__ __forceinline__ bf16x8 pack8(const float (&v)[8]) {
    u32x4 w; w.x = cvt_pk_bf16_n(v[0], v[1]); w.y = cvt_pk_bf16_n(v[2], v[3]); w.z = cvt_pk_bf16_n(v[4], v[5]); w.w = cvt_pk_bf16_n(v[6], v[7]);
    return __builtin_bit_cast(bf16x8, w);
}
__device__ __forceinline__ void unpack8(bf16x8 x, float (&o)[8]) {
    const u32x4 w = __builtin_bit_cast(u32x4, x);
    o[0] = bf_lo(w.x); o[1] = bf_hi(w.x); o[2] = bf_lo(w.y); o[3] = bf_hi(w.y); o[4] = bf_lo(w.z); o[5] = bf_hi(w.z); o[6] = bf_lo(w.w); o[7] = bf_hi(w.w);
}
struct MsOps { bf16x8 fr[4]; };
struct MsIn  { bf16x8 f[2]; };
constexpr int MS_YT = 34816, MS_DV = 51200;
__device__ __forceinline__ void phase_mb_scan(PP p, LAS unsigned char* lds, bool ctx_out) {
    const int tid = mk_tid(), lane = tid & 63, wid = __builtin_amdgcn_readfirstlane(tid >> 6), G = gridDim.x, r16 = lane & 15, q4 = lane >> 4;
    const int tq = wid & 3, ph = wid >> 2;
    const bf16_t* MG = wsp<const bf16_t>(p, MB_G); const bf16_t* MCP = wsp<const bf16_t>(p, MB_CP); const bf16_t* MBT = wsp<const bf16_t>(p, MB_BT); const bf16_t* MXT = wsp<const bf16_t>(p, MB_XT);
    const float* MGV = wsp<const float>(p, MB_GV); const float* MDTC = wsp<const float>(p, MB_DTC); bf16_t* MY = wsp<bf16_t>(p, MB_Y);
    LAS bf16x8* Sx = (LAS bf16x8*)lds;
    LAS float* VX = (LAS float*)(lds + 32768);
    for (int it = mk_bid(); it < 256; it += G) {
        const int g = it & 7, d = (it >> 3) & 1, hd = g * 16 + (it >> 4);
        auto load_ops = [&](int j, MsOps& o) {
            const int c = scan_chunk(j < NCH ? j : NCH - 1, d);
            const size_t gc = (size_t)g * NCH + c;
            const bf16_t* src = wid < 4 ? MCP + gc * 8192 + (size_t)(wid * 4) * 512 : MBT + gc * 8192 + (size_t)((wid - 4) * 4) * 512;
#pragma unroll
            for (int k = 0; k < 4; ++k) o.fr[k] = *(const bf16x8*)(src + (size_t)k * 512 + lane * 8);
        };
        auto load_in = [&](int j, MsIn& v) {
            const int c = scan_chunk(j < NCH ? j : NCH - 1, d);
            const size_t gc = (size_t)g * NCH + c, hc = (size_t)hd * NCH + c;
            const bf16_t* src = wid < 4 ? MXT + hc * 4096 + (size_t)(wid * 2) * 512 : MG + gc * 4096 + (size_t)((wid - 4) * 2) * 512;
#pragma unroll
            for (int ks = 0; ks < 2; ++ks) v.f[ks] = *(const bf16x8*)(src + (size_t)ks * 512 + lane * 8);
        };
        auto derive = [&](int b, const MsIn& v, int vb) {
            LAS unsigned char* im = lds + MS_DV + b * 24576;
            LAS const float* gv = VX + vb * 128;
            const float gtot = gv[d ? 0 : 63], gt = gv[((wid - 4) & 3) * 16 + r16];
#pragma unroll
            for (int ks = 0; ks < 2; ++ks) {
                float x[8], gs[8];
                unpack8(v.f[ks], x);
                const f32x4 ga = *(LAS const f32x4*)(gv + ks * 32 + 8 * q4), gb = *(LAS const f32x4*)(gv + ks * 32 + 8 * q4 + 4);
#pragma unroll
                for (int jj = 0; jj < 8; ++jj) gs[jj] = jj < 4 ? ga[jj & 3] : gb[jj & 3];
                if (wid < 4) {
                    const f32x4 da = *(LAS const f32x4*)(gv + 64 + ks * 32 + 8 * q4), db = *(LAS const f32x4*)(gv + 64 + ks * 32 + 8 * q4 + 4);
                    float xd[8], xc[8];
#pragma unroll
                    for (int jj = 0; jj < 8; ++jj) { const float dtv = jj < 4 ? da[jj & 3] : db[jj & 3]; xd[jj] = x[jj] * dtv; xc[jj] = xd[jj] * __expf(gtot - gs[jj]); }
                    *(LAS bf16x8*)(im + (wid * 2 + ks) * 1024 + lane * 16) = pack8(xd);
                    *(LAS bf16x8*)(im + (8 + wid * 2 + ks) * 1024 + lane * 16) = pack8(xc);
                } else {
                    const int t = (wid - 4) * 16 + r16; float w[8];
#pragma unroll
                    for (int jj = 0; jj < 8; ++jj) { const int s = ks * 32 + 8 * q4 + jj; const bool keep = d ? (s >= t) : (s <= t); w[jj] = keep ? x[jj] * __expf(gt - gs[jj]) : 0.f; }
                    *(LAS bf16x8*)(im + (16 + (wid - 4) * 2 + ks) * 1024 + lane * 16) = pack8(w);
                }
            }
        };
        auto load_vec = [&](int j) -> float {
            const int c = scan_chunk(j < NCH ? j : NCH - 1, d);
            const size_t dhc = ((size_t)d * 128 + hd) * NCH + c;
            return *(wid == 1 ? MDTC + dhc * 64 + lane : MGV + dhc * 64 + lane);
        };
        f32x4 S[2][4];
#pragma unroll
        for (int a = 0; a < 2; ++a)
#pragma unroll
            for (int b = 0; b < 4; ++b) S[a][b] = (f32x4){0.f, 0.f, 0.f, 0.f};
        MsOps o0, o1; MsIn ia, ib;
        load_in(0, ia); load_in(1, ib); load_ops(0, o0);
        float vnext = 0.f, vn1 = 0.f;
        vnext = load_vec(0); vn1 = load_vec(1);
        __syncthreads();
#pragma unroll
        for (int b = 0; b < 2; ++b) { unsigned zz = 0u; asm volatile("" : "+v"(zz)); ((LAS u32x4*)lds)[((2 * ph + b) * 4 + tq) * 64 + lane] = (u32x4){zz, zz, zz, zz}; }
        if (wid < 2) { VX[wid * 64 + lane] = vnext; VX[128 + wid * 64 + lane] = vn1; }
        __syncthreads();
        derive(0, ia, 0);
        __syncthreads();
        int vcur = 0;
        int buf = 0;
        auto flush_y = [&](int j) {
            const int c = scan_chunk(j, d);
            if (ctx_out || c < 256) {
                const int row = 8 * wid + (lane >> 3), piece = lane & 7;
                const u32x4 v = *(LAS const u32x4*)(lds + MS_YT + (j & 1) * 8192 + row * 128 + piece * 16);
                *(u32x4*)(MY + ((size_t)d * T + hg_chunk_row(c) + row) * 8192 + hd * 64 + piece * 8) = v;
            }
        };
        auto step = [&](int j, const MsOps& u, MsOps& ld, const MsIn& inx, MsIn& inl) {
            load_ops(j + 1, ld);
            load_in(j + 2, inl);
            vnext = load_vec(j + 2);
            if (j > 0) flush_y(j - 1);
            const int vn = vcur == 2 ? 0 : vcur + 1, vn2 = vn == 2 ? 0 : vn + 1;
            LAS const float* gv = VX + vcur * 128;
            LAS const unsigned char* im = lds + MS_DV + buf * 24576;
#define MS_FR(fi) (*(LAS const bf16x8*)(im + (fi) * 1024 + lane * 16))
            if (wid < 4) {
                const int tl = wid * 16;
                const f32x4 gr = *(LAS const f32x4*)(gv + tl + 4 * q4);
                const f32x4 eg = {__expf(gr[0]), __expf(gr[1]), __expf(gr[2]), __expf(gr[3])};
                const bf16x8 wA0 = MS_FR(16 + wid * 2), wA1 = MS_FR(16 + wid * 2 + 1);
                bf16x8 sb[4][4], xf[4][2];
#pragma unroll
                for (int pj = 0; pj < 4; ++pj) {
#pragma unroll
                    for (int kk = 0; kk < 4; ++kk) sb[pj][kk] = Sx[((buf * 4 + pj) * 4 + kk) * 64 + lane];
                    xf[pj][0] = MS_FR(pj * 2); xf[pj][1] = MS_FR(pj * 2 + 1);
                }
                __builtin_amdgcn_sched_barrier(0);
                f32x4 acc[4];
#pragma unroll
                for (int pj = 0; pj < 4; ++pj) acc[pj] = (f32x4){0.f, 0.f, 0.f, 0.f};
#pragma unroll
                for (int kk = 0; kk < 4; ++kk)
#pragma unroll
                    for (int pj = 0; pj < 4; ++pj) acc[pj] = __builtin_amdgcn_mfma_f32_16x16x32_bf16(u.fr[kk], sb[pj][kk], acc[pj], 0, 0, 0);
#pragma unroll
                for (int pj = 0; pj < 4; ++pj) acc[pj] = acc[pj] * eg;
#pragma unroll
                for (int pj = 0; pj < 4; ++pj) acc[pj] = __builtin_amdgcn_mfma_f32_16x16x32_bf16(wA0, xf[pj][0], acc[pj], 0, 0, 0);
#pragma unroll
                for (int pj = 0; pj < 4; ++pj) acc[pj] = __builtin_amdgcn_mfma_f32_16x16x32_bf16(wA1, xf[pj][1], acc[pj], 0, 0, 0);
#pragma unroll
                for (int pj = 0; pj < 4; ++pj)
#pragma unroll
                    for (int i = 0; i < 4; ++i) ((LAS bf16_t*)(lds + MS_YT + (j & 1) * 8192))[(tl + 4 * q4 + i) * 64 + pj * 16 + r16] = f2bf_n(acc[pj][i]);
            } else {
                const float Dc = __expf(gv[d ? 0 : 63]);
                bf16x8 xc[4][2];
#pragma unroll
                for (int pj = 0; pj < 4; ++pj) { xc[pj][0] = MS_FR(8 + pj * 2); xc[pj][1] = MS_FR(8 + pj * 2 + 1); }
                __builtin_amdgcn_sched_barrier(0);
#pragma unroll
                for (int pj = 0; pj < 4; ++pj)
#pragma unroll
                    for (int a = 0; a < 2; ++a) S[a][pj] = Dc * S[a][pj];
#pragma unroll
                for (int h2 = 0; h2 < 2; ++h2)
#pragma unroll
                    for (int pj = 0; pj < 4; ++pj)
#pragma unroll
                        for (int a = 0; a < 2; ++a) S[a][pj] = __builtin_amdgcn_mfma_f32_16x16x32_bf16(u.fr[a * 2 + h2], xc[pj][h2], S[a][pj], 0, 0, 0);
            }
#undef MS_FR
            derive(buf ^ 1, inx, vn);
            if (wid >= 4) {
#pragma unroll
                for (int pj = 0; pj < 4; ++pj) {
                    u32x4 sw; sw.x = cvt_pk_bf16_n(S[0][pj][0], S[0][pj][1]); sw.y = cvt_pk_bf16_n(S[0][pj][2], S[0][pj][3]); sw.z = cvt_pk_bf16_n(S[1][pj][0], S[1][pj][1]); sw.w = cvt_pk_bf16_n(S[1][pj][2], S[1][pj][3]);
                    ((LAS u32x4*)lds)[(((buf ^ 1) * 4 + pj) * 4 + (wid - 4)) * 64 + lane] = sw;
                }
            }
            if (wid < 2) VX[vn2 * 128 + wid * 64 + lane] = vnext;
            lds_barrier();
            buf ^= 1; vcur = vn;
        };
#pragma unroll 1
        for (int j = 0; j < NCH; j += 2) { step(j, o0, o1, ib, ia); step(j + 1, o1, o0, ia, ib); }
        flush_y(NCH - 1);
    }
}
struct MrRaw { u32x4 a[2], b[2], x[2], z[2]; };
__device__ __forceinline__ void phase_mb_readout(PP p) {
    const int tid = mk_tid(), lane = tid & 63, wid = __builtin_amdgcn_readfirstlane(tid >> 6), G = gridDim.x, bid = mk_bid();
    const bf16_t* Y0 = wsp<const bf16_t>(p, MB_Y); const bf16_t* Y1 = Y0 + (size_t)T * 8192; const bf16_t* XS = wsp<const bf16_t>(p, MB_XS); const bf16_t* Z = wsp<const bf16_t>(p, MB_Z);
    bf16_t* Y = wsp<bf16_t>(p, WS_YB); const float* ng = p->in[I_SSMNORM]; const float* dsk = p->in[I_SSMD];
    const unsigned c = (unsigned)(wid & 7) * 1024u + (unsigned)lane * 8u;
    f32x4 n[2][2]; float dk[2];
#pragma unroll
    for (int i = 0; i < 2; ++i) { n[i][0] = *(const f32x4*)(ng + c + i * 512u); n[i][1] = *(const f32x4*)(ng + c + i * 512u + 4u); dk[i] = dsk[(c + i * 512u) >> 6]; }
    auto load = [&](int i, MrRaw& w) {
        const int r = bid + i * G; const size_t ro = (size_t)(r < T ? r : T - 1) * 8192;
#pragma unroll
        for (int h = 0; h < 2; ++h) { w.a[h] = *(const u32x4*)(Y0 + ro + c + h * 512u); w.b[h] = *(const u32x4*)(Y1 + ro + c + h * 512u); w.x[h] = *(const u32x4*)(XS + ro + c + h * 512u); w.z[h] = *(const u32x4*)(Z + ro + c + h * 512u); }
    };
    auto process = [&](int i, const MrRaw& w) {
        int r = bid + i * G;
        asm volatile("" : "+s"(r));
        float v[2][8]; float ss = 0.f;
#pragma unroll
        for (int h = 0; h < 2; ++h) {
            float a[8], b[8], x[8], z[8]; unpack8u(w.a[h], a); unpack8u(w.b[h], b); unpack8u(w.x[h], x); unpack8u(w.z[h], z);
#pragma unroll
            for (int e = 0; e < 8; ++e) { const float y = (a[e] + b[e] + dk[h] * x[e]) * siluf_(z[e]); v[h][e] = y; ss += y * y; }
        }
        const float rs = rsqrtf(wave_sum(ss) * (1.0f / 1024.0f) + RMS_EPS);
        if (r < T) {
#pragma unroll
            for (int h = 0; h < 2; ++h) {
                f32x4 o0, o1;
#pragma unroll
                for (int e = 0; e < 4; ++e) { o0[e] = v[h][e] * rs * n[h][0][e]; o1[e] = v[h][4 + e] * rs * n[h][1][e]; }
                st_bf16x8(Y + (size_t)r * 8192 + c + h * 512u, o0, o1);
            }
        }
    };
    const int nmine = bid < T ? (T - bid + G - 1) / G : 0;
    MrRaw ra, rb, rc;
    load(0, ra); load(1, rb);
#pragma unroll 1
    for (int i = 0; i < nmine; i += 3) {
        load(i + 2, rc); process(i, ra);
        load(i + 3, ra); process(i + 1, rb);
        load(i + 4, rb); process(i + 2, rc);
    }
}

struct QkRaw { u32x4 x[10]; f32x2 cs[4]; };
__device__ __forceinline__ void phase_at_qknorm(PP p) {
    const int tid = mk_tid(), lane = tid & 63, wid = __builtin_amdgcn_readfirstlane(tid >> 6), G = gridDim.x, bid = mk_bid();
    const int sub = lane >> 4, l16 = lane & 15;
    bf16_t* Qb = wsp<bf16_t>(p, AT_Q); bf16_t* Kb = wsp<bf16_t>(p, AT_K);
    const float* rope = wsp<const float>(p, WS_ROPE);
    float gq[8], gk[8];
#pragma unroll
    for (int e = 0; e < 8; ++e) { gq[e] = p->in[I_ATQN][l16 * 8 + e]; gk[e] = p->in[I_ATKN][l16 * 8 + e]; }
    auto piece_ptr = [&](int r, int it) -> bf16_t* {
        return it < 8 ? Qb + (size_t)r * 4096 + (it * 4 + sub) * 128 + l16 * 8 : Kb + (size_t)r * 1024 + ((it - 8) * 4 + sub) * 128 + l16 * 8;
    };
    auto one = [&](u32x4 raw, bool isq, const float (&cs)[4], const float (&sn)[4], bf16_t* ptr) {
        float x[8]; unpack8u(raw, x);
        float ss = 0.f;
#pragma unroll
        for (int e = 0; e < 8; ++e) ss += x[e] * x[e];
        ss = row16_all(ss, OpSum());
        const float rs = rsqrtf(ss * (1.0f / 128.0f) + RMS_EPS);
        float y[8], o[8];
#pragma unroll
        for (int e = 0; e < 8; ++e) y[e] = x[e] * rs * (isq ? gq[e] : gk[e]);
#pragma unroll
        for (int e2 = 0; e2 < 4; ++e2) { o[2 * e2] = y[2 * e2] * cs[e2] - y[2 * e2 + 1] * sn[e2]; o[2 * e2 + 1] = y[2 * e2] * sn[e2] + y[2 * e2 + 1] * cs[e2]; }
        u32x4 w; w.x = cvt_pk_bf16(o[0], o[1]); w.y = cvt_pk_bf16(o[2], o[3]); w.z = cvt_pk_bf16(o[4], o[5]); w.w = cvt_pk_bf16(o[6], o[7]);
        *(u32x4*)ptr = w;
    };
    const int rw0 = bid * 8 + wid, nmine = rw0 < TL ? (TL - rw0 + G * 8 - 1) / (G * 8) : 0;
    auto load = [&](int i, QkRaw& w) {
        int r = rw0 + i * G * 8; r = r < TL ? r : TL - 1;
#pragma unroll
        for (int it = 0; it < 10; ++it) w.x[it] = *(const u32x4*)piece_ptr(r, it);
        const int pos = (l16 < 8) ? (r >> 6) : (r & 63);
#pragma unroll
        for (int e2 = 0; e2 < 4; ++e2) w.cs[e2] = *(const f32x2*)(rope + (size_t)(pos * 32 + ((l16 * 4 + e2) & 31)) * 2);
    };
    auto process = [&](int i, const QkRaw& w) {
        int r = rw0 + i * G * 8;
        asm volatile("" : "+s"(r));
        if (r < TL) {
            float cs[4], sn[4];
#pragma unroll
            for (int e2 = 0; e2 < 4; ++e2) { cs[e2] = w.cs[e2][0]; sn[e2] = w.cs[e2][1]; }
#pragma unroll
            for (int it = 0; it < 10; ++it) one(w.x[it], it < 8, cs, sn, piece_ptr(r, it));
        }
    };
    {
        QkRaw ra, rb;
        load(0, ra);
#pragma unroll 1
        for (int i = 0; i < nmine; i += 2) { load(i + 1, rb); process(i, ra); load(i + 2, ra); process(i + 1, rb); }
    }
    {
        const float cs[4] = {1.f, 1.f, 1.f, 1.f}, sn[4] = {0.f, 0.f, 0.f, 0.f};
        static_assert(pg8::TailOrder::pick_sk(AT_PROJ / 256, D / 64) == 8, "q/k norm sums 8 context partial sums");
        const bf16_t* part = wsp<const bf16_t>(p, WS_PART); bf16_t* Vb = wsp<bf16_t>(p, AT_V);
        auto sum8 = [&](int rr, int col) -> u32x4 {
            u32x4 pw[8];
#pragma unroll
            for (int s = 0; s < 8; ++s) pw[s] = *(const u32x4*)(part + ((size_t)(s * 256 + rr)) * AT_PROJ + col);
            f32x4 a = {0.f, 0.f, 0.f, 0.f}, b = a;
#pragma unroll
            for (int s = 0; s < 8; ++s) { a += (f32x4){bf_lo(pw[s].x), bf_hi(pw[s].x), bf_lo(pw[s].y), bf_hi(pw[s].y)}; b += (f32x4){bf_lo(pw[s].z), bf_hi(pw[s].z), bf_lo(pw[s].w), bf_hi(pw[s].w)}; }
            u32x4 o; o.x = cvt_pk_bf16(a[0], a[1]); o.y = cvt_pk_bf16(a[2], a[3]); o.z = cvt_pk_bf16(b[0], b[1]); o.w = cvt_pk_bf16(b[2], b[3]); return o;
        };
        for (int rr = bid; rr < TC; rr += G) {
            const int r = TL + rr;
            bf16_t* pq = piece_ptr(r, wid); bf16_t* pk = piece_ptr(r, 8 + (wid & 1));
            const u32x4 xq = sum8(rr, (wid * 4 + sub) * 128 + l16 * 8);
            const int c2 = wid < 2 ? 4096 + ((wid & 1) * 4 + sub) * 128 + l16 * 8 : 5120 + (((wid - 2) & 1) * 64 + lane) * 8;
            const u32x4 x2 = sum8(rr, c2);
            if (wid < 2) one(x2, false, cs, sn, pk);
            else if (wid < 4) *(u32x4*)(Vb + (size_t)r * 1024 + ((wid - 2) * 64 + lane) * 8) = x2;
            one(xq, true, cs, sn, pq);
        }
    }
}
__device__ __forceinline__ void phase_attention(PP p, unsigned char* lds, bool ctx_out) {
    const int G = gridDim.x, b = mk_bid();
    const bf16_t* Qb = wsp<const bf16_t>(p, AT_Q); const bf16_t* Kb = wsp<const bf16_t>(p, AT_K); const bf16_t* Vb = wsp<const bf16_t>(p, AT_V);
    bf16_t* Y = wsp<bf16_t>(p, WS_YB);
    const int nit = ctx_out ? 2048 + 32 : 2048;
    for (int idx = b; idx < nit; idx += G) {
        int hq, row0, krow0, seq;
        if (idx < 2048) { const int kvh = idx & 7, li = idx >> 3; hq = kvh * 4 + (li >> 6); row0 = (li & 63) * 256; krow0 = 0; seq = T; }
        else { hq = idx - 2048; row0 = TL; krow0 = TL; seq = TC; }
        const int kvh = hq >> 2;
        att::attn_dense_body<bf16_t>(Qb + (size_t)row0 * 4096 + hq * 128, Kb + (size_t)krow0 * 1024 + kvh * 128, Vb + (size_t)krow0 * 1024 + kvh * 128,
                                     Y + (size_t)row0 * 4096 + hq * 128, seq, (char*)lds);
        __syncthreads();
    }
}
constexpr int N_PHASE = 3 + 16 * DEPTH;
__global__ void __launch_bounds__(NT, 2) mk_fwd(Params p_unused) {
    extern __shared__ __attribute__((aligned(16))) unsigned char lds[];
    LAS unsigned char* ldsl = (LAS unsigned char*)lds;
    ((LAS int*)(ldsl + LDS_WMAP))[mk_hwslot()] = (int)(threadIdx.x >> 6);
#if !MK_MULTI
    if (threadIdx.x < 4) ((LAS unsigned*)(ldsl + LDS_XB))[threadIdx.x] = 0u;
#endif
    __syncthreads();
#if !MK_MULTI
    XcdBarrier bar = xcd_barrier_post(wsp<unsigned>((PP)__builtin_amdgcn_kernarg_segment_ptr(), WS_CTL), (volatile LAS unsigned*)(ldsl + LDS_XB));
#endif
    PP kp = (PP)__builtin_amdgcn_kernarg_segment_ptr();
    const int lo = kp->ph_lo, hi = kp->ph_hi;
#ifndef MK_PROBE
#define MK_PROBE 0
#endif
#define REPS(t) ((MK_PROBE == 1 && ((t) == 3 || (t) == 8 || (t) == 9 || (t) == 12 || (t) == 13 || (t) == 19 || (t) == 21 || (t) == 23)) || (MK_PROBE == 2 && (t) == 11) || \
                 (MK_PROBE == 4 && (t) == 0) || (MK_PROBE == 5 && (t) == 4) || (MK_PROBE == 6 && (t) == 6) || (MK_PROBE == 7 && ((t) == 15 || (t) == 17)) || \
                 (MK_PROBE == 8 && ((t) == 7 || (t) == 18 || (t) == 22 || (t) == 14)) || (MK_PROBE == 9 && (t) == 15) || (MK_PROBE == 10 && (t) == 18) || (MK_PROBE == 11 && (t) == 7) || (MK_PROBE == 12 && (t) == 22) || (MK_PROBE == 13 && (t) == 14) || (MK_PROBE == 14 && (t) == 10) || (MK_PROBE == 15 && (t) == 17) || (MK_PROBE == 16 && ((t) == 20 || (t) == 24) && 0) ? 2 : 1)
#ifdef MK_ONLY
#define TAGON(t) ((t) == MK_ONLY)
#else
#define TAGON(t) true
#endif
#if MK_MULTI
#define PHASE(tag, id, body) do { if (TAGON(tag)) if (lo <= (id) && (id) < hi) { PP p = launder(kp); body; } } while (0)
#else
#define PHASE(tag, id, body) do { if (TAGON(tag)) if (lo <= (id) && (id) < hi) { for (int rep_ = 0; rep_ < REPS(tag); ++rep_) { { PP p = launder(kp); body; } if ((id) + 1 < hi) { xcd_barrier(bar); } } } } while (0)
#endif
    PHASE(0, 0, phase_prologue1(p, ldsl));
    PHASE(1, 1, phase_modreduce(p));
    PHASE(2, 2, phase_mod0(p));
#pragma unroll 1
    for (int l = 0; l < DEPTH; ++l) {
        const int kind = l % 3, j = l / 3, pb = 3 + 16 * l;
        const bool ctx_out = l < DEPTH - 1;
        const int Mo = ctx_out ? T : TL;
        if (kind == 0) {
#define F_HGIN FHgIn{wsp<bf16_t>(p, HG_QB), wsp<float>(p, HG_LF), wsp<bf16_t>(p, HG_KB), wsp<bf16_t>(p, HG_V), wsp<bf16_t>(p, HG_SG), wsp<const float>(p, WS_LB) + j * 2048}
            PHASE(3, pb + 0, run_gemm(p, ldsl, wsp<const bf16_t>(p, WS_H), wsp<const bf16_t>(p, WS_HGIN + j * SZ_HGIN), T, HG_PROJ, D, F_HGIN));
            PHASE(25, pb + 1, run_ctx_reduce(p, HG_PROJ, D, F_HGIN));
            PHASE(4, pb + 2, phase_hg_prep(p, ldsl));
            PHASE(6, pb + 4, phase_hg_scan(p, ldsl, ctx_out));
            PHASE(7, pb + 6, phase_hg_readout(p, ldsl, j, ctx_out));
            PHASE(8, pb + 7, run_gemm(p, ldsl, wsp<const bf16_t>(p, WS_YB), wsp<const bf16_t>(p, WS_HGOUT + j * SZ_SQ), Mo, D, D, FBf16{wsp<bf16_t>(p, WS_OB), D}));
        } else if (kind == 1) {
#define F_ATIN FAtIn{wsp<bf16_t>(p, AT_Q), wsp<bf16_t>(p, AT_K), wsp<bf16_t>(p, AT_V)}
            PHASE(9, pb + 0, run_gemm(p, ldsl, wsp<const bf16_t>(p, WS_H), wsp<const bf16_t>(p, WS_ATQKV), T, AT_PROJ, D, F_ATIN));
            PHASE(10, pb + 2, phase_at_qknorm(p));
            PHASE(11, pb + 3, phase_attention(p, lds, ctx_out));
            PHASE(12, pb + 7, run_gemm(p, ldsl, wsp<const bf16_t>(p, WS_YB), wsp<const bf16_t>(p, WS_ATOUT), Mo, D, D, FBf16{wsp<bf16_t>(p, WS_OB), D}));
        } else {
#define F_MBIN FMbIn{wsp<bf16_t>(p, MB_Z), wsp<bf16_t>(p, MB_XBC), wsp<float>(p, MB_DT)}
            PHASE(13, pb + 0, run_gemm(p, ldsl, wsp<const bf16_t>(p, WS_H), wsp<const bf16_t>(p, WS_SSMIN), T, SSM_PROJ, D, F_MBIN));
            PHASE(27, pb + 1, run_ctx_reduce(p, SSM_PROJ, D, F_MBIN));
            PHASE(15, pb + 3, phase_mb_prep(p, ldsl));
            PHASE(17, pb + 5, phase_mb_scan(p, ldsl, ctx_out));
            PHASE(18, pb + 6, phase_mb_readout(p));
            PHASE(19, pb + 7, run_gemm(p, ldsl, wsp<const bf16_t>(p, WS_YB), wsp<const bf16_t>(p, WS_SSMOUT), Mo, D, 8192, FBf16{wsp<bf16_t>(p, WS_OB), D}));
        }
        static_assert(pg8::TailOrder::pick_sk(D / 256, D / 64) == 16 && pg8::TailOrder::pick_sk(D / 256, 8192 / 64) == 16, "phase_ln sums 16 context partial sums");
        PHASE(20, pb + 9, phase_ln(p, ldsl, l, 0));
        PHASE(21, pb + 10, run_gemm_gu(p, ldsl, l, Mo));
        PHASE(22, pb + 12, phase_ffn_fix(p, l, ctx_out));
        PHASE(23, pb + 13, run_gemm(p, ldsl, wsp<const bf16_t>(p, WS_HID), wsp<const bf16_t>(p, WS_FD + l * SZ_SQ), Mo, D, D, FBf16{wsp<bf16_t>(p, WS_OB), D}));
        PHASE(24, pb + 15, phase_ln(p, ldsl, l, 1));
    }
#undef PHASE
}

static bool phase_used_host(int id) {
    if (id < 3) return true;
    const int l = (id - 3) >> 4, k = (id - 3) & 15, kind = l % 3; const bool ctx_out = l < DEPTH - 1;
    if (k == 11) return false;
    if (k == 8 || k == 14) return false;
    if (kind == 0) return !(k == 3 || k == 5);
    if (kind == 1) return !(k == 1 || k == 4 || k == 5 || k == 6);
    return !(k == 2 || k == 4);
}
extern "C" void kernel_launch(void* const* d_in, const int* in_sizes, int n_in, void* d_out, int out_size, void* d_ws, size_t ws_size, hipStream_t stream) {
    static int grid = 0;
    if (grid == 0) {
        if (n_in != 29 || out_size != TL * D || ws_size < WS_END) { fprintf(stderr, "kernel_launch: expected 29 inputs, %d outputs, >= %zu bytes of workspace; got %d, %d, %zu\n", TL * D, (size_t)WS_END, n_in, out_size, ws_size); grid = -1; return; }
        int dev = 0, cus = 0, per_cu = 0;
        if (hipGetDevice(&dev) != hipSuccess || hipDeviceGetAttribute(&cus, hipDeviceAttributeMultiprocessorCount, dev) != hipSuccess) { grid = -1; return; }
        if (hipFuncSetAttribute((const void*)mk_fwd, hipFuncAttributeMaxDynamicSharedMemorySize, LDS_BYTES) != hipSuccess) { fprintf(stderr, "kernel_launch: hipFuncSetAttribute failed\n"); grid = -1; return; }
        if (hipOccupancyMaxActiveBlocksPerMultiprocessor(&per_cu, (const void*)mk_fwd, NT, LDS_BYTES) != hipSuccess || per_cu < 1) { fprintf(stderr, "kernel_launch: occupancy query reports %d\n", per_cu); (void)hipGetLastError(); }
        grid = cus;
    }
    if (grid < 0) return;
    Params p{};
    for (int i = 0; i < 29; ++i) p.in[i] = (const float*)d_in[i];
    p.out = (float*)d_out; p.ws = (unsigned char*)d_ws;
#if MK_MULTI
    for (int id = 0; id < N_PHASE; ++id) {
        if (!phase_used_host(id)) continue;
        p.ph_lo = id; p.ph_hi = id + 1;
        hipLaunchKernelGGL(mk_fwd, dim3(grid), dim3(NT), LDS_BYTES, stream, p);
    }
#else
    (void)hipMemsetAsync((char*)d_ws + WS_CTL, 0, 65536, stream);
    p.ph_lo = 0; p.ph_hi = N_PHASE;
    hipLaunchKernelGGL(mk_fwd, dim3(grid), dim3(NT), LDS_BYTES, stream, p);
#endif
    const hipError_t le = hipPeekAtLastError();
    if (le != hipSuccess) fprintf(stderr, "kernel_launch: launch failed: %s\n", hipGetErrorName(le));
}
```

```cpp
#include <hip/hip_runtime.h>
#include <cstdio>
#include <cstdint>

#define LAS __attribute__((address_space(3)))
typedef unsigned short bf16_t;
typedef short bf16x8 __attribute__((ext_vector_type(8)));
typedef short s16x4 __attribute__((ext_vector_type(4)));
typedef float f32x2 __attribute__((ext_vector_type(2)));
typedef float f32x4 __attribute__((ext_vector_type(4)));
typedef float f32x8 __attribute__((ext_vector_type(8)));
typedef float f32x16 __attribute__((ext_vector_type(16)));
typedef unsigned u32x2 __attribute__((ext_vector_type(2)));
typedef unsigned u32x4 __attribute__((ext_vector_type(4)));

#ifndef MK_MULTI
#define MK_MULTI 0
#define MK_PROBE 0
#endif

constexpr int D = 4096, TL = 16384, TC = 256, T = TL + TC, DEPTH = 4, NT = 512;
constexpr float ALPHA = 1.6817928305074292f;
constexpr float LN_EPS = 1e-6f, RMS_EPS = 1e-6f;
constexpr int HG_PROJ = 14336, AT_PROJ = 6144, SSM_PROJ = 18688, MODN = 6 * D;
constexpr int SKMAX = 16;

constexpr size_t al256(size_t x) { return (x + 255) & ~(size_t)255; }
constexpr size_t WS_CTL   = 0;
constexpr size_t WS_MODP  = 65536;
constexpr size_t WS_MODV  = WS_MODP + (size_t)32 * 4 * 2 * MODN * 4;
constexpr size_t WS_ROPE  = WS_MODV + (size_t)4 * 2 * MODN * 4;
constexpr size_t WS_LB    = WS_ROPE + (size_t)256 * 32 * 2 * 4;
constexpr size_t WS_W     = al256(WS_LB + (size_t)3 * 2 * 2 * 2048 * 4);
constexpr size_t SZ_HGIN = (size_t)HG_PROJ * D * 2, SZ_SQ = (size_t)D * D * 2, SZ_ATQKV = (size_t)AT_PROJ * D * 2, SZ_SSMIN = (size_t)SSM_PROJ * D * 2, SZ_SSMOUT = (size_t)D * 8192 * 2, SZ_GU = (size_t)8192 * D * 2;
constexpr size_t WS_HGIN  = WS_W;
constexpr size_t WS_HGOUT = WS_HGIN + 2 * SZ_HGIN;
constexpr size_t WS_ATQKV = WS_HGOUT + 2 * SZ_SQ;
constexpr size_t WS_ATOUT = WS_ATQKV + SZ_ATQKV;
constexpr size_t WS_SSMIN = WS_ATOUT + SZ_SQ;
constexpr size_t WS_SSMOUT = WS_SSMIN + SZ_SSMIN;
constexpr size_t WS_GU    = WS_SSMOUT + SZ_SSMOUT;
constexpr size_t WS_FD    = WS_GU + 4 * SZ_GU;
constexpr size_t WS_ACT   = WS_FD + 4 * SZ_SQ;
constexpr size_t WS_X     = WS_ACT;
constexpr size_t WS_H     = WS_X + (size_t)T * D * 4;
constexpr size_t WS_YB    = WS_H + (size_t)T * D * 2;
constexpr size_t WS_OB    = WS_YB + (size_t)T * 8192 * 2;
constexpr size_t WS_AU    = WS_OB + (size_t)T * D * 2;
constexpr size_t WS_HID   = WS_AU + (size_t)T * 8192 * 2;
constexpr size_t WS_PART  = WS_HID + (size_t)T * D * 2;
constexpr size_t WS_EDGE  = WS_PART + (size_t)68 * 1024 * 1024;
constexpr size_t WS_MIX   = WS_EDGE + (size_t)65 * 6 * 4096 * 4;
constexpr int NCH = 260;
constexpr size_t HG_QB  = WS_MIX;
constexpr size_t HG_LF  = HG_QB + (size_t)T * 2048 * 2;
constexpr size_t HG_KB  = HG_LF + (size_t)2 * T * 2048 * 4;
constexpr size_t HG_V   = HG_KB + (size_t)2 * T * 2048 * 2;
constexpr size_t HG_SG  = HG_V + (size_t)T * D * 2;
constexpr size_t HG_O   = HG_SG + (size_t)T * D * 2;
constexpr size_t HG_A   = HG_O + (size_t)2 * T * D * 2;
constexpr size_t HG_QT  = HG_A + (size_t)32 * NCH * 64 * 64 * 2;
constexpr size_t HG_KT  = HG_QT + (size_t)32 * NCH * 64 * 128 * 2;
constexpr size_t HG_D   = HG_KT + (size_t)32 * NCH * 64 * 128 * 2;
constexpr size_t HG_VT  = HG_D + (size_t)32 * NCH * 128 * 4;
constexpr size_t HG_END = HG_VT + (size_t)16 * NCH * 256 * 64 * 2;
constexpr size_t AT_Q   = WS_MIX;
constexpr size_t AT_K   = AT_Q + (size_t)T * D * 2;
constexpr size_t AT_V   = AT_K + (size_t)T * 1024 * 2;
constexpr size_t AT_END = AT_V + (size_t)T * 1024 * 2;
constexpr size_t MB_Z   = WS_MIX;
constexpr size_t MB_XBC = MB_Z + (size_t)T * 8192 * 2;
constexpr size_t MB_DT  = MB_XBC + (size_t)T * 10240 * 2;
constexpr size_t MB_XS  = MB_DT + (size_t)T * 256 * 4;
constexpr size_t MB_BB  = MB_XS + (size_t)T * 8192 * 2;
constexpr size_t MB_CB  = MB_BB + (size_t)T * 1024 * 2;
constexpr size_t MB_DTV = MB_CB + (size_t)T * 1024 * 2;
constexpr size_t MB_Y   = MB_DTV + (size_t)2 * T * 128 * 4;
constexpr size_t MB_G   = MB_Y + (size_t)2 * T * 8192 * 2;
constexpr size_t MB_CP  = MB_G + (size_t)8 * NCH * 64 * 64 * 2;
constexpr size_t MB_BT  = MB_CP + (size_t)8 * NCH * 64 * 128 * 2;
constexpr size_t MB_XT  = MB_BT + (size_t)8 * NCH * 64 * 128 * 2;
constexpr size_t MB_GV  = MB_XT + (size_t)128 * NCH * 64 * 64 * 2;
constexpr size_t MB_DTC = MB_GV + (size_t)256 * NCH * 64 * 4;
constexpr size_t MB_END = MB_DTC + (size_t)256 * NCH * 64 * 4;
constexpr size_t WS_END = (MB_END > HG_END ? (MB_END > AT_END ? MB_END : AT_END) : (HG_END > AT_END ? HG_END : AT_END));

constexpr int LDS_MAIN = 131072, LDS_HALO = LDS_MAIN, LDS_XB = 162816, LDS_WMAP = LDS_XB + 256, LDS_BYTES = LDS_WMAP + 256;

__device__ __forceinline__ unsigned cvt_pk_bf16(float lo, float hi) { unsigned r; asm volatile("v_cvt_pk_bf16_f32 %0, %1, %2" : "=v"(r) : "v"(lo), "v"(hi)); return r; }
typedef __bf16 bf16v2_t __attribute__((ext_vector_type(2)));
__device__ __forceinline__ unsigned cvt_pk_bf16_n(float lo, float hi) { const bf16v2_t v = __builtin_convertvector((f32x2){lo, hi}, bf16v2_t); return __builtin_bit_cast(unsigned, v); }
__device__ __forceinline__ float bf_lo(unsigned w) { return __uint_as_float(w << 16); }
__device__ __forceinline__ float bf_hi(unsigned w) { return __uint_as_float(w & 0xffff0000u); }
__device__ __forceinline__ float bf1(bf16_t b) { return __uint_as_float(((unsigned)b) << 16); }
__device__ __forceinline__ bf16_t f2bf(float f) { return (bf16_t)(cvt_pk_bf16(f, 0.f) & 0xffffu); }
__device__ __forceinline__ bf16_t f2bf_n(float f) { return (bf16_t)(cvt_pk_bf16_n(f, 0.f) & 0xffffu); }
__device__ __forceinline__ float sigmoidf_(float x) { return 1.0f / (1.0f + __expf(-x)); }
__device__ __forceinline__ float siluf_(float x) { return x / (1.0f + __expf(-x)); }
template <int CTRL> __device__ __forceinline__ float dpp_mov(float v) { return __int_as_float(__builtin_amdgcn_update_dpp(0, __float_as_int(v), CTRL, 0xF, 0xF, false)); }
__device__ __forceinline__ float xch16(float v, int lane) { const auto r = __builtin_amdgcn_permlane16_swap(__float_as_uint(v), __float_as_uint(v), false, false); return __uint_as_float((lane & 16) ? r[0] : r[1]); }
__device__ __forceinline__ float xch32(float v, int lane) { const auto r = __builtin_amdgcn_permlane32_swap(__float_as_uint(v), __float_as_uint(v), false, false); return __uint_as_float((lane & 32) ? r[0] : r[1]); }
struct OpSum { __device__ __forceinline__ float operator()(float a, float b) const { return a + b; } };
struct OpMax { __device__ __forceinline__ float operator()(float a, float b) const { return fmaxf(a, b); } };
template <class Op> __device__ __forceinline__ float row16_all(float v, Op op) {
    v = op(v, dpp_mov<0xB1>(v)); v = op(v, dpp_mov<0x4E>(v)); v = op(v, dpp_mov<0x141>(v)); v = op(v, dpp_mov<0x140>(v));
    return v;
}
template <class Op> __device__ __forceinline__ float wave_all(float v, Op op) {
    v = row16_all(v, op);
    { const auto r = __builtin_amdgcn_permlane16_swap(__float_as_uint(v), __float_as_uint(v), false, false); v = op(__uint_as_float(r[0]), __uint_as_float(r[1])); }
    { const auto r = __builtin_amdgcn_permlane32_swap(__float_as_uint(v), __float_as_uint(v), false, false); v = op(__uint_as_float(r[0]), __uint_as_float(r[1])); }
    return v;
}
__device__ __forceinline__ float wave_sum(float v) { return wave_all(v, OpSum()); }
__device__ __forceinline__ float wave_max(float v) { return wave_all(v, OpMax()); }
__device__ __forceinline__ unsigned mk_hwslot() { return (unsigned)__builtin_amdgcn_s_getreg((5 << 11) | 4) & 63u; }
__device__ __forceinline__ int mk_tid() {
    extern __shared__ __attribute__((aligned(16))) unsigned char mk_lds_[];
    const int w = __builtin_amdgcn_readfirstlane(((const LAS int*)((LAS unsigned char*)mk_lds_ + LDS_WMAP))[mk_hwslot()]);
    int l; asm volatile("v_mbcnt_lo_u32_b32 %0, -1, 0\n\tv_mbcnt_hi_u32_b32 %0, -1, %0" : "=v"(l));
    return w * 64 + l;
}
__device__ __forceinline__ int mk_bid() { int b = blockIdx.x; asm volatile("" : "+v"(b)); return __builtin_amdgcn_readfirstlane(b); }
__device__ __forceinline__ void lds_barrier() { asm volatile("s_waitcnt lgkmcnt(0)\n\ts_barrier" ::: "memory"); }
__device__ __forceinline__ void ld8bf(const bf16_t* p, float (&o)[8]) { const u32x4 w = *(const u32x4*)p; o[0] = bf_lo(w.x); o[1] = bf_hi(w.x); o[2] = bf_lo(w.y); o[3] = bf_hi(w.y); o[4] = bf_lo(w.z); o[5] = bf_hi(w.z); o[6] = bf_lo(w.w); o[7] = bf_hi(w.w); }
__device__ __forceinline__ void st_bf16x8(bf16_t* p, f32x4 v0, f32x4 v1) {
    u32x4 w; w.x = cvt_pk_bf16(v0[0], v0[1]); w.y = cvt_pk_bf16(v0[2], v0[3]); w.z = cvt_pk_bf16(v1[0], v1[1]); w.w = cvt_pk_bf16(v1[2], v1[3]);
    *(u32x4*)p = w;
}
__device__ __forceinline__ void st_bf16x8_n(bf16_t* p, f32x4 v0, f32x4 v1) {
    u32x4 w; w.x = cvt_pk_bf16_n(v0[0], v0[1]); w.y = cvt_pk_bf16_n(v0[2], v0[3]); w.z = cvt_pk_bf16_n(v1[0], v1[1]); w.w = cvt_pk_bf16_n(v1[2], v1[3]);
    *(u32x4*)p = w;
}
#define XB_TMO      128
#define XB_XCNT(j)  (256  + 64 * (j))
#define XB_XSUB(j)  (1280 + 64 * (j))
#define XB_XGEN(j)  (2304 + 64 * (j))
#define XB_TOP      3328
#define XB_TOPGEN   3392
#define XCD_BAR_WORDS 3456
#define XB_SPIN_CAP (1u << 22)

__device__ __forceinline__ unsigned xb_ld(unsigned* p)              { return __hip_atomic_load(p, __ATOMIC_RELAXED, __HIP_MEMORY_SCOPE_AGENT); }
__device__ __forceinline__ unsigned xb_add(unsigned* p, unsigned v) { return __hip_atomic_fetch_add(p, v, __ATOMIC_RELAXED, __HIP_MEMORY_SCOPE_AGENT); }
__device__ __forceinline__ unsigned xb_xcc_id() { return (unsigned)__builtin_amdgcn_s_getreg((3 << 11) | 20) & 0xFu; }
#define XB_SPIN(cond, bar) do { unsigned _sp = 0; while (cond) { __builtin_amdgcn_s_sleep(1); \
    if ((++_sp & 255u) == 0u) { if (xb_ld(&(bar)[XB_TMO])) break; if (_sp > XB_SPIN_CAP) { atomicAdd(&(bar)[XB_TMO], 1u); break; } } } } while (0)

struct XcdBarrier {
    unsigned* bar; unsigned x;
    volatile LAS unsigned* st;
};

__device__ __forceinline__ XcdBarrier xcd_barrier_post(unsigned* bar, volatile LAS unsigned* st) {
    XcdBarrier b; b.bar = bar; b.x = xb_xcc_id(); b.st = st;
    if (mk_tid() == 0) (void)xb_add(&bar[XB_XCNT(b.x)], 1u);
    return b;
}
__device__ __forceinline__ void xcd_barrier_complete(unsigned* bar, unsigned x, unsigned& nloc, unsigned& nx) {
    const unsigned G = gridDim.x * gridDim.y * gridDim.z;
    unsigned sum, cnt, mine, sp = 0u;
    for (;;) {
        sum = 0u; cnt = 0u; mine = 0u;
#pragma unroll
        for (unsigned j = 0; j < 16; ++j) { const unsigned c = xb_ld(&bar[XB_XCNT(j)]); sum += c; cnt += (c > 0u) ? 1u : 0u; mine = (j == x) ? c : mine; }
        if (sum == G) break;
        __builtin_amdgcn_s_sleep(1);
        if ((++sp & 255u) == 0u) { if (xb_ld(&bar[XB_TMO])) break; if (sp > XB_SPIN_CAP) { atomicAdd(&bar[XB_TMO], 1u); break; } }
    }
    nloc = mine > 0u ? mine : 1u; nx = cnt > 0u ? cnt : 1u;
}

__device__ __forceinline__ void xcd_barrier(const XcdBarrier& b) {
    asm volatile("s_waitcnt vmcnt(0)" ::: "memory");
    __syncthreads();
    if (mk_tid() == 0) {
        unsigned* bar = b.bar;
        __builtin_amdgcn_s_waitcnt(0);
        unsigned nloc = b.st[0], nx = b.st[1];
        if (nloc == 0u) { xcd_barrier_complete(bar, b.x, nloc, nx); b.st[0] = nloc; b.st[1] = nx; }
        const unsigned old = xb_add(&bar[XB_XSUB(b.x)], 1u);
        const unsigned gen = old / nloc;
        if (old + 1u == (gen + 1u) * nloc) {
            __builtin_amdgcn_fence(__ATOMIC_RELEASE, "agent");
            asm volatile("s_waitcnt vmcnt(0)" ::: "memory");
            const unsigned og = xb_add(&bar[XB_TOP], 1u);
            const unsigned tg = og / nx;
            if (og + 1u == (tg + 1u) * nx) xb_add(&bar[XB_TOPGEN], 1u);
            else XB_SPIN(xb_ld(&bar[XB_TOPGEN]) == tg, bar);
            __builtin_amdgcn_fence(__ATOMIC_ACQUIRE, "agent");
            xb_add(&bar[XB_XGEN(b.x)], 1u);
            asm volatile("s_waitcnt vmcnt(0)" ::: "memory");
        } else {
            XB_SPIN(xb_ld(&bar[XB_XGEN(b.x)]) == gen, bar);
            __builtin_amdgcn_fence(__ATOMIC_ACQUIRE, "agent");
            asm volatile("s_waitcnt vmcnt(0)" ::: "memory");
        }
    }
    __syncthreads();
}
namespace pg8 {
#define PG8_LAS __attribute__((address_space(3)))
constexpr int BM = 256, BK = 64, HALF = 128, HTB = HALF * BK * 2  , STAGE_BYTES = 8 * HTB, NXCD = 8, WGM = 8;

__host__ __device__ __forceinline__ int lds_byte(int r, int c) { const int st = (r >> 4) * 2 + (c >> 5), rr = r & 15, cc = c & 31, ob = rr * 64 + cc * 2; return st * 1024 + (ob ^ (((ob >> 9) & 1) << 5)); }
__host__ __device__ __forceinline__ void stage_rc(int b, int& R, int& C) { const int st = b / 1024, sb = b % 1024, swz = sb ^ (((sb >> 9) & 1) << 5); R = (st >> 1) * 16 + swz / 64; C = (st & 1) * 32 + (swz % 64) / 2; }
__host__ __device__ __forceinline__ int perm32(int rho) { const int n = rho >> 4, i = rho & 15; return 8 * (i >> 2) + 4 * n + (i & 3); }
struct Unit { int pm, pn, k0, nt, sk; };
struct Gemm { const bf16_t* A; const bf16_t* Bt; int M, N, K; };
struct StaticOrder {
    int nM, nN, nwg, G, c, ntf;
    __host__ __device__ __forceinline__ void init(int M, int N, int K, int G_, int c_) { nM = M / BM; nN = N / BM; nwg = nM * nN; G = G_; c = c_; ntf = K / BK; }
    __host__ __device__ __forceinline__ Unit get(int i) const {
        Unit u; u.pm = -1; u.pn = 0; u.k0 = 0; u.nt = ntf; u.sk = -1;
        const long L = (long)i * G + c; if (L >= nwg) return u;
        int wgid = (int)L; { const int q = nwg / NXCD, r = nwg % NXCD, xcd = wgid % NXCD, off = wgid / NXCD; wgid = (xcd < r ? xcd * (q + 1) : r * (q + 1) + (xcd - r) * q) + off; }
        const int nig = WGM * nN, gid = wgid / nig, fm = gid * WGM, gsz = (nM - fm) < WGM ? (nM - fm) : WGM;
        u.pm = fm + ((wgid % nig) % gsz); u.pn = (wgid % nig) / gsz; return u;
    }
    __device__ __forceinline__ void a_ready(const Unit&) const {}
    __device__ __forceinline__ void done(const Unit&) const {}
};
struct TailOrder {
    StaticOrder so; int U0, SK, nsplit;
    __host__ __device__ static constexpr int pick_sk(int nN, int ntf) { int sk = 1; while (sk * 2 <= SKMAX && sk * 2 * nN <= 256 && ntf / (sk * 2) >= 4) sk *= 2; return sk; }
    __host__ __device__ __forceinline__ void init(int Mlat, int N, int K, int G_, int c_, bool has_ctx) { so.init(Mlat, N, K, G_, c_); U0 = so.nwg; SK = pick_sk(so.nN, so.ntf); nsplit = has_ctx ? so.nN * SK : 0; }
    __host__ __device__ __forceinline__ Unit get(int i) const {
        const long L = (long)i * so.G + so.c;
        if (L < U0) return so.get(i);
        Unit u; const int s = (int)(L - U0); const bool ok = s < nsplit;
        u.pm = ok ? so.nM : -1; u.pn = s % so.nN; u.sk = s / so.nN; u.nt = so.ntf / SK; u.k0 = u.sk * u.nt; return u;
    }
    __device__ __forceinline__ void a_ready(const Unit&) const {}
    __device__ __forceinline__ void done(const Unit&) const {}
};
template <class Epi, class Sched>
__device__ __forceinline__ void gemm_phase(PG8_LAS unsigned char* lds, const Gemm g, const Sched& S, const Epi& E) {
    const int tid = mk_tid(), wid = __builtin_amdgcn_readfirstlane(tid >> 6), lane = tid & 63, wr = wid >> 2, wc = wid & 3, fr = lane & 15, fq = lane >> 4;
    const int K = g.K;
    unsigned voffA[2], voffB[2];
#pragma unroll
    for (int i = 0; i < 2; ++i) { int R, C; stage_rc(tid * 16 + i * 8192, R, C); const int Rb = Epi::PERM ? ((R & ~31) + perm32(R & 31)) : R;
        voffA[i] = (unsigned)(R * K + C) * 2u; voffB[i] = (unsigned)(Rb * K + C) * 2u; }
    const size_t kstep = (size_t)(BK * 2);
    const size_t hstep = (size_t)HALF * K * 2;
    const size_t tstep = 2 * hstep;
    const unsigned ldsw = (unsigned)wid * 1024u;
    const int aoff = lds_byte(wr * 64 + fr, fq * 8), boff = lds_byte(wc * 32 + fr, fq * 8);
#define PG8_SA(b, h) (((b) * 2 + (h)) * HTB)
#define PG8_SB(b, h) ((4 + (b) * 2 + (h)) * HTB)
#define PG8_STAGE(bufoff, gbase, voff) do { _Pragma("unroll") for (int _i = 0; _i < 2; ++_i) \
        __builtin_amdgcn_global_load_lds((const unsigned*)((const char*)(gbase) + (voff)[_i]), (PG8_LAS unsigned*)(lds + (bufoff) + ldsw + _i * 8192), 16, 0, 0); } while (0)
#define PG8_LDA(dst, b, h) do { _Pragma("unroll") for (int m = 0; m < 4; ++m) _Pragma("unroll") for (int k = 0; k < 2; ++k) dst[m][k] = *(const PG8_LAS bf16x8*)(lds + PG8_SA(b, h) + aoff + m * 2048 + k * 1024); } while (0)
#define PG8_LDB(dst, b, h) do { _Pragma("unroll") for (int n = 0; n < 2; ++n) _Pragma("unroll") for (int k = 0; k < 2; ++k) dst[n][k] = *(const PG8_LAS bf16x8*)(lds + PG8_SB(b, h) + boff + n * 2048 + k * 1024); } while (0)
#define PG8_MMA(ai, bj, At, Bt) do { __builtin_amdgcn_s_setprio(1); _Pragma("unroll") for (int m = 0; m < 4; ++m) _Pragma("unroll") for (int n = 0; n < 2; ++n) _Pragma("unroll") for (int k = 0; k < 2; ++k) \
        acc[ai][bj][m][n] = __builtin_amdgcn_mfma_f32_16x16x32_bf16(Bt[n][k], At[m][k], acc[ai][bj][m][n], 0, 0, 0); __builtin_amdgcn_s_setprio(0); } while (0)
#define PG8_WAIT_V(n) asm volatile("s_waitcnt vmcnt(" #n ")" ::: "memory")
#define PG8_WAIT_L(n) asm volatile("s_waitcnt lgkmcnt(" #n ")" ::: "memory")
#define PG8_BAR __builtin_amdgcn_s_barrier()
#define PG8_SCHED __builtin_amdgcn_sched_barrier(0)
    Unit cur, nxt; int ui = 0;
    cur = S.get(0); if (cur.pm < 0) return;
    f32x4 acc[2][2][4][2];
#pragma unroll
    for (int a = 0; a < 2; ++a)
#pragma unroll
        for (int b = 0; b < 2; ++b)
#pragma unroll
            for (int m = 0; m < 4; ++m)
#pragma unroll
                for (int n = 0; n < 2; ++n) acc[a][b][m][n] = (f32x4){0.f, 0.f, 0.f, 0.f};
    bf16x8 At[4][2], B0[2][2], B1[2][2];
    const char* cA = (const char*)g.A + (size_t)cur.pm * tstep + (size_t)cur.k0 * kstep; const char* cB = (const char*)g.Bt + (size_t)cur.pn * tstep + (size_t)cur.k0 * kstep;
    S.a_ready(cur);
    PG8_STAGE(PG8_SB(0, 0), cB, voffB); PG8_STAGE(PG8_SA(0, 0), cA, voffA); PG8_STAGE(PG8_SB(0, 1), cB + hstep, voffB); PG8_STAGE(PG8_SA(0, 1), cA + hstep, voffA);
    if (wr == 1) PG8_BAR;
    PG8_WAIT_V(4); PG8_BAR;
    PG8_STAGE(PG8_SB(1, 0), cB + kstep, voffB); PG8_STAGE(PG8_SA(1, 0), cA + kstep, voffA); PG8_STAGE(PG8_SB(1, 1), cB + hstep + kstep, voffB);
    PG8_WAIT_V(6); PG8_BAR;
    for (;;) {
        nxt = S.get(ui + 1); const bool has_next = nxt.pm >= 0;
        const char* nA = has_next ? (const char*)g.A + (size_t)nxt.pm * tstep + (size_t)nxt.k0 * kstep : cA; const char* nB = has_next ? (const char*)g.Bt + (size_t)nxt.pn * tstep + (size_t)nxt.k0 * kstep : cB;
        const int nt = cur.nt;
        for (int t = 0; t < nt; t += 2) {
            const bool last = (t == nt - 2);
            const char* a1 = cA + (size_t)(t + 1) * kstep;
            const char* a2 = last ? nA : cA + (size_t)(t + 2) * kstep; const char* b2 = last ? nB : cB + (size_t)(t + 2) * kstep;
            const char* a3 = a2 + kstep; const char* b3 = b2 + kstep;
            if (last && has_next) S.a_ready(nxt);
            PG8_LDB(B0, 0, 0); PG8_SCHED; PG8_LDA(At, 0, 0); PG8_STAGE(PG8_SA(1, 1), a1 + hstep, voffA);
            PG8_WAIT_L(8); PG8_BAR; PG8_WAIT_L(0); PG8_MMA(0, 0, At, B0); PG8_BAR; PG8_SCHED;
            PG8_LDB(B1, 0, 1); PG8_STAGE(PG8_SB(0, 0), b2, voffB);
            PG8_BAR; PG8_WAIT_L(0); PG8_MMA(0, 1, At, B1); PG8_BAR;
            PG8_LDA(At, 0, 1); PG8_STAGE(PG8_SA(0, 0), a2, voffA);
            PG8_BAR; PG8_WAIT_L(0); PG8_MMA(1, 0, At, B0); PG8_BAR; PG8_SCHED;
            PG8_STAGE(PG8_SB(0, 1), b2 + hstep, voffB);
            PG8_WAIT_V(6); PG8_BAR; PG8_MMA(1, 1, At, B1); PG8_BAR;
            PG8_LDB(B0, 1, 0); PG8_SCHED; PG8_LDA(At, 1, 0); PG8_STAGE(PG8_SA(0, 1), a2 + hstep, voffA);
            PG8_WAIT_L(8); PG8_BAR; PG8_WAIT_L(0); PG8_MMA(0, 0, At, B0); PG8_BAR; PG8_SCHED;
            PG8_LDB(B1, 1, 1); PG8_STAGE(PG8_SB(1, 0), b3, voffB);
            PG8_BAR; PG8_WAIT_L(0); PG8_MMA(0, 1, At, B1); PG8_BAR;
            PG8_LDA(At, 1, 1); PG8_STAGE(PG8_SA(1, 0), a3, voffA);
            PG8_BAR; PG8_WAIT_L(0); PG8_MMA(1, 0, At, B0); PG8_BAR; PG8_SCHED;
            PG8_STAGE(PG8_SB(1, 1), b3 + hstep, voffB);
            PG8_WAIT_V(6); PG8_BAR; PG8_MMA(1, 1, At, B1); PG8_BAR;
        }
            if constexpr (!Epi::AFTER_DRAIN) { E(acc, cur, wr, wc, fr, fq); S.done(cur); }
            if (!has_next) break;
#pragma unroll
        for (int a = 0; a < 2; ++a)
#pragma unroll
            for (int b = 0; b < 2; ++b)
#pragma unroll
                for (int m = 0; m < 4; ++m)
#pragma unroll
                    for (int n = 0; n < 2; ++n) acc[a][b][m][n] = (f32x4){0.f, 0.f, 0.f, 0.f};
        cur = nxt; cA = nA; cB = nB; ++ui;
    }
    PG8_WAIT_V(0);
    if (wr == 0) PG8_BAR;
    PG8_BAR;
    if constexpr (Epi::AFTER_DRAIN) { E.fused(acc, cur, wr, wc, fr, fq, lds, wid, lane); S.done(cur); }
#undef PG8_SA
#undef PG8_SB
#undef PG8_STAGE
#undef PG8_LDA
#undef PG8_LDB
#undef PG8_MMA
#undef PG8_WAIT_V
#undef PG8_WAIT_L
#undef PG8_BAR
#undef PG8_SCHED
}
}
namespace att {
using bf16 = bf16_t;
constexpr int   D = 128, NW = 8, QBLK = 32, KVBLK = 64;
constexpr float SCALE = 0.088388347648318440f;
constexpr float THR = 8.f;
constexpr int SDEPTH = 2;
constexpr int LDQ = 4096, LDK = 1024, LDO = 4096;
constexpr size_t SHM_V = KVBLK * D * 2, SHM_K = KVBLK * D * 2, SHM_ATTN = 2 * SHM_V + 2 * SHM_K + NW * 64 * 4;
#define KSWZ(row, colB) ((row) * 256 + ((colB) ^ (((row) & 7) << 4)))
#define SBAR() __builtin_amdgcn_sched_barrier(0)
__device__ __forceinline__ int crow(int r, int hi) { return (r & 3) + 8 * (r >> 2) + 4 * hi; }
__device__ __forceinline__ unsigned cvtpk(float lo, float hi) {
  unsigned r; asm volatile("v_cvt_pk_bf16_f32 %0, %1, %2" : "=v"(r) : "v"(lo), "v"(hi)); return r;
}
template <typename TIn> struct Stage;
template <> struct Stage<bf16>  { using T = bf16x8;
  __device__ static __forceinline__ T ld8(const bf16* p) { return *reinterpret_cast<const bf16x8*>(p); }
  __device__ static __forceinline__ bf16x8 tobf(T x) { return x; } };
template <> struct Stage<float> { using T = f32x8;
  __device__ static __forceinline__ T ld8(const float* p) { return *reinterpret_cast<const f32x8*>(p); }
  __device__ static __forceinline__ bf16x8 tobf(T x) {
    u32x4 w = {cvtpk(x[0], x[1]), cvtpk(x[2], x[3]), cvtpk(x[4], x[5]), cvtpk(x[6], x[7])}; return *reinterpret_cast<bf16x8*>(&w); } };

__device__ __forceinline__ void partialSM(f32x16& p0, f32x16& p1, float& m_reg, float& mn, float& alpha) {
  constexpr float C = SCALE * 1.4426950408889634f;
  float pmax = p0[0]; for (int r = 1; r < 16; ++r) pmax = fmaxf(pmax, p0[r]); for (int r = 0; r < 16; ++r) pmax = fmaxf(pmax, p1[r]);
  { auto rr = __builtin_amdgcn_permlane32_swap(__float_as_uint(pmax), __float_as_uint(pmax), false, false);
    pmax = fmaxf(__uint_as_float(rr[0]), __uint_as_float(rr[1])); }
  if (__builtin_expect(__all(pmax - m_reg <= THR / SCALE), 1)) { mn = m_reg; alpha = 1.f; }
  else { mn = fmaxf(m_reg, pmax); alpha = __builtin_amdgcn_exp2f((m_reg - mn) * C); m_reg = mn; }
  float mnC = -mn * C;
  for (int r = 0; r < 16; ++r) p0[r] = fmaf(p0[r], C, mnC); for (int r = 0; r < 16; ++r) p1[r] = fmaf(p1[r], C, mnC);
  for (int r = 0; r < 16; ++r) p0[r] = __builtin_amdgcn_exp2f(p0[r]);
}
__device__ __forceinline__ void finishSM(f32x16& p0, f32x16& p1, float alpha, float& l_reg, bf16x8& pa0, bf16x8& pa1, bf16x8& pa2, bf16x8& pa3) {
  for (int r = 0; r < 16; ++r) p1[r] = __builtin_amdgcn_exp2f(p1[r]);
  float ps = 0; for (int r = 0; r < 16; ++r) ps += p0[r]; for (int r = 0; r < 16; ++r) ps += p1[r];
  { auto rr = __builtin_amdgcn_permlane32_swap(__float_as_uint(ps), __float_as_uint(ps), false, false);
    ps = __uint_as_float(rr[0]) + __uint_as_float(rr[1]); }
  l_reg = l_reg * alpha + ps;
#define PK4(P, BASE, OUT) do { unsigned a0 = cvtpk(P[BASE + 0], P[BASE + 1]), a1 = cvtpk(P[BASE + 2], P[BASE + 3]);   \
    unsigned b0 = cvtpk(P[BASE + 4], P[BASE + 5]), b1 = cvtpk(P[BASE + 6], P[BASE + 7]);                              \
    auto r0 = __builtin_amdgcn_permlane32_swap(a0, b0, false, false); auto r1 = __builtin_amdgcn_permlane32_swap(a1, b1, false, false); \
    u32x4 w = {r0[0], r1[0], r0[1], r1[1]}; OUT = *reinterpret_cast<bf16x8*>(&w); } while (0)
  PK4(p0, 0, pa0); PK4(p0, 8, pa1); PK4(p1, 0, pa2); PK4(p1, 8, pa3);
#undef PK4
}
__device__ __forceinline__ void qkt(f32x16& p0, f32x16& p1, const bf16* Ks, const bf16x8* qr, int r32, int hi) {
  p0 = f32x16{}; p1 = f32x16{};
  for (int d0 = 0; d0 < 8; ++d0) { int cb = (d0 * 16 + hi * 8) * 2;
    bf16x8 b0 = *reinterpret_cast<const bf16x8*>((const char*)Ks + KSWZ(r32, cb));
    bf16x8 b1 = *reinterpret_cast<const bf16x8*>((const char*)Ks + KSWZ(32 + r32, cb));
    p0 = __builtin_amdgcn_mfma_f32_32x32x16_bf16(b0, qr[d0], p0, 0, 0, 0);
    p1 = __builtin_amdgcn_mfma_f32_32x32x16_bf16(b1, qr[d0], p1, 0, 0, 0); }
}
__device__ __forceinline__ int v_st(int k, int c) { const int kk = (k & ~0xC) | ((k & 4) << 1) | ((k & 8) >> 1); return ((kk >> 3) * 4 + (c >> 5)) * 512 + ((kk & 7) * 32 + (c & 31)) * 2; }
__device__ __forceinline__ int v_rd_base(int lane) { return ((lane & 3) << 3) | (((lane >> 2) & 3) << 6) | (((lane >> 4) & 1) << 5) | (((lane >> 5) & 1) << 8); }
constexpr int v_rd_off(int d0, int ks, int half) { return d0 * 512 + ks * 4096 + half * 2048; }
template <int OFF> __device__ __forceinline__ s16x4 tr_read(int vb) {
  s16x4 r; asm volatile("ds_read_b64_tr_b16 %0, %1 offset:%2" : "=&v"(r) : "v"(vb), "i"(OFF) : "memory"); return r;
}
template <int D0> __device__ __forceinline__ void pv_one(f32x16& od, int vb, bf16x8 pa0, bf16x8 pa1, bf16x8 pa2, bf16x8 pa3) {
  const s16x4 l0 = tr_read<v_rd_off(D0, 0, 0)>(vb), h0 = tr_read<v_rd_off(D0, 0, 1)>(vb), l1 = tr_read<v_rd_off(D0, 1, 0)>(vb), h1 = tr_read<v_rd_off(D0, 1, 1)>(vb);
  const s16x4 l2 = tr_read<v_rd_off(D0, 2, 0)>(vb), h2 = tr_read<v_rd_off(D0, 2, 1)>(vb), l3 = tr_read<v_rd_off(D0, 3, 0)>(vb), h3 = tr_read<v_rd_off(D0, 3, 1)>(vb);
  asm volatile("s_waitcnt lgkmcnt(0)" ::: "memory"); SBAR();
#define PK(L, H) (bf16x8){L[0], L[1], L[2], L[3], H[0], H[1], H[2], H[3]}
  od = __builtin_amdgcn_mfma_f32_32x32x16_bf16(pa0, PK(l0, h0), od, 0, 0, 0);
  od = __builtin_amdgcn_mfma_f32_32x32x16_bf16(pa1, PK(l1, h1), od, 0, 0, 0);
  od = __builtin_amdgcn_mfma_f32_32x32x16_bf16(pa2, PK(l2, h2), od, 0, 0, 0);
  od = __builtin_amdgcn_mfma_f32_32x32x16_bf16(pa3, PK(l3, h3), od, 0, 0, 0);
#undef PK
}
__device__ __forceinline__ void pv_d0(f32x16* o, int vb, bf16x8 pa0, bf16x8 pa1, bf16x8 pa2, bf16x8 pa3) {
  pv_one<0>(o[0], vb, pa0, pa1, pa2, pa3); pv_one<1>(o[1], vb, pa0, pa1, pa2, pa3); pv_one<2>(o[2], vb, pa0, pa1, pa2, pa3); pv_one<3>(o[3], vb, pa0, pa1, pa2, pa3);
}

template <typename TQ>
__device__ __forceinline__ void attn_dense_body(const TQ* __restrict__ Qb, const bf16* __restrict__ Kh, const bf16* __restrict__ Vh,
                                                bf16* __restrict__ Ob, int seq, char* lds) {
  using St = Stage<bf16>; using SQ = Stage<TQ>;
  const int tid = mk_tid(), wid = tid >> 6, lane = tid & 63, r32 = lane & 31, hi = lane >> 5;
  bf16* V_lds = (bf16*)lds; bf16* K_lds = (bf16*)(lds + 2 * SHM_V);
  float* ws = (float*)(lds + 2 * SHM_V + 2 * SHM_K) + wid * 64; float* li_l = ws; float* al_l = ws + 32;
  float m_reg = -1e30f, l_reg = 0; f32x16 o[4] = {}; bf16x8 qr[8];
  const TQ* Qw = Qb + (long)(wid * QBLK + r32) * LDQ + hi * 8;
#pragma unroll
  for (int d0 = 0; d0 < 8; ++d0) qr[d0] = SQ::tobf(SQ::ld8(Qw + d0 * 16));
  const int sr = tid >> 4, sc = (tid & 15) * 8, vst0 = v_st(sr, sc), vst1 = v_st(32 + sr, sc);
  const int vb0 = (int)(uintptr_t)V_lds + v_rd_base(lane);
  struct { typename St::T vs0, vs1, ks0, ks1; } sr_[SDEPTH];
#define SLOAD(i, k0) do { sr_[i].vs0 = St::ld8(&Vh[(long)((k0) + sr) * LDK + sc]); sr_[i].vs1 = St::ld8(&Vh[(long)((k0) + 32 + sr) * LDK + sc]); \
    sr_[i].ks0 = St::ld8(&Kh[(long)((k0) + sr) * LDK + sc]); sr_[i].ks1 = St::ld8(&Kh[(long)((k0) + 32 + sr) * LDK + sc]); } while (0)
#define SWRITE(b, i) do { *(bf16x8*)((char*)V_lds + (b) * SHM_V + vst0) = St::tobf(sr_[i].vs0);          \
    *(bf16x8*)((char*)V_lds + (b) * SHM_V + vst1) = St::tobf(sr_[i].vs1); int kc = sc * 2;               \
    *(bf16x8*)((char*)K_lds + (b) * SHM_K + KSWZ(sr, kc)) = St::tobf(sr_[i].ks0);                       \
    *(bf16x8*)((char*)K_lds + (b) * SHM_K + KSWZ(32 + sr, kc)) = St::tobf(sr_[i].ks1); } while (0)
#define SWAIT() do { if constexpr (SDEPTH == 2) asm volatile("s_waitcnt vmcnt(4)" ::: "memory"); else asm volatile("s_waitcnt vmcnt(0)" ::: "memory"); } while (0)
#define RESC(a) do { if (__any((a) < 1.f)) { if (hi == 0) al_l[r32] = (a); asm volatile("s_waitcnt lgkmcnt(0)" ::: "memory"); \
    for (int d = 0; d < 4; ++d) for (int r = 0; r < 16; ++r) o[d][r] *= al_l[crow(r, hi)]; } } while (0)
  f32x16 pA0, pA1, pB0, pB1; float mnA, mnB, alA, alB; bf16x8 pa0, pa1, pa2, pa3; const int NT = seq / KVBLK;
  constexpr int SE = 0, SO = SDEPTH - 1;
  SLOAD(SE, 0); asm volatile("s_waitcnt vmcnt(0)" ::: "memory"); SWRITE(0, SE); __syncthreads();
  qkt(pA0, pA1, K_lds, qr, r32, hi); partialSM(pA0, pA1, m_reg, mnA, alA);
  SLOAD(SO, KVBLK); if constexpr (SDEPTH == 2) { if (2 < NT) SLOAD(SE, 2 * KVBLK); }
  SWAIT(); SWRITE(1, SO); __syncthreads();
  for (int j = 1; j + 1 < NT; j += 2) {
    SBAR(); qkt(pB0, pB1, (bf16*)((char*)K_lds + SHM_K), qr, r32, hi);
    finishSM(pA0, pA1, alA, l_reg, pa0, pa1, pa2, pa3); SBAR();
    SLOAD(SO, (j + SDEPTH) * KVBLK); SBAR();
    pv_d0(o, vb0, pa0, pa1, pa2, pa3); partialSM(pB0, pB1, m_reg, mnB, alB);
    __syncthreads(); SWAIT(); SWRITE(0, SE);
    RESC(alB); __syncthreads();
    SBAR(); qkt(pA0, pA1, K_lds, qr, r32, hi);
    finishSM(pB0, pB1, alB, l_reg, pa0, pa1, pa2, pa3); SBAR();
    if (SDEPTH == 1 || j + 3 < NT) SLOAD(SE, (j + 1 + SDEPTH) * KVBLK); SBAR();
    pv_d0(o, vb0 + (int)SHM_V, pa0, pa1, pa2, pa3); partialSM(pA0, pA1, m_reg, mnA, alA);
    __syncthreads(); SWAIT(); SWRITE(1, SO);
    RESC(alA); __syncthreads();
  }
  SBAR(); qkt(pB0, pB1, (bf16*)((char*)K_lds + SHM_K), qr, r32, hi);
  finishSM(pA0, pA1, alA, l_reg, pa0, pa1, pa2, pa3); SBAR();
  pv_d0(o, vb0, pa0, pa1, pa2, pa3); partialSM(pB0, pB1, m_reg, mnB, alB);
  __syncthreads(); RESC(alB);
  finishSM(pB0, pB1, alB, l_reg, pa0, pa1, pa2, pa3); SBAR();
  pv_d0(o, vb0 + (int)SHM_V, pa0, pa1, pa2, pa3);
  if (hi == 0) li_l[r32] = l_reg; asm volatile("s_waitcnt lgkmcnt(0)" ::: "memory");
  float rli[16];
#pragma unroll
  for (int r = 0; r < 16; ++r) rli[r] = __builtin_amdgcn_rcpf(li_l[crow(r, hi)]);
  bf16* Ow = Ob + (long)(wid * QBLK) * LDO;
  __syncthreads();
  bf16* Ot = (bf16*)(lds + wid * 8192);
#pragma unroll
  for (int r = 0; r < 16; ++r) { int orow = crow(r, hi);
    for (int d0 = 0; d0 < 4; ++d0) Ot[orow * 128 + d0 * 32 + r32] = f2bf(o[d0][r] * rli[r]); }
  asm volatile("s_waitcnt lgkmcnt(0)" ::: "memory");
#pragma unroll
  for (int k = 0; k < 8; ++k) { const int pi = k * 64 + lane, orow = pi >> 4, c16 = pi & 15;
    *reinterpret_cast<u32x4*>(Ow + (long)orow * LDO + c16 * 8) = *reinterpret_cast<const u32x4*>(Ot + orow * 128 + c16 * 8); }
#undef SLOAD
#undef SWRITE
#undef SWAIT
#undef RESC
}
}
struct Params { const float* in[29]; float* out; unsigned char* ws; int ph_lo, ph_hi; };
typedef const __attribute__((address_space(4))) Params* PP;
__device__ __forceinline__ PP launder(PP p) {
    const unsigned long long v = (unsigned long long)p; unsigned lo = (unsigned)v, hi = (unsigned)(v >> 32);
    asm volatile("" : "+s"(lo), "+s"(hi));
    return (PP)(((unsigned long long)hi << 32) | lo);
}
enum { I_X = 0, I_C, I_CTX, I_CCTX, I_MODW, I_MODB, I_LNG, I_LNB, I_HGWIN, I_HGWOUT, I_HGLB, I_HGNORM, I_ATWQKV, I_ATWOUT, I_ATQN, I_ATKN,
       I_SSMWIN, I_SSMCW, I_SSMCB, I_SSMDTB, I_SSMALOG, I_SSMD, I_SSMNORM, I_SSMWOUT, I_FFNWG, I_FFNWU, I_FFNCW, I_FFNCB, I_FFNWD };

template <class TT> __device__ __forceinline__ TT* wsp(PP p, size_t off) { return (TT*)(p->ws + off); }
__device__ __forceinline__ const float* modv(PP p, int l, int s, int part) { return wsp<const float>(p, WS_MODV) + ((size_t)(l * 2 + s) * MODN + (size_t)part * D); }
__device__ __forceinline__ const float* xin_row(PP p, int r) { return r < TL ? p->in[I_X] + (size_t)r * D : p->in[I_CTX] + (size_t)(r - TL) * D; }

template <class F> struct EpiFn {
    static constexpr bool PERM = true, AFTER_DRAIN = false;
    F f; bf16_t* part; int N;
    template <int KD> __device__ __forceinline__ void tile(const f32x4 (&acc)[2][2][4][2], const pg8::Unit& u, int wr, int wc, int fr, int fq) const {
        const int row0 = u.pm * 256 + wr * 64 + fr;
#pragma unroll
        for (int bj = 0; bj < 2; ++bj) {
            const int col = u.pn * 256 + bj * 128 + wc * 32 + 8 * fq;
#pragma unroll
            for (int ai = 0; ai < 2; ++ai)
#pragma unroll
                for (int m = 0; m < 4; ++m) f.template store<KD>(row0 + ai * 128 + m * 16, col, acc[ai][bj][m][0], acc[ai][bj][m][1]);
        }
    }
    __device__ __forceinline__ void operator()(const f32x4 (&acc)[2][2][4][2], const pg8::Unit& u, int wr, int wc, int fr, int fq) const {
        if (u.sk >= 0) {
            const int rl0 = wr * 64 + fr;
#pragma unroll
            for (int bj = 0; bj < 2; ++bj) {
                const int col = u.pn * 256 + bj * 128 + wc * 32 + 8 * fq;
#pragma unroll
                for (int ai = 0; ai < 2; ++ai)
#pragma unroll
                    for (int m = 0; m < 4; ++m) st_bf16x8_n(part + ((size_t)(u.sk * 256 + rl0 + ai * 128 + m * 16)) * N + col, acc[ai][bj][m][0], acc[ai][bj][m][1]);
            }
            return;
        }
        const int kd = f.kind(u.pn * 256);
        if (F::NK == 1 || kd == 0) tile<0>(acc, u, wr, wc, fr, fq);
        else if (F::NK == 2 || kd == 1) tile<1>(acc, u, wr, wc, fr, fq);
        else if (F::NK == 3 || kd == 2) tile<2>(acc, u, wr, wc, fr, fq);
        else tile<3>(acc, u, wr, wc, fr, fq);
    }
};
struct FBf16 { bf16_t* O; int ld;
    static constexpr int NK = 1;
    __device__ __forceinline__ int kind(int) const { return 0; }
    template <int KD> __device__ __forceinline__ void store(int row, int col, f32x4 v0, f32x4 v1) const { st_bf16x8(O + (size_t)row * ld + col, v0, v1); } };
struct FHgIn { bf16_t* q; float* lf; bf16_t* k; bf16_t* v; bf16_t* sg; const float* lb;
    static constexpr int NK = 4;
    __device__ __forceinline__ int kind(int col0) const { return col0 < 2048 ? 0 : col0 < 6144 ? 1 : col0 < 10240 ? 2 : 3; }
    template <int KD> __device__ __forceinline__ void store(int row, int col, f32x4 v0, f32x4 v1) const {
        if (KD == 0) {
            f32x4 a, b;
#pragma unroll
            for (int i = 0; i < 4; ++i) { a[i] = siluf_(v0[i]) * 0.08838834764831845f; b[i] = siluf_(v1[i]) * 0.08838834764831845f; }
            st_bf16x8(q + (size_t)row * 2048 + col, a, b);
        } else if (KD == 1) {
            const int cc = col - 2048, d = cc >> 11, c = cc & 2047;
            const float* lp = lb + d * 4096 + c;
            f32x4 fa, fb, ka, kb;
#pragma unroll
            for (int i = 0; i < 8; ++i) {
                const float z = i < 4 ? v0[i & 3] : v1[i & 3];
                const float lbv = lp[i], la = lp[8192 + i], l1 = lp[16384 + i];
                const float e = __expf(-fabsf(z)), r1 = 1.0f / (1.0f + e);
                const float ls = fminf(z, 0.f) - __logf(1.0f + e);
                const float bb = l1 + ls, mx = fmaxf(la, bb);
                const float lfv = mx + __logf(1.0f + __expf(-fabsf(la - bb)));
                const float kv = (1.0f - lbv) * (z >= 0.f ? e * r1 : r1);
                if (i < 4) { fa[i & 3] = lfv; ka[i & 3] = kv; } else { fb[i & 3] = lfv; kb[i & 3] = kv; }
            }
            const size_t o = ((size_t)d * T + row) * 2048 + c;
            *(f32x4*)(lf + o) = fa; *(f32x4*)(lf + o + 4) = fb; st_bf16x8(k + o, ka, kb);
        } else if (KD == 2) {
            st_bf16x8(v + (size_t)row * 4096 + (col - 6144), v0, v1);
        } else {
            f32x4 a, b;
#pragma unroll
            for (int i = 0; i < 4; ++i) { a[i] = siluf_(v0[i]); b[i] = siluf_(v1[i]); }
            st_bf16x8(sg + (size_t)row * 4096 + (col - 10240), a, b);
        }
    } };
struct FAtIn { bf16_t* q; bf16_t* k; bf16_t* v;
    static constexpr int NK = 3;
    __device__ __forceinline__ int kind(int col0) const { return col0 < 4096 ? 0 : col0 < 5120 ? 1 : 2; }
    template <int KD> __device__ __forceinline__ void store(int row, int col, f32x4 v0, f32x4 v1) const {
        if (KD == 0) st_bf16x8(q + (size_t)row * 4096 + col, v0, v1);
        else if (KD == 1) st_bf16x8(k + (size_t)row * 1024 + (col - 4096), v0, v1);
        else st_bf16x8(v + (size_t)row * 1024 + (col - 5120), v0, v1);
    } };
struct FMbIn { bf16_t* z; bf16_t* xbc; float* dt;
    static constexpr int NK = 3;
    __device__ __forceinline__ int kind(int col0) const { return col0 < 8192 ? 0 : col0 < 18432 ? 1 : 2; }
    template <int KD> __device__ __forceinline__ void store(int row, int col, f32x4 v0, f32x4 v1) const {
        if (KD == 0) st_bf16x8(z + (size_t)row * 8192 + col, v0, v1);
        else if (KD == 1) st_bf16x8(xbc + (size_t)row * 10240 + (col - 8192), v0, v1);
        else { float* o = dt + (size_t)row * 256 + (col - 18432); *(f32x4*)o = v0; *(f32x4*)(o + 4) = v1; }
    } };

template <class F> __device__ __forceinline__ void run_gemm(PP p, LAS unsigned char* lds, const bf16_t* A, const bf16_t* Bt, int M, int N, int K, const F& f) {
    pg8::Gemm g{A, Bt, M, N, K}; pg8::TailOrder S; S.init(TL, N, K, (int)gridDim.x, (int)mk_bid(), M > TL);
    EpiFn<F> E{f, wsp<bf16_t>(p, WS_PART), N};
    pg8::gemm_phase<EpiFn<F>, pg8::TailOrder>(lds, g, S, E);
}
template <class F> __device__ __forceinline__ void run_ctx_reduce(PP p, int N, int K, const F& f) {
    const int tid = mk_tid(), G = gridDim.x, SK = pg8::TailOrder::pick_sk(N / 256, K / 64), ng = N / 8;
    const bf16_t* part = wsp<const bf16_t>(p, WS_PART);
    for (int idx = mk_bid() * NT + tid; idx < 256 * ng; idx += G * NT) {
        const int row = idx / ng, col = (idx % ng) * 8;
        f32x4 v0 = {0.f, 0.f, 0.f, 0.f}, v1 = {0.f, 0.f, 0.f, 0.f};
        for (int s0 = 0; s0 < SK; s0 += 8) {
            u32x4 raw[8];
#pragma unroll
            for (int i = 0; i < 8; ++i) { const int s = s0 + i < SK ? s0 + i : SK - 1; raw[i] = *(const u32x4*)(part + ((size_t)(s * 256 + row)) * N + col); }
#pragma unroll
            for (int i = 0; i < 8; ++i) if (s0 + i < SK) {
                v0 += (f32x4){bf_lo(raw[i].x), bf_hi(raw[i].x), bf_lo(raw[i].y), bf_hi(raw[i].y)}; v1 += (f32x4){bf_lo(raw[i].z), bf_hi(raw[i].z), bf_lo(raw[i].w), bf_hi(raw[i].w)};
            }
        }
        const int kd = f.kind(col & ~255);
        if (F::NK == 1 || kd == 0) f.template store<0>(TL + row, col, v0, v1);
        else if (F::NK == 2 || kd == 1) f.template store<1>(TL + row, col, v0, v1);
        else if (F::NK == 3 || kd == 2) f.template store<2>(TL + row, col, v0, v1);
        else f.template store<3>(TL + row, col, v0, v1);
    }
}

__device__ __forceinline__ float dpp_ror1(float x) { return __int_as_float(__builtin_amdgcn_update_dpp(0, __float_as_int(x), 0x121, 0xF, 0xF, false)); }
__device__ __forceinline__ float dpp_ror15(float x) { return __int_as_float(__builtin_amdgcn_update_dpp(0, __float_as_int(x), 0x12F, 0xF, 0xF, false)); }
struct EpiGu {
    static constexpr bool PERM = true, AFTER_DRAIN = false;
    bf16_t* hid; bf16_t* part; float* edge; const float* cw; const float* cb; LAS unsigned char* halo;
    __device__ __forceinline__ void operator()(const f32x4 (&acc)[2][2][4][2], const pg8::Unit& u, int wr, int wc, int fr, int fq) const {
        if (u.sk >= 0) {
            const int rl0 = wr * 64 + fr;
#pragma unroll
            for (int bj = 0; bj < 2; ++bj) {
                const int col = u.pn * 256 + bj * 128 + wc * 32 + 8 * fq;
#pragma unroll
                for (int ai = 0; ai < 2; ++ai)
#pragma unroll
                    for (int m = 0; m < 4; ++m) st_bf16x8_n(part + ((size_t)(u.sk * 256 + rl0 + ai * 128 + m * 16)) * 8192 + col, acc[ai][bj][m][0], acc[ai][bj][m][1]);
            }
            return;
        }
        const int hc = u.pn * 128 + wc * 32 + 8 * fq;
        LAS float* H = (LAS float*)halo;
        const int hcol = wc * 32 + 8 * fq;
#pragma unroll
        for (int ai = 0; ai < 2; ++ai) {
            if (fr == 0)  { *(LAS f32x4*)(H + ((ai * 2 + wr) * 2 + 0) * 128 + hcol) = acc[ai][0][0][0]; *(LAS f32x4*)(H + ((ai * 2 + wr) * 2 + 0) * 128 + hcol + 4) = acc[ai][0][0][1]; }
            if (fr == 15) { *(LAS f32x4*)(H + ((ai * 2 + wr) * 2 + 1) * 128 + hcol) = acc[ai][0][3][0]; *(LAS f32x4*)(H + ((ai * 2 + wr) * 2 + 1) * 128 + hcol + 4) = acc[ai][0][3][1]; }
        }
        asm volatile("s_waitcnt lgkmcnt(0)\n\ts_barrier\n\ts_barrier" ::: "memory");
        float w0[8], w1[8], w2[8], bb[8];
        { const f32x4 a0 = *(const f32x4*)(cw + hc), a1 = *(const f32x4*)(cw + hc + 4), b0 = *(const f32x4*)(cw + D + hc), b1 = *(const f32x4*)(cw + D + hc + 4);
          const f32x4 c0 = *(const f32x4*)(cw + 2 * D + hc), c1 = *(const f32x4*)(cw + 2 * D + hc + 4), d0 = *(const f32x4*)(cb + hc), d1 = *(const f32x4*)(cb + hc + 4);
#pragma unroll
          for (int j = 0; j < 4; ++j) { w0[j] = a0[j]; w0[4 + j] = a1[j]; w1[j] = b0[j]; w1[4 + j] = b1[j]; w2[j] = c0[j]; w2[4 + j] = c1[j]; bb[j] = d0[j]; bb[4 + j] = d1[j]; } }
        const int row0 = u.pm * 256 + wr * 64 + fr;
#pragma unroll
        for (int ai = 0; ai < 2; ++ai) {
            const bool hasp = (wr == 1) || (ai == 1), hasn = (wr == 0) || (ai == 0);
            const int pb = wr == 1 ? (ai * 2 + 0) : ((ai - 1) * 2 + 1), nb = wr == 0 ? (ai * 2 + 1) : ((ai + 1) * 2 + 0);
            float hp[8], hn[8];
            { f32x4 x0 = {0.f, 0.f, 0.f, 0.f}, x1 = x0, y0 = x0, y1 = x0;
              if (hasp) { x0 = *(LAS const f32x4*)(H + (pb * 2 + 1) * 128 + hcol); x1 = *(LAS const f32x4*)(H + (pb * 2 + 1) * 128 + hcol + 4); }
              if (hasn) { y0 = *(LAS const f32x4*)(H + (nb * 2 + 0) * 128 + hcol); y1 = *(LAS const f32x4*)(H + (nb * 2 + 0) * 128 + hcol + 4); }
#pragma unroll
              for (int j = 0; j < 4; ++j) { hp[j] = x0[j]; hp[4 + j] = x1[j]; hn[j] = y0[j]; hn[4 + j] = y1[j]; } }
#pragma unroll
            for (int m = 0; m < 4; ++m) {
                float h[8];
#pragma unroll
                for (int j = 0; j < 8; ++j) {
                    const float a = j < 4 ? acc[ai][0][m][0][j & 3] : acc[ai][0][m][1][j & 3], up = j < 4 ? acc[ai][1][m][0][j & 3] : acc[ai][1][m][1][j & 3];
                    const float am = m > 0 ? (j < 4 ? acc[ai][0][m > 0 ? m - 1 : 0][0][j & 3] : acc[ai][0][m > 0 ? m - 1 : 0][1][j & 3]) : 0.f;
                    const float ap = m < 3 ? (j < 4 ? acc[ai][0][m < 3 ? m + 1 : 3][0][j & 3] : acc[ai][0][m < 3 ? m + 1 : 3][1][j & 3]) : 0.f;
                    const float p1 = dpp_ror1(a), p2 = m > 0 ? dpp_ror1(am) : hp[j];
                    const float n1 = dpp_ror15(a), n2 = m < 3 ? dpp_ror15(ap) : hn[j];
                    const float prev = fr > 0 ? p1 : p2, next = fr < 15 ? n1 : n2;
                    h[j] = siluf_(bb[j] + w0[j] * prev + w1[j] * a + w2[j] * next) * up;
                }
                u32x4 w; w.x = cvt_pk_bf16(h[0], h[1]); w.y = cvt_pk_bf16(h[2], h[3]); w.z = cvt_pk_bf16(h[4], h[5]); w.w = cvt_pk_bf16(h[6], h[7]);
                *(u32x4*)(hid + (size_t)(row0 + ai * 128 + m * 16) * D + hc) = w;
            }
        }
        float* E = edge + (size_t)u.pm * 6 * D + hc;
        if (wr == 0 && fr < 2)  { *(f32x4*)(E + (size_t)fr * D) = acc[0][0][0][0]; *(f32x4*)(E + (size_t)fr * D + 4) = acc[0][0][0][1]; }
        if (wr == 0 && fr == 0) { *(f32x4*)(E + (size_t)4 * D) = acc[0][1][0][0]; *(f32x4*)(E + (size_t)4 * D + 4) = acc[0][1][0][1]; }
        if (wr == 1 && fr >= 14) { *(f32x4*)(E + (size_t)(fr - 12) * D) = acc[1][0][3][0]; *(f32x4*)(E + (size_t)(fr - 12) * D + 4) = acc[1][0][3][1]; }
        if (wr == 1 && fr == 15) { *(f32x4*)(E + (size_t)5 * D) = acc[1][1][3][0]; *(f32x4*)(E + (size_t)5 * D + 4) = acc[1][1][3][1]; }
    }
};
__device__ __forceinline__ void run_gemm_gu(PP p, LAS unsigned char* lds, int l, int M) {
    pg8::Gemm g{wsp<const bf16_t>(p, WS_H), wsp<const bf16_t>(p, WS_GU + l * SZ_GU), M, 8192, D}; pg8::TailOrder S; S.init(TL, 8192, D, (int)gridDim.x, (int)mk_bid(), M > TL);
    EpiGu E{wsp<bf16_t>(p, WS_HID), wsp<bf16_t>(p, WS_PART), wsp<float>(p, WS_EDGE), p->in[I_FFNCW] + (size_t)l * 3 * D, p->in[I_FFNCB] + (size_t)l * D, lds + LDS_HALO};
    pg8::gemm_phase<EpiGu, pg8::TailOrder>(lds, g, S, E);
}

struct WMat { const float* src; bf16_t* dst; int K, N, ldn, il; };
__device__ __forceinline__ WMat wmat(PP p, int id) {
    WMat w; w.il = 0;
    if (id < 2)       { w.src = p->in[I_HGWIN] + (size_t)id * D * HG_PROJ; w.dst = wsp<bf16_t>(p, WS_HGIN + id * SZ_HGIN); w.K = D; w.N = HG_PROJ; w.ldn = HG_PROJ; }
    else if (id < 4)  { const int j = id - 2; w.src = p->in[I_HGWOUT] + (size_t)j * D * D; w.dst = wsp<bf16_t>(p, WS_HGOUT + j * SZ_SQ); w.K = D; w.N = D; w.ldn = D; }
    else if (id == 4) { w.src = p->in[I_ATWQKV]; w.dst = wsp<bf16_t>(p, WS_ATQKV); w.K = D; w.N = AT_PROJ; w.ldn = AT_PROJ; }
    else if (id == 5) { w.src = p->in[I_ATWOUT]; w.dst = wsp<bf16_t>(p, WS_ATOUT); w.K = D; w.N = D; w.ldn = D; }
    else if (id == 6) { w.src = p->in[I_SSMWIN]; w.dst = wsp<bf16_t>(p, WS_SSMIN); w.K = D; w.N = SSM_PROJ; w.ldn = SSM_PROJ; }
    else if (id == 7) { w.src = p->in[I_SSMWOUT]; w.dst = wsp<bf16_t>(p, WS_SSMOUT); w.K = 8192; w.N = D; w.ldn = D; }
    else if (id < 12) { const int l = id - 8; w.src = p->in[I_FFNWG] + (size_t)l * D * D; w.dst = wsp<bf16_t>(p, WS_GU + l * SZ_GU); w.K = D; w.N = D; w.ldn = D; w.il = 1; }
    else if (id < 16) { const int l = id - 12; w.src = p->in[I_FFNWU] + (size_t)l * D * D; w.dst = wsp<bf16_t>(p, WS_GU + l * SZ_GU); w.K = D; w.N = D; w.ldn = D; w.il = 2; }
    else              { const int l = id - 16; w.src = p->in[I_FFNWD] + (size_t)l * D * D; w.dst = wsp<bf16_t>(p, WS_FD + l * SZ_SQ); w.K = D; w.N = D; w.ldn = D; }
    return w;
}
constexpr int N_WMAT = 20;
__device__ __forceinline__ void wt_tile(const WMat& w, int tk, int tn, LAS unsigned* T32  , int tid) {
    const int k0 = tk * 128, n0 = tn * 64;
    const int r = tid >> 4, c4 = (tid & 15) * 4;
#pragma unroll
    for (int i = 0; i < 2; ++i) {
        const int kk = 2 * r + 64 * i;
        const f32x4 a = *(const f32x4*)(w.src + (size_t)(k0 + kk) * w.ldn + n0 + c4);
        const f32x4 b = *(const f32x4*)(w.src + (size_t)(k0 + kk + 1) * w.ldn + n0 + c4);
#pragma unroll
        for (int j = 0; j < 4; ++j) T32[(c4 + j) * 65 + (kk >> 1)] = cvt_pk_bf16(a[j], b[j]);
    }
    __syncthreads();
    const int n = tid >> 3, q = tid & 7;
    u32x4 o0, o1;
    o0.x = T32[n * 65 + q * 8 + 0]; o0.y = T32[n * 65 + q * 8 + 1]; o0.z = T32[n * 65 + q * 8 + 2]; o0.w = T32[n * 65 + q * 8 + 3];
    o1.x = T32[n * 65 + q * 8 + 4]; o1.y = T32[n * 65 + q * 8 + 5]; o1.z = T32[n * 65 + q * 8 + 6]; o1.w = T32[n * 65 + q * 8 + 7];
    const int nr = n0 + n, orow = w.il ? 256 * (nr >> 7) + (nr & 127) + (w.il == 2 ? 128 : 0) : nr;
    bf16_t* dp = w.dst + (size_t)orow * w.K + k0 + q * 16;
    *(u32x4*)dp = o0; *(u32x4*)(dp + 8) = o1;
    __syncthreads();
}
__device__ __forceinline__ void phase_prologue1(PP p, LAS unsigned char* lds) {
    const int tid = mk_tid(), G = gridDim.x, b = mk_bid();
    LAS unsigned* T32 = (LAS unsigned*)lds;
    for (int id = 0; id < N_WMAT; ++id) {
        const WMat w = wmat(p, id);
        const int nk = w.K / 128, nn = w.N / 64, ntile = nk * nn;
        for (int t = b; t < ntile; t += G) wt_tile(w, t % nk, t / nk, T32, tid);
    }
    LAS float* cs = (LAS float*)(lds + 32768);
    for (int task = b; task < 4 * 32 * 12; task += G) {
        const int cb = task % 12, ks = (task / 12) % 32, l = task / (12 * 32);
        __syncthreads();
        if (tid < 256) { const int s = tid >> 7, i = tid & 127; const float cv = (s == 0 ? p->in[I_C] : p->in[I_CCTX])[ks * 128 + i]; cs[tid] = siluf_(cv); }
        __syncthreads();
        const int j0 = cb * 2048 + tid * 4;
        const float* wp = p->in[I_MODW] + ((size_t)l * D + (size_t)ks * 128) * MODN + j0;
        f32x4 al = {0.f, 0.f, 0.f, 0.f}, ac = {0.f, 0.f, 0.f, 0.f};
#pragma unroll 8
        for (int i = 0; i < 128; ++i) { const f32x4 wv = *(const f32x4*)(wp + (size_t)i * MODN); al += cs[i] * wv; ac += cs[128 + i] * wv; }
        float* pp = wsp<float>(p, WS_MODP) + ((size_t)(ks * 4 + l) * 2) * MODN + j0;
        *(f32x4*)pp = al; *(f32x4*)(pp + MODN) = ac;
    }
    if (b == 0 && tid < 32) {
        const int j = tid; double th = 1.0;
        for (int i = 0; i < j; ++i) th *= 0.7498942093324559;
        const double t2 = th * th; double ct = 1.0, st = th, tc = 1.0, ts = th;
        for (int n = 1; n <= 14; ++n) { tc *= -t2 / (double)((2 * n - 1) * (2 * n)); ts *= -t2 / (double)((2 * n) * (2 * n + 1)); ct += tc; st += ts; }
        double cc = 1.0, ss = 0.0; float* o = wsp<float>(p, WS_ROPE);
        for (int pos = 0; pos < 256; ++pos) { o[(size_t)(pos * 32 + j) * 2] = (float)cc; o[(size_t)(pos * 32 + j) * 2 + 1] = (float)ss; const double nc = cc * ct - ss * st, ns = ss * ct + cc * st; cc = nc; ss = ns; }
    }
    for (int i = b * NT + tid; i < 2 * 2048; i += G * NT) {
        const int d = i >> 11, c = i & 2047;
        const float r0 = p->in[I_HGLB][(size_t)(d * 2 + 0) * 2048 + c], r1 = p->in[I_HGLB][(size_t)(d * 2 + 1) * 2048 + c];
        const float m = fmaxf(r0, r1), e0 = __expf(r0 - m), e1 = __expf(r1 - m);
        float* o = wsp<float>(p, WS_LB);
        const float lb1 = e1 / (e0 + e1);
        o[(size_t)(d * 2 + 0) * 2048 + c] = 0.f; o[8192 + (size_t)(d * 2 + 0) * 2048 + c] = -__builtin_inff(); o[16384 + (size_t)(d * 2 + 0) * 2048 + c] = 0.f;
        o[(size_t)(d * 2 + 1) * 2048 + c] = lb1; o[8192 + (size_t)(d * 2 + 1) * 2048 + c] = __logf(lb1); o[16384 + (size_t)(d * 2 + 1) * 2048 + c] = __logf(1.0f - lb1);
    }
}
__device__ __forceinline__ void phase_modreduce(PP p) {
    const int tid = mk_tid(), G = gridDim.x, b = mk_bid();
    for (int i = b * NT + tid; i < 4 * 2 * MODN; i += G * NT) {
        const int j = i % MODN, l = i / (2 * MODN);
        float s = p->in[I_MODB][(size_t)l * MODN + j];
        const float* pp = wsp<const float>(p, WS_MODP) + i;
#pragma unroll 8
        for (int ks = 0; ks < 32; ++ks) s += pp[(size_t)ks * 4 * 2 * MODN];
        wsp<float>(p, WS_MODV)[i] = s;
    }
}
__device__ __forceinline__ void phase_mod0(PP p) {
    const int tid = mk_tid(), G = gridDim.x, b = mk_bid();
    bf16_t* H = wsp<bf16_t>(p, WS_H);
    const int c = ((b * NT + tid) & 511) * 8, r00 = (b * NT + tid) >> 9, rs = (G * NT) >> 9;
    for (int s = 0; s < 2; ++s) {
        const float* sh = modv(p, 0, s, 0) + c; const float* sc = modv(p, 0, s, 1) + c;
        const f32x4 h0 = *(const f32x4*)sh, h1 = *(const f32x4*)(sh + 4), c0 = 1.0f + *(const f32x4*)sc, c1 = 1.0f + *(const f32x4*)(sc + 4);
        const int rlo = s == 0 ? 0 : TL, rhi = s == 0 ? TL : T;
        for (int r = rlo + r00; r < rhi; r += 4 * rs) {
            f32x4 x0[4], x1[4];
#pragma unroll
            for (int u = 0; u < 4; ++u) { const int ru = r + u * rs < rhi ? r + u * rs : r; const float* xr = xin_row(p, ru) + c; x0[u] = *(const f32x4*)xr; x1[u] = *(const f32x4*)(xr + 4); }
#pragma unroll
            for (int u = 0; u < 4; ++u) if (r + u * rs < rhi) st_bf16x8(H + (size_t)(r + u * rs) * D + c, x0[u] * c0 + h0, x1[u] * c1 + h1);
        }
    }
}

constexpr float XQ_MAGIC = 12615680.0f;
__device__ __forceinline__ float xq_lo(unsigned w) { return __uint_as_float((w & 0xffffu) | 0x4B400000u) - XQ_MAGIC; }
__device__ __forceinline__ float xq_hi(unsigned w) { return __uint_as_float((w >> 16) | 0x4B400000u) - XQ_MAGIC; }
__device__ __forceinline__ unsigned xq_pack(float y0, float y1, float inv) { return (__float_as_uint(fmaf(y0, inv, XQ_MAGIC)) & 0xffffu) | (__float_as_uint(fmaf(y1, inv, XQ_MAGIC)) << 16); }
__device__ __forceinline__ float amax4(float m, f32x4 y) { return fmaxf(fmaxf(m, fmaxf(fabsf(y[0]), fabsf(y[1]))), fmaxf(fabsf(y[2]), fabsf(y[3]))); }
template <class Op> __device__ __forceinline__ float ln_reduce8(const float (&s)[8], int lane, Op op) {
    float t[4], u[2];
    { const bool hi = lane & 32;
#pragma unroll
      for (int k = 0; k < 4; ++k) { const float send = hi ? s[k] : s[4 + k], keep = hi ? s[4 + k] : s[k]; t[k] = op(keep, xch32(send, lane)); } }
    { const bool hi = lane & 16;
#pragma unroll
      for (int k = 0; k < 2; ++k) { const float send = hi ? t[k] : t[2 + k], keep = hi ? t[2 + k] : t[k]; u[k] = op(keep, xch16(send, lane)); } }
    float w;
    { const bool hi = lane & 8; const float send = hi ? u[0] : u[1], keep = hi ? u[1] : u[0]; w = op(keep, dpp_mov<0x128>(send)); }
    w = op(w, dpp_mov<0xB1>(w)); w = op(w, dpp_mov<0x4E>(w)); w = op(w, dpp_mov<0x141>(w));
    return w;
}
typedef OpSum LnSum; typedef OpMax LnMax;
template <bool FIRST> struct LnRaw { u32x4 x[FIRST ? 16 : 8]; u32x4 o[8]; float xs; };
__device__ __forceinline__ float sum8_(f32x4 a, f32x4 b) { return ((a[0] + a[1]) + (a[2] + a[3])) + ((b[0] + b[1]) + (b[2] + b[3])); }
template <bool FIRST, bool LAST> __device__ __forceinline__ void ln_latent(PP p, LAS unsigned char* lds, int l, int which) {
    const int tid = mk_tid(), lane = tid & 63, wid = __builtin_amdgcn_readfirstlane(tid >> 6), G = gridDim.x, b = mk_bid();
    const unsigned c = (unsigned)(wid & 7) * 512u + (unsigned)lane * 8u; const int NB = TL / 8;
    LAS float* red = (LAS float*)(lds + 98304);
    const bf16_t* OB = wsp<const bf16_t>(p, WS_OB); bf16_t* XQ = wsp<bf16_t>(p, WS_X); float* XS = (float*)(p->ws + WS_X + (size_t)T * D * 2); bf16_t* H = wsp<bf16_t>(p, WS_H);
    LAS const float* vg = (LAS const float*)lds;
    const int k = (wid & 7) * 64 + lane;
#define LNV(vi, hf) (*(const LAS f32x4*)(vg + (vi) * D + (hf) * 2048 + k * 4))
    auto load = [&](int bt, LnRaw<FIRST>& w) {
        const int r0 = (bt < NB ? bt : NB - 1) * 8;
#pragma unroll
        for (int j = 0; j < 8; ++j) {
            const size_t ro = (size_t)(r0 + j) * D;
            w.o[j] = *(const u32x4*)(OB + ro + c);
            if (FIRST) { const float* xr = p->in[I_X] + ro; w.x[2 * j] = *(const u32x4*)(xr + c); w.x[2 * j + 1] = *(const u32x4*)(xr + c + 4u); }
            else w.x[j] = *(const u32x4*)(XQ + ro + c);
        }
        if (!FIRST) w.xs = XS[r0 + (lane & 7)];
    };
    auto exchange = [&](int k, float wv, float (&tot)[8], bool is_max) {
        if ((lane & 7) == 0) red[(k * 8 + wid) * 8 + (lane >> 3)] = wv;
        lds_barrier();
        f32x4 a0 = *(const LAS f32x4*)(red + k * 64), a1 = *(const LAS f32x4*)(red + k * 64 + 4);
#pragma unroll
        for (int w = 1; w < 8; ++w) {
            const f32x4 c0 = *(const LAS f32x4*)(red + (k * 8 + w) * 8), c1 = *(const LAS f32x4*)(red + (k * 8 + w) * 8 + 4);
            if (is_max) {
#pragma unroll
                for (int e = 0; e < 4; ++e) { a0[e] = fmaxf(a0[e], c0[e]); a1[e] = fmaxf(a1[e], c1[e]); }
            } else { a0 += c0; a1 += c1; }
        }
#pragma unroll
        for (int j = 0; j < 8; ++j) tot[j] = j < 4 ? a0[j & 3] : a1[j & 3];
    };
    auto process = [&](int bt, const LnRaw<FIRST>& w, bool valid) {
        int r0 = (bt < NB ? bt : NB - 1) * 8;
        asm volatile("" : "+s"(r0));
        f32x4 v0[8], v1[8]; float s[8], tot[8];
        const f32x4 gt0 = LNV(0, 0), gt1 = LNV(0, 1);
#pragma unroll
        for (int j = 0; j < 8; ++j) {
            const u32x4 ow = w.o[j];
            const f32x4 o0 = {bf_lo(ow.x), bf_hi(ow.x), bf_lo(ow.y), bf_hi(ow.y)}, o1 = {bf_lo(ow.z), bf_hi(ow.z), bf_lo(ow.w), bf_hi(ow.w)};
            if (FIRST) {
                v0[j] = ALPHA * __builtin_bit_cast(f32x4, w.x[2 * j]) + gt0 * o0; v1[j] = ALPHA * __builtin_bit_cast(f32x4, w.x[2 * j + 1]) + gt1 * o1;
            } else {
                const float as = ALPHA * __uint_as_float(__builtin_amdgcn_readlane(__float_as_uint(w.xs), j));
                const u32x4 xw = w.x[j];
                const f32x4 q0 = {xq_lo(xw.x), xq_hi(xw.x), xq_lo(xw.y), xq_hi(xw.y)}, q1 = {xq_lo(xw.z), xq_hi(xw.z), xq_lo(xw.w), xq_hi(xw.w)};
                v0[j] = as * q0 + gt0 * o0; v1[j] = as * q1 + gt1 * o1;
            }
            s[j] = sum8_(v0[j], v1[j]);
        }
        exchange(0, ln_reduce8(s, lane, LnSum()), tot, false);
#pragma unroll
        for (int j = 0; j < 8; ++j) { const float mean = tot[j] * (1.0f / D); v0[j] = v0[j] - mean; v1[j] = v1[j] - mean; s[j] = sum8_(v0[j] * v0[j], v1[j] * v1[j]); }
        exchange(1, ln_reduce8(s, lane, LnSum()), tot, false);
        const f32x4 g0 = LNV(1, 0), g1 = LNV(1, 1), b0 = LNV(2, 0), b1 = LNV(2, 1);
#pragma unroll
        for (int j = 0; j < 8; ++j) {
            const float rstd = rsqrtf(tot[j] * (1.0f / D) + LN_EPS);
            v0[j] = v0[j] * (rstd * g0) + b0; v1[j] = v1[j] * (rstd * g1) + b1;
            if (!LAST) s[j] = amax4(amax4(0.f, v0[j]), v1[j]);
        }
        if (LAST) {
            if (valid) {
#pragma unroll
                for (int j = 0; j < 8; ++j) { float* o = p->out + (size_t)(r0 + j) * D; *(f32x4*)(o + c) = v0[j]; *(f32x4*)(o + c + 4u) = v1[j]; }
            }
        } else {
            exchange(2, ln_reduce8(s, lane, LnMax()), tot, true);
            if (valid) {
                const f32x4 sc0 = 1.0f + LNV(3, 0), sc1 = 1.0f + LNV(3, 1), sh0 = LNV(4, 0), sh1 = LNV(4, 1);
                float mine = 0.f;
#pragma unroll
                for (int j = 0; j < 8; ++j) {
                    const float M = fmaxf(tot[j], 1e-20f), inv = 32767.0f / M;
                    mine = lane == j ? M * (1.0f / 32767.0f) : mine;
                    const size_t ro = (size_t)(r0 + j) * D;
                    u32x4 xw; xw.x = xq_pack(v0[j][0], v0[j][1], inv); xw.y = xq_pack(v0[j][2], v0[j][3], inv); xw.z = xq_pack(v1[j][0], v1[j][1], inv); xw.w = xq_pack(v1[j][2], v1[j][3], inv);
                    *(u32x4*)(XQ + ro + c) = xw;
                    st_bf16x8(H + ro + c, v0[j] * sc0 + sh0, v1[j] * sc1 + sh1);
                }
                if (wid == 0 && lane < 8) XS[r0 + lane] = mine;
            }
        }
    };
    const int nmine = b < NB ? (NB - b + G - 1) / G : 0;
    if (FIRST) {
        LnRaw<FIRST> ra;
        for (int i = 0; i < nmine; ++i) { load(b + i * G, ra); process(b + i * G, ra, true); }
    } else {
        LnRaw<FIRST> ra, rb;
        load(b, ra);
#pragma unroll 1
        for (int i = 0; i < nmine; i += 2) {
            load(b + (i + 1) * G, rb); process(b + i * G, ra, true);
            load(b + (i + 2) * G, ra); process(b + (i + 1) * G, rb, i + 1 < nmine);
        }
    }
}
#undef LNV
__device__ __forceinline__ void phase_ln(PP p, LAS unsigned char* lds, int l, int which  ) {
    const int tid = mk_tid(), lane = tid & 63, wid = tid >> 6, G = gridDim.x, b = mk_bid();
    LAS float* vg = (LAS float*)lds;
    const bool last = (l == DEPTH - 1 && which == 1), first = (l == 0 && which == 0);
    const bf16_t* OB = wsp<const bf16_t>(p, WS_OB); bf16_t* XQ = wsp<bf16_t>(p, WS_X); float* XS = (float*)(p->ws + WS_X + (size_t)T * D * 2); bf16_t* H = wsp<bf16_t>(p, WS_H);
    const float* lg = p->in[I_LNG] + (size_t)(l * 2 + which) * D; const float* lbv = p->in[I_LNB] + (size_t)(l * 2 + which) * D;
    for (int s = 0; s < 2; ++s) {
        if (s == 1 && l == DEPTH - 1) break;
        __syncthreads();
        const float* gt = modv(p, l, s, which == 0 ? 2 : 5);
        const float* sc = last ? nullptr : (which == 0 ? modv(p, l, s, 4) : modv(p, l + 1, s, 1));
        const float* sh = last ? nullptr : (which == 0 ? modv(p, l, s, 3) : modv(p, l + 1, s, 0));
        for (int i = tid; i < D; i += NT) { const int ps = ((i >> 2) & 1) * 2048 + (i >> 3) * 4 + (i & 3); vg[ps] = gt[i]; vg[D + ps] = lg[i]; vg[2 * D + ps] = lbv[i]; vg[3 * D + ps] = sc ? sc[i] : 0.f; vg[4 * D + ps] = sh ? sh[i] : 0.f; }
        __syncthreads();
        if (s == 0) { if (first) ln_latent<true, false>(p, lds, l, which); else if (last) ln_latent<false, true>(p, lds, l, which); else ln_latent<false, false>(p, lds, l, which); continue; }
#define LN_VEC(vi, k, hf) (*(const LAS f32x4*)(vg + (vi) * D + (hf) * 2048 + (k) * 4))
        auto load_piece = [&](int r, int c, int k, float as, f32x4& v0, f32x4& v1) {
            const bf16_t* part = wsp<const bf16_t>(p, WS_PART) + (size_t)(r - TL) * D + c;
            u32x4 pw[16];
#pragma unroll
            for (int sk = 0; sk < 16; ++sk) pw[sk] = *(const u32x4*)(part + (size_t)sk * 256 * D);
            f32x4 o0 = {0.f, 0.f, 0.f, 0.f}, o1 = o0;
#pragma unroll
            for (int sk = 0; sk < 16; ++sk) { o0 += (f32x4){bf_lo(pw[sk].x), bf_hi(pw[sk].x), bf_lo(pw[sk].y), bf_hi(pw[sk].y)}; o1 += (f32x4){bf_lo(pw[sk].z), bf_hi(pw[sk].z), bf_lo(pw[sk].w), bf_hi(pw[sk].w)}; }
            if (first) {
                const float* xr = xin_row(p, r) + c;
                v0 = ALPHA * *(const f32x4*)xr + LN_VEC(0, k, 0) * o0; v1 = ALPHA * *(const f32x4*)(xr + 4) + LN_VEC(0, k, 1) * o1;
            } else {
                const u32x4 xw = *(const u32x4*)(XQ + (size_t)r * D + c);
                const f32x4 q0 = {xq_lo(xw.x), xq_hi(xw.x), xq_lo(xw.y), xq_hi(xw.y)}, q1 = {xq_lo(xw.z), xq_hi(xw.z), xq_lo(xw.w), xq_hi(xw.w)};
                v0 = as * q0 + LN_VEC(0, k, 0) * o0; v1 = as * q1 + LN_VEC(0, k, 1) * o1;
            }
        };
        auto store_piece = [&](int r, int c, int k, f32x4 y0, f32x4 y1, float inv) {
            u32x4 xw; xw.x = xq_pack(y0[0], y0[1], inv); xw.y = xq_pack(y0[2], y0[3], inv); xw.z = xq_pack(y1[0], y1[1], inv); xw.w = xq_pack(y1[2], y1[3], inv);
            *(u32x4*)(XQ + (size_t)r * D + c) = xw;
            st_bf16x8(H + (size_t)r * D + c, y0 * (1.0f + LN_VEC(3, k, 0)) + LN_VEC(4, k, 0), y1 * (1.0f + LN_VEC(3, k, 1)) + LN_VEC(4, k, 1));
        };
        if (s == 1) {
            if (l < DEPTH - 1) {
                LAS float* red = vg + 5 * D;
                for (int rr = b; rr < TC; rr += G) {
                    const int r = TL + rr, c = wid * 512 + lane * 8, k = wid * 64 + lane;
                    f32x4 v0, v1;
                    load_piece(r, c, k, first ? 0.f : ALPHA * XS[r], v0, v1);
                    const float ws_ = wave_sum(((v0[0] + v0[1]) + (v0[2] + v0[3])) + ((v1[0] + v1[1]) + (v1[2] + v1[3]))); if (lane == 0) red[wid] = ws_;
                    __syncthreads();
                    float tot = 0.f;
#pragma unroll
                    for (int w = 0; w < 8; ++w) tot += red[w];
                    const float mean = tot * (1.0f / D);
                    const f32x4 d0 = v0 - mean, d1 = v1 - mean;
                    const float wq = wave_sum(((d0[0] * d0[0] + d0[1] * d0[1]) + (d0[2] * d0[2] + d0[3] * d0[3])) + ((d1[0] * d1[0] + d1[1] * d1[1]) + (d1[2] * d1[2] + d1[3] * d1[3]))); if (lane == 0) red[8 + wid] = wq;
                    __syncthreads();
                    float qt = 0.f;
#pragma unroll
                    for (int w = 0; w < 8; ++w) qt += red[8 + w];
                    const float rstd = rsqrtf(qt * (1.0f / D) + LN_EPS);
                    const f32x4 y0 = d0 * rstd * LN_VEC(1, k, 0) + LN_VEC(2, k, 0), y1 = d1 * rstd * LN_VEC(1, k, 1) + LN_VEC(2, k, 1);
                    const float wm = wave_max(amax4(amax4(0.f, y0), y1)); if (lane == 0) red[16 + wid] = wm;
                    __syncthreads();
                    float M = 1e-20f;
#pragma unroll
                    for (int w = 0; w < 8; ++w) M = fmaxf(M, red[16 + w]);
                    if (tid == 0) XS[r] = M * (1.0f / 32767.0f);
                    store_piece(r, c, k, y0, y1, 32767.0f / M);
                }
            }
            continue;
        }
#undef LN_VEC
    }
}

__device__ __forceinline__ void phase_ffn_fix(PP p, int l, bool ctx_out) {
    const int tid = mk_tid(), G = gridDim.x, b = mk_bid();
    bf16_t* HID = wsp<bf16_t>(p, WS_HID); const float* edge = wsp<const float>(p, WS_EDGE); const bf16_t* part = wsp<const bf16_t>(p, WS_PART);
    const float* cw = p->in[I_FFNCW] + (size_t)l * 3 * D; const float* cb = p->in[I_FFNCB] + (size_t)l * D;
    for (int idx = b * NT + tid; idx < 64 * 2 * 512; idx += G * NT) {
        const int c = (idx & 511) * 8, e = (idx >> 9) & 1, pm = idx >> 10;
        const float* E = edge + (size_t)pm * 6 * D + c;
        float h[8];
#pragma unroll
        for (int j = 0; j < 8; ++j) {
            float a, ap, an, uu;
            if (e == 0) { a = E[j]; an = E[D + j]; ap = pm > 0 ? edge[((size_t)(pm - 1) * 6 + 3) * D + c + j] : 0.f; uu = E[4 * D + j]; }
            else { a = E[3 * D + j]; ap = E[2 * D + j]; an = pm < 63 ? edge[((size_t)(pm + 1) * 6 + 0) * D + c + j] : 0.f; uu = E[5 * D + j]; }
            h[j] = siluf_(cb[c + j] + cw[c + j] * ap + cw[D + c + j] * a + cw[2 * D + c + j] * an) * uu;
        }
        u32x4 w; w.x = cvt_pk_bf16(h[0], h[1]); w.y = cvt_pk_bf16(h[2], h[3]); w.z = cvt_pk_bf16(h[4], h[5]); w.w = cvt_pk_bf16(h[6], h[7]);
        *(u32x4*)(HID + (size_t)(pm * 256 + (e ? 255 : 0)) * D + c) = w;
    }
    if (ctx_out) {
        constexpr int SK = 8;
        for (int idx = b * NT + tid; idx < TC * 512; idx += G * NT) {
            const int c = (idx & 511) * 8, t = idx >> 9, ic = 256 * (c >> 7) + (c & 127);
            auto sum8 = [&](int tt, int col, float (&o)[8]) {
                f32x4 x = {0.f, 0.f, 0.f, 0.f}, y = x;
#pragma unroll
                for (int s = 0; s < SK; ++s) { float o8[8]; ld8bf(part + ((size_t)(s * 256 + tt)) * 8192 + col, o8); x += (f32x4){o8[0], o8[1], o8[2], o8[3]}; y += (f32x4){o8[4], o8[5], o8[6], o8[7]}; }
                o[0] = x[0]; o[1] = x[1]; o[2] = x[2]; o[3] = x[3]; o[4] = y[0]; o[5] = y[1]; o[6] = y[2]; o[7] = y[3];
            };
            float prev[8], cur[8], nxt[8], u[8], h[8];
#pragma unroll
            for (int j = 0; j < 8; ++j) { prev[j] = 0.f; nxt[j] = 0.f; }
            if (t > 0) sum8(t - 1, ic, prev);
            sum8(t, ic, cur);
            if (t + 1 < TC) sum8(t + 1, ic, nxt);
            sum8(t, ic + 128, u);
#pragma unroll
            for (int j = 0; j < 8; ++j) h[j] = siluf_(cb[c + j] + cw[c + j] * prev[j] + cw[D + c + j] * cur[j] + cw[2 * D + c + j] * nxt[j]) * u[j];
            u32x4 w; w.x = cvt_pk_bf16(h[0], h[1]); w.y = cvt_pk_bf16(h[2], h[3]); w.z = cvt_pk_bf16(h[4], h[5]); w.w = cvt_pk_bf16(h[6], h[7]);
            *(u32x4*)(HID + (size_t)(TL + t) * D + c) = w;
        }
    }
}
template <int CC> __device__ __forceinline__ size_t frag_off(int row, int col) { return ((size_t)((row >> 4) * (CC / 32) + (col >> 5)) * 64 + ((col & 31) >> 3) * 16 + (row & 15)) * 8 + (col & 7); }
__device__ __forceinline__ int hg_chunk_row(int c) { return c < 256 ? c * 64 : TL + (c - 256) * 64; }
__device__ __forceinline__ int hg_kperm(int k) { const int kl = k & 31, hi = kl >> 4, r = kl & 15; return (k & ~31) + (r >> 2) * 8 + hi * 4 + (r & 3); }
template <int V> struct IC { static constexpr int value = V; };
__device__ __forceinline__ float clamp80(float x) { return fminf(fmaxf(x, -80.f), 80.f); }
__device__ __forceinline__ void phase_hg_prep(PP p, LAS unsigned char* lds) {
    const int tid = mk_tid(), lane = tid & 63, wid = tid >> 6, G = gridDim.x, r16 = lane & 15, q4 = lane >> 4;
    const bf16_t* QB = wsp<const bf16_t>(p, HG_QB); const bf16_t* KB = wsp<const bf16_t>(p, HG_KB); const float* LF = wsp<const float>(p, HG_LF); const bf16_t* V = wsp<const bf16_t>(p, HG_V);
    bf16_t* HA = wsp<bf16_t>(p, HG_A); bf16_t* HQT = wsp<bf16_t>(p, HG_QT); bf16_t* HKT = wsp<bf16_t>(p, HG_KT); float* HD = wsp<float>(p, HG_D); bf16_t* HVT = wsp<bf16_t>(p, HG_VT);
    constexpr int RS = 272;
    constexpr int HP_TOT = 288 * RS, HP_QT = HP_TOT + 2048, HP_A = HP_QT + 16384;
    LAS float* TOT = (LAS float*)(lds + HP_TOT);
    const int k = tid & 127, I = __builtin_amdgcn_readfirstlane(tid >> 7);
    struct HpIn { u32x4 lf[4], q[2], kk[2]; };
    auto load_in = [&](int item, HpIn& v) {
        const int c = item % NCH, h = (item / NCH) & 15, d = item / (NCH * 16), rb = hg_chunk_row(c);
#pragma unroll
        for (int u = 0; u < 4; ++u) { const int pi = tid + 512 * u, row = pi >> 5, cp = pi & 31; v.lf[u] = *(const u32x4*)(LF + ((size_t)d * T + rb + row) * 2048 + h * 128 + cp * 4); }
#pragma unroll
        for (int u = 0; u < 2; ++u) { const int pi = tid + 512 * u, row = pi >> 4, cp = pi & 15;
            v.q[u] = *(const u32x4*)(QB + (size_t)(rb + row) * 2048 + h * 128 + cp * 8); v.kk[u] = *(const u32x4*)(KB + ((size_t)d * T + rb + row) * 2048 + h * 128 + cp * 8); }
    };
    auto process = [&](int item, const HpIn& in, auto dtag) {
        constexpr int d = decltype(dtag)::value;
        const int c = item % NCH, h = (item / NCH) & 15, rb = hg_chunk_row(c);
        (void)rb; (void)h;
        lds_barrier();
#pragma unroll
        for (int u = 0; u < 4; ++u) *(LAS u32x4*)(lds + (tid + 512 * u) * 16) = in.lf[u];
#pragma unroll
        for (int u = 0; u < 2; ++u) { *(LAS u32x4*)(lds + 32768 + (tid + 512 * u) * 16) = in.q[u]; *(LAS u32x4*)(lds + 49152 + (tid + 512 * u) * 16) = in.kk[u]; }
        lds_barrier();
        float b[16], qv[16], kv[16];
        const int tb = d ? 63 - 16 * I : 16 * I;
#pragma unroll
        for (int j = 0; j < 16; ++j) {
            const int to = d ? -j : j;
            b[j] = ((LAS const float*)lds + tb * 128 + k)[to * 128]; qv[j] = bf1(((LAS const bf16_t*)(lds + 32768) + tb * 128 + k)[to * 128]); kv[j] = bf1(((LAS const bf16_t*)(lds + 49152) + tb * 128 + k)[to * 128]);
        }
        lds_barrier();
#pragma unroll
        for (int j = 1; j < 16; ++j) b[j] += b[j - 1];
        TOT[I * 128 + k] = b[15];
        lds_barrier();
        const float t0 = TOT[k], t1 = TOT[128 + k], t2 = TOT[256 + k], t3 = TOT[384 + k];
        const float rI = (I > 0 ? t0 : 0.f) + (I > 1 ? t1 : 0.f) + (I > 2 ? t2 : 0.f), gtot = (t0 + t1) + (t2 + t3);
        if (I == 0) HD[(size_t)item * 128 + k] = __expf(gtot);
        const float off1 = (I == 0 ? t0 : I == 1 ? t1 : I == 2 ? t2 : t3), off2 = off1 + (I == 0 ? t1 : t2), off3 = off2 + t2;
        const float bmid = b[7];
        const int kp = hg_kperm(k);
        const float cq = __expf(rI), ck = __expf(gtot - rI - off1), c2 = __expf(off2 - off1), c3 = __expf(off3 - off1);
        unsigned short kt16[16];
        LAS bf16_t* pQD = (LAS bf16_t*)(lds + (size_t)(16 * I) * RS) + k;
        LAS bf16_t* pKD = (LAS bf16_t*)(lds + (size_t)(64 + 16 * I) * RS) + k;
        LAS bf16_t* pQO = (LAS bf16_t*)(lds + (size_t)(I >= 1 ? 128 + 16 * (I - 1) : 272) * RS) + k;
        LAS bf16_t* pK1 = (LAS bf16_t*)(lds + (size_t)(I == 0 ? 176 : I == 1 ? 208 : I == 2 ? 256 : 272) * RS) + k;
        LAS bf16_t* pK2 = (LAS bf16_t*)(lds + (size_t)(I == 0 ? 192 : I == 1 ? 240 : 272) * RS) + k;
        LAS bf16_t* pK3 = (LAS bf16_t*)(lds + (size_t)(I == 0 ? 224 : 272) * RS) + k;
        LAS bf16_t* pQT = (LAS bf16_t*)(lds + HP_QT) + frag_off<128>(tb, kp);
#pragma unroll
        for (int j = 0; j < 16; ++j) {
            const float eb = __expf(b[j]), e1 = __expf(off1 - b[j]);
            pQT[d ? -8 * j : 8 * j] = f2bf_n(qv[j] * (cq * eb));
            kt16[j] = f2bf_n(kv[j] * (ck * e1));
            pQD[j * (RS / 2)] = f2bf_n(qv[j] * __expf(clamp80(b[j] - bmid)));
            pKD[j * (RS / 2)] = f2bf_n(kv[j] * __expf(clamp80(bmid - b[j])));
            pQO[j * (RS / 2)] = f2bf_n(qv[j] * eb);
            pK1[j * (RS / 2)] = f2bf_n(kv[j] * e1);
            pK2[j * (RS / 2)] = f2bf_n(kv[j] * (c2 * e1));
            pK3[j * (RS / 2)] = f2bf_n(kv[j] * (c3 * e1));
        }
        {
            u32x4 w0, w1;
#define KT_(i) ((unsigned)(d ? kt16[15 - (i)] : kt16[(i)]))
            w0.x = KT_(0) | (KT_(1) << 16); w0.y = KT_(2) | (KT_(3) << 16); w0.z = KT_(4) | (KT_(5) << 16); w0.w = KT_(6) | (KT_(7) << 16);
            w1.x = KT_(8) | (KT_(9) << 16); w1.y = KT_(10) | (KT_(11) << 16); w1.z = KT_(12) | (KT_(13) << 16); w1.w = KT_(14) | (KT_(15) << 16);
#undef KT_
            const int s0 = d ? 48 - 16 * I : 16 * I;
            *(u32x4*)(HKT + (size_t)item * 8192 + frag_off<64>(k, s0)) = w0; *(u32x4*)(HKT + (size_t)item * 8192 + frag_off<64>(k, s0 + 8)) = w1;
        }
        lds_barrier();
        { const u32x4 x0 = *(LAS const u32x4*)(lds + HP_QT + tid * 16), x1 = *(LAS const u32x4*)(lds + HP_QT + 8192 + tid * 16);
          *(u32x4*)(HQT + (size_t)item * 8192 + tid * 8) = x0; *(u32x4*)(HQT + (size_t)item * 8192 + 4096 + tid * 8) = x1; }
#pragma unroll 1
        for (int tile = wid; tile < 16; tile += 8) {
            const int Iq = tile >> 2, J = tile & 3;
            f32x4 acc = {0.f, 0.f, 0.f, 0.f};
            if (J <= Iq) {
                const int arow = (J == Iq) ? 16 * Iq : 128 + 16 * (Iq - 1);
                const int brow = (J == Iq) ? 64 + 16 * Iq : (Iq == 1 ? 176 : Iq == 2 ? 192 : 224) + 16 * J;
#pragma unroll
                for (int kk = 0; kk < 4; ++kk) {
                    const bf16x8 av = *(const LAS bf16x8*)(lds + (size_t)(arow + r16) * RS + kk * 64 + q4 * 16);
                    const bf16x8 bv = *(const LAS bf16x8*)(lds + (size_t)(brow + r16) * RS + kk * 64 + q4 * 16);
                    acc = __builtin_amdgcn_mfma_f32_16x16x32_bf16(av, bv, acc, 0, 0, 0);
                }
                if (J == Iq) {
#pragma unroll
                    for (int i = 0; i < 4; ++i) acc[i] = (r16 <= 4 * q4 + i) ? acc[i] : 0.f;
                }
            }
#pragma unroll
            for (int i = 0; i < 4; ++i) {
                const int tau = 16 * Iq + 4 * q4 + i, sig = 16 * J + r16, t = d ? 63 - tau : tau, s = d ? 63 - sig : sig;
                ((LAS bf16_t*)(lds + HP_A))[frag_off<64>(t, s)] = f2bf_n(acc[i]);
            }
        }
        lds_barrier();
        *(u32x4*)(HA + (size_t)item * 4096 + tid * 8) = *(LAS const u32x4*)(lds + HP_A + tid * 16);
    };
    const int NI = 32 * NCH, i0 = mk_bid();
    HpIn va, vb;
    auto run = [&](int item, const HpIn& in) { if (item < NCH * 16) process(item, in, IC<0>{}); else process(item, in, IC<1>{}); };
    if (i0 < NI) load_in(i0, va);
#pragma unroll 1
    for (int item = i0; item < NI; item += 2 * G) {
        if (item + G < NI) load_in(item + G, vb);
        run(item, va);
        if (item + 2 * G < NI) load_in(item + 2 * G, va);
        if (item + G < NI) run(item + G, vb);
    }
}
__device__ __forceinline__ int scan_chunk(int j, int d) { return d == 0 ? (j < 4 ? 256 + j : j - 4) : 259 - j; }
constexpr int HS_NF = 45, HS_BUF = HS_NF * 1024, HS_SX = 3 * HS_BUF, HS_OT = HS_SX + 16384;
static_assert(HS_OT + 8192 <= LDS_XB, "HGRN2 scan LDS image");
__device__ __forceinline__ void phase_hg_scan(PP p, LAS unsigned char* lds, bool ctx_out) {
    const int tid = mk_tid(), lane = tid & 63, wid = __builtin_amdgcn_readfirstlane(tid >> 6), G = gridDim.x, r16 = lane & 15, q4 = lane >> 4;
    const int vt = wid & 1, qt = wid >> 1;
    const bf16_t* HA = wsp<const bf16_t>(p, HG_A); const bf16_t* HQT = wsp<const bf16_t>(p, HG_QT); const bf16_t* HKT = wsp<const bf16_t>(p, HG_KT); const float* HD = wsp<const float>(p, HG_D);
    const bf16_t* HV = wsp<const bf16_t>(p, HG_V); bf16_t* HO = wsp<bf16_t>(p, HG_O);
    LAS bf16x8* Sx = (LAS bf16x8*)(lds + HS_SX);
    for (int it = mk_bid(); it < 256; it += G) {
        const int hd = (it & 7) * 4 + (it >> 6), vs = (it >> 3) & 7, d = hd >> 4, h = hd & 15;
        const bool zfa = d ? (wid == 4 || wid == 6) : (wid == 1 || wid == 3);
        const int nd = 6 - (zfa ? 1 : 0) - (wid > 4 ? 1 : 0);
#define HS_WAIT_ND() do { if (nd == 6) asm volatile("s_waitcnt vmcnt(6)" ::: "memory"); else if (nd == 5) asm volatile("s_waitcnt vmcnt(5)" ::: "memory"); else asm volatile("s_waitcnt vmcnt(4)" ::: "memory"); } while (0)
        auto dma_set = [&](int j, int b) {
            const int c = scan_chunk(j < NCH ? j : NCH - 1, d);
            const size_t itemc = (size_t)hd * NCH + c;
            LAS unsigned char* im = lds + b * HS_BUF;
#define HS_DMA(src, fi) __builtin_amdgcn_global_load_lds((const unsigned*)(src), (LAS unsigned*)(im + (fi) * 1024), 16, 0, 0)
            if (!zfa) HS_DMA(HA + itemc * 4096 + (size_t)wid * 512 + lane * 8, wid);
            HS_DMA(HQT + itemc * 8192 + (size_t)wid * 512 + lane * 8, wid + 8);
            HS_DMA(HQT + itemc * 8192 + (size_t)(wid + 8) * 512 + lane * 8, wid + 16);
            HS_DMA(HKT + itemc * 8192 + (size_t)wid * 512 + lane * 8, wid + 24);
            HS_DMA(HKT + itemc * 8192 + (size_t)(wid + 8) * 512 + lane * 8, wid + 32);
            const bf16_t* vtp = HV + (size_t)(hg_chunk_row(c) + (wid & 3) * 16 + (lane >> 2)) * D + h * 256 + vs * 32 + (lane & 3) * 8;
            const bf16_t* dp = (const bf16_t*)(HD + itemc * 128) + (lane < 32 ? lane : 31) * 8;
            if (wid <= 4) HS_DMA(wid < 4 ? vtp : dp, wid < 4 ? 40 + wid : 44);
#undef HS_DMA
        };
        f32x4 S0 = {0.f, 0.f, 0.f, 0.f}, S1 = {0.f, 0.f, 0.f, 0.f};
        __syncthreads();
        if (zfa) {
#pragma unroll
            for (int b3 = 0; b3 < 3; ++b3) { unsigned zz = 0u; asm volatile("" : "+v"(zz)); *(LAS u32x4*)(lds + b3 * HS_BUF + wid * 1024 + lane * 16) = (u32x4){zz, zz, zz, zz}; }
        }
        dma_set(0, 0); dma_set(1, 1);
        { unsigned zz = 0u; asm volatile("" : "+v"(zz)); ((LAS u32x4*)(lds + HS_SX))[(vt * 4 + qt) * 64 + lane] = (u32x4){zz, zz, zz, zz}; }
        HS_WAIT_ND();
        lds_barrier();
        int buf = 0, ib = 0;
        auto flush_o = [&](int j) {
            const int c = scan_chunk(j, d);
            if (ctx_out || c < 256) {
                const int row = 16 * wid + (lane >> 2), piece = lane & 3;
                const u32x4 v = *(LAS const u32x4*)(lds + HS_OT + (j & 1) * 4096 + row * 64 + piece * 16);
                *(u32x4*)(HO + ((size_t)d * T + hg_chunk_row(c) + row) * D + h * 256 + vs * 32 + piece * 8) = v;
            }
        };
#pragma unroll 1
        for (int j = 0; j < NCH; ++j) {
            if (j > 0 && wid < 4) flush_o(j - 1);
            { const int ib2 = ib >= 1 ? ib - 1 : 2; dma_set(j + 2, ib2); }
            LAS const unsigned char* im = lds + ib * HS_BUF;
#define HS_FR(fi) (*(LAS const bf16x8*)(im + (fi) * 1024 + lane * 16))
            const unsigned vtb = (unsigned)(size_t)(im + 40 * 1024) + (unsigned)(((lane >> 4) * 8 + ((lane & 15) >> 2)) * 64 + (vt * 16 + 4 * (lane & 3)) * 2);
            s16x4 t00, t01, t10, t11;
            asm volatile("ds_read_b64_tr_b16 %0, %1" : "=&v"(t00) : "v"(vtb) : "memory");
            asm volatile("ds_read_b64_tr_b16 %0, %1 offset:256" : "=&v"(t01) : "v"(vtb) : "memory");
            asm volatile("ds_read_b64_tr_b16 %0, %1 offset:2048" : "=&v"(t10) : "v"(vtb) : "memory");
            asm volatile("ds_read_b64_tr_b16 %0, %1 offset:2304" : "=&v"(t11) : "v"(vtb) : "memory");
            const bf16x8 a0 = HS_FR(qt * 2), a1 = HS_FR(qt * 2 + 1);
            bf16x8 sb[4], qf[4];
#pragma unroll
            for (int kk = 0; kk < 4; ++kk) { sb[kk] = Sx[((buf * 2 + vt) * 4 + kk) * 64 + lane]; qf[kk] = HS_FR(8 + qt * 4 + kk); }
            const bf16x8 k00 = HS_FR(24 + (2 * qt) * 2), k01 = HS_FR(24 + (2 * qt) * 2 + 1), k10 = HS_FR(24 + (2 * qt + 1) * 2), k11 = HS_FR(24 + (2 * qt + 1) * 2 + 1);
            const f32x4 dv0 = *(LAS const f32x4*)(im + 44 * 1024 + ((2 * qt) * 16 + 4 * q4) * 4), dv1 = *(LAS const f32x4*)(im + 44 * 1024 + ((2 * qt + 1) * 16 + 4 * q4) * 4);
#undef HS_FR
            asm volatile("s_waitcnt lgkmcnt(0)" ::: "memory");
            __builtin_amdgcn_sched_barrier(0);
            const bf16x8 bv0 = {t00[0], t00[1], t00[2], t00[3], t01[0], t01[1], t01[2], t01[3]}, bv1 = {t10[0], t10[1], t10[2], t10[3], t11[0], t11[1], t11[2], t11[3]};
            f32x4 accq = {0.f, 0.f, 0.f, 0.f}, acca = {0.f, 0.f, 0.f, 0.f};
#pragma unroll
            for (int kk = 0; kk < 4; ++kk) accq = __builtin_amdgcn_mfma_f32_16x16x32_bf16(qf[kk], sb[kk], accq, 0, 0, 0);
            acca = __builtin_amdgcn_mfma_f32_16x16x32_bf16(a0, bv0, acca, 0, 0, 0); acca = __builtin_amdgcn_mfma_f32_16x16x32_bf16(a1, bv1, acca, 0, 0, 0);
            S0 = dv0 * S0; S1 = dv1 * S1;
            S0 = __builtin_amdgcn_mfma_f32_16x16x32_bf16(k00, bv0, S0, 0, 0, 0); S0 = __builtin_amdgcn_mfma_f32_16x16x32_bf16(k01, bv1, S0, 0, 0, 0);
            S1 = __builtin_amdgcn_mfma_f32_16x16x32_bf16(k10, bv0, S1, 0, 0, 0); S1 = __builtin_amdgcn_mfma_f32_16x16x32_bf16(k11, bv1, S1, 0, 0, 0);
            u32x4 sw; sw.x = cvt_pk_bf16_n(S0[0], S0[1]); sw.y = cvt_pk_bf16_n(S0[2], S0[3]); sw.z = cvt_pk_bf16_n(S1[0], S1[1]); sw.w = cvt_pk_bf16_n(S1[2], S1[3]);
            ((LAS u32x4*)(lds + HS_SX))[(((buf ^ 1) * 2 + vt) * 4 + qt) * 64 + lane] = sw;
            const f32x4 acc = accq + acca;
#pragma unroll
            for (int i = 0; i < 4; ++i) ((LAS bf16_t*)(lds + HS_OT + (j & 1) * 4096))[(qt * 16 + 4 * q4 + i) * 32 + vt * 16 + r16] = f2bf_n(acc[i]);
            HS_WAIT_ND();
            lds_barrier();
            buf ^= 1; ib = ib == 2 ? 0 : ib + 1;
        }
        if (wid < 4) flush_o(NCH - 1);
        asm volatile("s_waitcnt vmcnt(0)" ::: "memory");
        __syncthreads();
    }
}
struct HrRaw { u32x4 a[4], b[4], g[4]; };
__device__ __forceinline__ void unpack8u(u32x4 w, float (&o)[8]) { o[0] = bf_lo(w.x); o[1] = bf_hi(w.x); o[2] = bf_lo(w.y); o[3] = bf_hi(w.y); o[4] = bf_lo(w.z); o[5] = bf_hi(w.z); o[6] = bf_lo(w.w); o[7] = bf_hi(w.w); }
__device__ __forceinline__ void phase_hg_readout(PP p, LAS unsigned char* lds, int j, bool ctx_out) {
    const int tid = mk_tid(), lane = tid & 63, wid = __builtin_amdgcn_readfirstlane(tid >> 6), G = gridDim.x, bid = mk_bid();
    const bf16_t* O0 = wsp<const bf16_t>(p, HG_O); const bf16_t* O1 = O0 + (size_t)T * D; const bf16_t* SG = wsp<const bf16_t>(p, HG_SG);
    bf16_t* Y = wsp<bf16_t>(p, WS_YB); const float* ng = p->in[I_HGNORM] + (size_t)j * D;
    {
        const unsigned c = (unsigned)(wid & 7) * 512u + (unsigned)lane * 8u; const int NB = TL / 4;
        const f32x4 n0 = *(const f32x4*)(ng + c), n1 = *(const f32x4*)(ng + c + 4u);
        LAS float* red = (LAS float*)lds;
        auto load = [&](int bt, HrRaw& w) {
            const int r0 = (bt < NB ? bt : NB - 1) * 4;
#pragma unroll
            for (int q = 0; q < 4; ++q) { const size_t ro = (size_t)(r0 + q) * D; w.a[q] = *(const u32x4*)(O0 + ro + c); w.b[q] = *(const u32x4*)(O1 + ro + c); w.g[q] = *(const u32x4*)(SG + ro + c); }
        };
        auto process = [&](int bt, const HrRaw& w, bool valid, int buf) {
            int r0 = (bt < NB ? bt : NB - 1) * 4;
            asm volatile("" : "+s"(r0));
            float v[4][8], s[4];
#pragma unroll
            for (int q = 0; q < 4; ++q) {
                float a[8], b[8]; unpack8u(w.a[q], a); unpack8u(w.b[q], b);
                float ss = 0.f;
#pragma unroll
                for (int e = 0; e < 8; ++e) { v[q][e] = a[e] + b[e]; ss += v[q][e] * v[q][e]; }
                s[q] = ss;
            }
            float t2[2], wv;
            { const bool hi = lane & 32;
#pragma unroll
              for (int k = 0; k < 2; ++k) { const float send = hi ? s[k] : s[2 + k], keep = hi ? s[2 + k] : s[k]; t2[k] = keep + xch32(send, lane); } }
            { const bool hi = lane & 16; const float send = hi ? t2[0] : t2[1], keep = hi ? t2[1] : t2[0]; wv = keep + xch16(send, lane); }
            wv = row16_all(wv, OpSum());
            if ((lane & 15) == 0) red[(buf * 8 + wid) * 4 + (lane >> 4)] = wv;
            lds_barrier();
            f32x4 tot = *(const LAS f32x4*)(red + buf * 32);
#pragma unroll
            for (int w8 = 1; w8 < 8; ++w8) tot += *(const LAS f32x4*)(red + (buf * 8 + w8) * 4);
            if (valid) {
#pragma unroll
                for (int q = 0; q < 4; ++q) {
                    const float rs = rsqrtf(tot[q] * (1.0f / D) + RMS_EPS);
                    float g[8]; unpack8u(w.g[q], g);
                    f32x4 o0, o1;
#pragma unroll
                    for (int e = 0; e < 4; ++e) { o0[e] = v[q][e] * rs * n0[e] * g[e]; o1[e] = v[q][4 + e] * rs * n1[e] * g[4 + e]; }
                    st_bf16x8(Y + (size_t)(r0 + q) * D + c, o0, o1);
                }
            }
        };
        const int nmine = bid < NB ? (NB - bid + G - 1) / G : 0;
        HrRaw ra, rb;
        __syncthreads();
        load(bid, ra);
#pragma unroll 1
        for (int i = 0; i < nmine; i += 2) {
            load(bid + (i + 1) * G, rb); process(bid + i * G, ra, true, 0);
            load(bid + (i + 2) * G, ra); process(bid + (i + 1) * G, rb, i + 1 < nmine, 1);
        }
    }
    if (ctx_out) {
        LAS float* red = (LAS float*)lds;
        for (int rr = mk_bid(); rr < TC; rr += G) {
            const int r = TL + rr, c = wid * 512 + lane * 8;
            float a[8], b[8], v[8], g[8], o[8]; float ss = 0.f;
            ld8bf(O0 + (size_t)r * D + c, a); ld8bf(O1 + (size_t)r * D + c, b); ld8bf(SG + (size_t)r * D + c, g);
#pragma unroll
            for (int e = 0; e < 8; ++e) { v[e] = a[e] + b[e]; ss += v[e] * v[e]; }
            const float ws_ = wave_sum(ss);
            __syncthreads();
            if (lane == 0) red[wid] = ws_;
            __syncthreads();
            float tot = 0.f;
#pragma unroll
            for (int w = 0; w < 8; ++w) tot += red[w];
            const float rs = rsqrtf(tot * (1.0f / D) + RMS_EPS);
            const f32x4 n0 = *(const f32x4*)(ng + c), n1 = *(const f32x4*)(ng + c + 4);
#pragma unroll
            for (int e = 0; e < 8; ++e) o[e] = v[e] * rs * (e < 4 ? n0[e] : n1[e - 4]) * g[e];
            u32x4 w; w.x = cvt_pk_bf16(o[0], o[1]); w.y = cvt_pk_bf16(o[2], o[3]); w.z = cvt_pk_bf16(o[4], o[5]); w.w = cvt_pk_bf16(o[6], o[7]);
            *(u32x4*)(Y + (size_t)r * D + c) = w;
        }
    }
}

__device__ __forceinline__ void phase_mb_prep(PP p, LAS unsigned char* lds) {
    const int tid = mk_tid(), lane = tid & 63, wid = tid >> 6, G = gridDim.x, r16 = lane & 15, q4 = lane >> 4, bid = mk_bid();
    const bf16_t* XBC = wsp<const bf16_t>(p, MB_XBC); bf16_t* XSo = wsp<bf16_t>(p, MB_XS); const float* DTR = wsp<const float>(p, MB_DT);
    const float* cw = p->in[I_SSMCW]; const float* cb = p->in[I_SSMCB];
    bf16_t* MG = wsp<bf16_t>(p, MB_G); bf16_t* MCP = wsp<bf16_t>(p, MB_CP); bf16_t* MBT = wsp<bf16_t>(p, MB_BT); bf16_t* MXT = wsp<bf16_t>(p, MB_XT); float* MGV = wsp<float>(p, MB_GV); float* MDTC = wsp<float>(p, MB_DTC);
    constexpr int RS = 272;
    for (int item = bid; item < 8 * NCH; item += G) {
        const int c = item % NCH, g = item / NCH, rb = hg_chunk_row(c);
        const int row = tid >> 3, seg = tid & 7;
        {
            const int sg = tid & 15, r32 = tid >> 4, s0 = rb < TL ? 0 : TL, s1 = rb < TL ? TL : T;
            __syncthreads();
#pragma unroll
            for (int op = 0; op < 2; ++op) {
                const int ch = (op == 0 ? 9216 : 8192) + g * 128 + sg * 8;
                const f32x4 wa0 = *(const f32x4*)(cw + ch), wa1 = *(const f32x4*)(cw + ch + 4), wb0 = *(const f32x4*)(cw + 10240 + ch), wb1 = *(const f32x4*)(cw + 10240 + ch + 4);
                const f32x4 wc0 = *(const f32x4*)(cw + 20480 + ch), wc1 = *(const f32x4*)(cw + 20480 + ch + 4), bb0 = *(const f32x4*)(cb + ch), bb1 = *(const f32x4*)(cb + ch + 4);
#pragma unroll
                for (int hr = 0; hr < 2; ++hr) {
                    const int rw = r32 + 32 * hr, t = rb + rw;
                    const float mm = t - 1 >= s0 ? 1.f : 0.f, mp = t + 1 < s1 ? 1.f : 0.f;
                    const u32x4 um = *(const u32x4*)(XBC + (size_t)(t - 1 >= s0 ? t - 1 : t) * 10240 + ch), u0 = *(const u32x4*)(XBC + (size_t)t * 10240 + ch), up = *(const u32x4*)(XBC + (size_t)(t + 1 < s1 ? t + 1 : t) * 10240 + ch);
                    float xm[8], x0[8], xp[8]; unpack8u(um, xm); unpack8u(u0, x0); unpack8u(up, xp);
                    f32x4 h0, h1;
#pragma unroll
                    for (int e = 0; e < 4; ++e) {
                        h0[e] = siluf_(bb0[e] + wa0[e] * (xm[e] * mm) + wb0[e] * x0[e] + wc0[e] * (xp[e] * mp)); h1[e] = siluf_(bb1[e] + wa1[e] * (xm[4 + e] * mm) + wb1[e] * x0[4 + e] + wc1[e] * (xp[4 + e] * mp));
                    }
                    u32x4 hw; hw.x = cvt_pk_bf16(h0[0], h0[1]); hw.y = cvt_pk_bf16(h0[2], h0[3]); hw.z = cvt_pk_bf16(h1[0], h1[1]); hw.w = cvt_pk_bf16(h1[2], h1[3]);
                    *(LAS u32x4*)(lds + (size_t)(op * 64 + rw) * RS + sg * 16) = hw;
                }
            }
            __syncthreads();
        }
        const u32x4 c0 = *(const LAS u32x4*)(lds + (size_t)row * RS + seg * 32), c1 = *(const LAS u32x4*)(lds + (size_t)row * RS + seg * 32 + 16);
        {
            const int blk = seg >> 1, hi = seg & 1;
            bf16_t* cp = MCP + (size_t)item * 8192; const int p0 = blk * 32 + hi * 4;
            *(u32x2*)(cp + frag_off<128>(row, p0)) = (u32x2){c0.x, c0.y}; *(u32x2*)(cp + frag_off<128>(row, p0 + 8)) = (u32x2){c0.z, c0.w};
            *(u32x2*)(cp + frag_off<128>(row, p0 + 16)) = (u32x2){c1.x, c1.y}; *(u32x2*)(cp + frag_off<128>(row, p0 + 24)) = (u32x2){c1.z, c1.w};
        }
        __syncthreads();
#pragma unroll 1
        for (int tile = wid; tile < 16; tile += 8) {
            const int tt = tile >> 2, st = tile & 3;
            f32x4 acc = {0.f, 0.f, 0.f, 0.f};
#pragma unroll
            for (int kk = 0; kk < 4; ++kk) {
                const bf16x8 av = *(const LAS bf16x8*)(lds + (size_t)(tt * 16 + r16) * RS + kk * 64 + q4 * 16);
                const bf16x8 bv = *(const LAS bf16x8*)(lds + (size_t)(64 + st * 16 + r16) * RS + kk * 64 + q4 * 16);
                acc = __builtin_amdgcn_mfma_f32_16x16x32_bf16(av, bv, acc, 0, 0, 0);
            }
#pragma unroll
            for (int i = 0; i < 4; ++i) MG[(size_t)item * 4096 + frag_off<64>(tt * 16 + 4 * q4 + i, st * 16 + r16)] = f2bf_n(acc[i]);
        }
        {
            const int n = tid & 127, part = tid >> 7;
            unsigned w[8];
#pragma unroll
            for (int j = 0; j < 8; ++j) {
                const unsigned lo = *(const LAS bf16_t*)(lds + (size_t)(64 + part * 16 + 2 * j) * RS + n * 2), hi = *(const LAS bf16_t*)(lds + (size_t)(64 + part * 16 + 2 * j + 1) * RS + n * 2);
                w[j] = lo | (hi << 16);
            }
            bf16_t* bp = MBT + (size_t)item * 8192;
            *(u32x4*)(bp + frag_off<64>(n, part * 16)) = (u32x4){w[0], w[1], w[2], w[3]}; *(u32x4*)(bp + frag_off<64>(n, part * 16 + 8)) = (u32x4){w[4], w[5], w[6], w[7]};
        }
    }
    {
        __syncthreads();
        constexpr int RSX = 144, NI = 128 * NCH;
        const int wv = __builtin_amdgcn_readfirstlane(wid), sgx = lane & 7;
        LAS unsigned char* wl = lds + wv * (66 * RSX);
        struct XRaw { u32x4 r[8]; u32x4 h; };
        int hdw = -1; f32x4 wa0, wa1, wb0, wb1, wc0, wc1, bb0, bb1;
        auto loadx = [&](int i, XRaw& w) {
            const int ii = i < NI ? i : NI - 1, c = ii >> 7, hd = ii & 127, rb = hg_chunk_row(c), s0 = rb < TL ? 0 : TL, s1 = rb < TL ? TL : T;
            const bf16_t* src = XBC + hd * 64 + sgx * 8;
#pragma unroll
            for (int k = 0; k < 8; ++k) w.r[k] = *(const u32x4*)(src + (size_t)(rb + k * 8 + (lane >> 3)) * 10240);
            const int hr = (lane & 8) ? (rb + 64 < s1 ? rb + 64 : s1 - 1) : (rb - 1 >= s0 ? rb - 1 : s0);
            w.h = *(const u32x4*)(src + (size_t)hr * 10240);
        };
        auto procx = [&](int i, const XRaw& w) {
#pragma unroll
            for (int k = 0; k < 8; ++k) *(LAS u32x4*)(wl + (1 + k * 8 + (lane >> 3)) * RSX + sgx * 16) = w.r[k];
            if (lane < 16) *(LAS u32x4*)(wl + ((lane & 8) ? 65 : 0) * RSX + sgx * 16) = w.h;
            if (i < NI) {
                const int c = i >> 7, hd = i & 127, rb = hg_chunk_row(c), s0 = rb < TL ? 0 : TL, s1 = rb < TL ? TL : T, ch = hd * 64 + sgx * 8;
                if (hd != hdw) {
                    hdw = hd;
                    wa0 = *(const f32x4*)(cw + ch); wa1 = *(const f32x4*)(cw + ch + 4); wb0 = *(const f32x4*)(cw + 10240 + ch); wb1 = *(const f32x4*)(cw + 10240 + ch + 4);
                    wc0 = *(const f32x4*)(cw + 20480 + ch); wc1 = *(const f32x4*)(cw + 20480 + ch + 4); bb0 = *(const f32x4*)(cb + ch); bb1 = *(const f32x4*)(cb + ch + 4);
                }
                const float mf = rb - 1 >= s0 ? 1.f : 0.f, ml = rb + 64 < s1 ? 1.f : 0.f;
                u32x4 hv[8];
#pragma unroll
                for (int k = 0; k < 8; ++k) {
                    const int rw = k * 8 + (lane >> 3);
                    const u32x4 um = *(const LAS u32x4*)(wl + rw * RSX + sgx * 16), up = *(const LAS u32x4*)(wl + (rw + 2) * RSX + sgx * 16);
                    const float mm = rw > 0 ? 1.f : mf, mp = rw < 63 ? 1.f : ml;
                    float xm[8], x0[8], xp[8]; unpack8u(um, xm); unpack8u(w.r[k], x0); unpack8u(up, xp);
                    f32x4 h0, h1;
#pragma unroll
                    for (int e = 0; e < 4; ++e) {
                        h0[e] = siluf_(bb0[e] + wa0[e] * (xm[e] * mm) + wb0[e] * x0[e] + wc0[e] * (xp[e] * mp)); h1[e] = siluf_(bb1[e] + wa1[e] * (xm[4 + e] * mm) + wb1[e] * x0[4 + e] + wc1[e] * (xp[4 + e] * mp));
                    }
                    hv[k].x = cvt_pk_bf16(h0[0], h0[1]); hv[k].y = cvt_pk_bf16(h0[2], h0[3]); hv[k].z = cvt_pk_bf16(h1[0], h1[1]); hv[k].w = cvt_pk_bf16(h1[2], h1[3]);
                }
#pragma unroll
                for (int k = 0; k < 8; ++k) {
                    const int rw = k * 8 + (lane >> 3);
                    *(LAS u32x4*)(wl + (1 + rw) * RSX + sgx * 16) = hv[k];
                    *(u32x4*)(XSo + (size_t)(rb + rw) * 8192 + ch) = hv[k];
                }
                bf16_t* xp_ = MXT + (size_t)(hd * NCH + c) * 4096;
#pragma unroll
                for (int part = 0; part < 8; ++part) {
                    unsigned wq[4];
#pragma unroll
                    for (int j = 0; j < 4; ++j) {
                        const unsigned lo = *(const LAS bf16_t*)(wl + (1 + part * 8 + 2 * j) * RSX + lane * 2), hi = *(const LAS bf16_t*)(wl + (1 + part * 8 + 2 * j + 1) * RSX + lane * 2);
                        wq[j] = lo | (hi << 16);
                    }
                    *(u32x4*)(xp_ + frag_off<64>(lane, part * 8)) = (u32x4){wq[0], wq[1], wq[2], wq[3]};
                }
            }
        };
        const int i0 = bid * 8 + wv, st = G * 8;
        XRaw xa, xb;
        loadx(i0, xa);
#pragma unroll 1
        for (int i = i0; i < NI; i += 2 * st) { loadx(i + st, xb); procx(i, xa); loadx(i + 2 * st, xa); procx(i + st, xb); }
    }
    for (int item0 = (bid * 8 + wid) * 4; item0 < 256 * NCH; item0 += G * 8 * 4) {
        float dtv[4], gsum[4]; int tt[4];
#pragma unroll
        for (int u = 0; u < 4; ++u) {
            const int item = item0 + u, c = item % NCH, dh = item / NCH, d = dh >> 7, hd = dh & 127, rb = hg_chunk_row(c);
            tt[u] = d ? 63 - lane : lane;
            { const float x = DTR[(size_t)(rb + tt[u]) * 256 + d * 128 + hd] + p->in[I_SSMDTB][d * 128 + hd]; dtv[u] = x > 20.f ? x : __logf(1.0f + __expf(x)); }
            gsum[u] = dtv[u] * -__expf(p->in[I_SSMALOG][d * 128 + hd]);
        }
#pragma unroll
        for (int u = 0; u < 4; ++u) {
#pragma unroll
            for (int o = 1; o < 64; o <<= 1) { const float x = __int_as_float(__builtin_amdgcn_ds_bpermute((lane - o) << 2, __float_as_int(gsum[u]))); if (lane >= o) gsum[u] += x; }
            MGV[(size_t)(item0 + u) * 64 + tt[u]] = gsum[u]; MDTC[(size_t)(item0 + u) * 64 + tt[u]] = dtv[u];
        }
    }
}
__device__ __forceinline__ bf16x8 pack8(const float (&v)[8]) {
    u32x4 w; w.x = cvt_pk_bf16_n(v[0], v[1]); w.y = cvt_pk_bf16_n(v[2], v[3]); w.z = cvt_pk_bf16_n(v[4], v[5]); w.w = cvt_pk_bf16_n(v[6], v[7]);
    return __builtin_bit_cast(bf16x8, w);
}
__device__ __forceinline__ void unpack8(bf16x8 x, float (&o)[8]) {
    const u32x4 w = __builtin_bit_cast(u32x4, x);
    o[0] = bf_lo(w.x); o[1] = bf_hi(w.x); o[2] = bf_lo(w.y); o[3] = bf_hi(w.y); o[4] = bf_lo(w.z); o[5] = bf_hi(w.z); o[6] = bf_lo(w.w); o[7] = bf_hi(w.w);
}
struct MsOps { bf16x8 fr[4]; };
struct MsIn  { bf16x8 f[2]; };
constexpr int MS_YT = 34816, MS_DV = 51200;
__device__ __forceinline__ void phase_mb_scan(PP p, LAS unsigned char* lds, bool ctx_out) {
    const int tid = mk_tid(), lane = tid & 63, wid = __builtin_amdgcn_readfirstlane(tid >> 6), G = gridDim.x, r16 = lane & 15, q4 = lane >> 4;
    const int tq = wid & 3, ph = wid >> 2;
    const bf16_t* MG = wsp<const bf16_t>(p, MB_G); const bf16_t* MCP = wsp<const bf16_t>(p, MB_CP); const bf16_t* MBT = wsp<const bf16_t>(p, MB_BT); const bf16_t* MXT = wsp<const bf16_t>(p, MB_XT);
    const float* MGV = wsp<const float>(p, MB_GV); const float* MDTC = wsp<const float>(p, MB_DTC); bf16_t* MY = wsp<bf16_t>(p, MB_Y);
    LAS bf16x8* Sx = (LAS bf16x8*)lds;
    LAS float* VX = (LAS float*)(lds + 32768);
    for (int it = mk_bid(); it < 256; it += G) {
        const int g = it & 7, d = (it >> 3) & 1, hd = g * 16 + (it >> 4);
        auto load_ops = [&](int j, MsOps& o) {
            const int c = scan_chunk(j < NCH ? j : NCH - 1, d);
            const size_t gc = (size_t)g * NCH + c;
            const bf16_t* src = wid < 4 ? MCP + gc * 8192 + (size_t)(wid * 4) * 512 : MBT + gc * 8192 + (size_t)((wid - 4) * 4) * 512;
#pragma unroll
            for (int k = 0; k < 4; ++k) o.fr[k] = *(const bf16x8*)(src + (size_t)k * 512 + lane * 8);
        };
        auto load_in = [&](int j, MsIn& v) {
            const int c = scan_chunk(j < NCH ? j : NCH - 1, d);
            const size_t gc = (size_t)g * NCH + c, hc = (size_t)hd * NCH + c;
            const bf16_t* src = wid < 4 ? MXT + hc * 4096 + (size_t)(wid * 2) * 512 : MG + gc * 4096 + (size_t)((wid - 4) * 2) * 512;
#pragma unroll
            for (int ks = 0; ks < 2; ++ks) v.f[ks] = *(const bf16x8*)(src + (size_t)ks * 512 + lane * 8);
        };
        auto derive = [&](int b, const MsIn& v, int vb) {
            LAS unsigned char* im = lds + MS_DV + b * 24576;
            LAS const float* gv = VX + vb * 128;
            const float gtot = gv[d ? 0 : 63], gt = gv[((wid - 4) & 3) * 16 + r16];
#pragma unroll
            for (int ks = 0; ks < 2; ++ks) {
                float x[8], gs[8];
                unpack8(v.f[ks], x);
                const f32x4 ga = *(LAS const f32x4*)(gv + ks * 32 + 8 * q4), gb = *(LAS const f32x4*)(gv + ks * 32 + 8 * q4 + 4);
#pragma unroll
                for (int jj = 0; jj < 8; ++jj) gs[jj] = jj < 4 ? ga[jj & 3] : gb[jj & 3];
                if (wid < 4) {
                    const f32x4 da = *(LAS const f32x4*)(gv + 64 + ks * 32 + 8 * q4), db = *(LAS const f32x4*)(gv + 64 + ks * 32 + 8 * q4 + 4);
                    float xd[8], xc[8];
#pragma unroll
                    for (int jj = 0; jj < 8; ++jj) { const float dtv = jj < 4 ? da[jj & 3] : db[jj & 3]; xd[jj] = x[jj] * dtv; xc[jj] = xd[jj] * __expf(gtot - gs[jj]); }
                    *(LAS bf16x8*)(im + (wid * 2 + ks) * 1024 + lane * 16) = pack8(xd);
                    *(LAS bf16x8*)(im + (8 + wid * 2 + ks) * 1024 + lane * 16) = pack8(xc);
                } else {
                    const int t = (wid - 4) * 16 + r16; float w[8];
#pragma unroll
                    for (int jj = 0; jj < 8; ++jj) { const int s = ks * 32 + 8 * q4 + jj; const bool keep = d ? (s >= t) : (s <= t); w[jj] = keep ? x[jj] * __expf(gt - gs[jj]) : 0.f; }
                    *(LAS bf16x8*)(im + (16 + (wid - 4) * 2 + ks) * 1024 + lane * 16) = pack8(w);
                }
            }
        };
        auto load_vec = [&](int j) -> float {
            const int c = scan_chunk(j < NCH ? j : NCH - 1, d);
            const size_t dhc = ((size_t)d * 128 + hd) * NCH + c;
            return *(wid == 1 ? MDTC + dhc * 64 + lane : MGV + dhc * 64 + lane);
        };
        f32x4 S[2][4];
#pragma unroll
        for (int a = 0; a < 2; ++a)
#pragma unroll
            for (int b = 0; b < 4; ++b) S[a][b] = (f32x4){0.f, 0.f, 0.f, 0.f};
        MsOps o0, o1; MsIn ia, ib;
        load_in(0, ia); load_in(1, ib); load_ops(0, o0);
        float vnext = 0.f, vn1 = 0.f;
        vnext = load_vec(0); vn1 = load_vec(1);
        __syncthreads();
#pragma unroll
        for (int b = 0; b < 2; ++b) { unsigned zz = 0u; asm volatile("" : "+v"(zz)); ((LAS u32x4*)lds)[((2 * ph + b) * 4 + tq) * 64 + lane] = (u32x4){zz, zz, zz, zz}; }
        if (wid < 2) { VX[wid * 64 + lane] = vnext; VX[128 + wid * 64 + lane] = vn1; }
        __syncthreads();
        derive(0, ia, 0);
        __syncthreads();
        int vcur = 0;
        int buf = 0;
        auto flush_y = [&](int j) {
            const int c = scan_chunk(j, d);
            if (ctx_out || c < 256) {
                const int row = 8 * wid + (lane >> 3), piece = lane & 7;
                const u32x4 v = *(LAS const u32x4*)(lds + MS_YT + (j & 1) * 8192 + row * 128 + piece * 16);
                *(u32x4*)(MY + ((size_t)d * T + hg_chunk_row(c) + row) * 8192 + hd * 64 + piece * 8) = v;
            }
        };
        auto step = [&](int j, const MsOps& u, MsOps& ld, const MsIn& inx, MsIn& inl) {
            load_ops(j + 1, ld);
            load_in(j + 2, inl);
            vnext = load_vec(j + 2);
            if (j > 0) flush_y(j - 1);
            const int vn = vcur == 2 ? 0 : vcur + 1, vn2 = vn == 2 ? 0 : vn + 1;
            LAS const float* gv = VX + vcur * 128;
            LAS const unsigned char* im = lds + MS_DV + buf * 24576;
#define MS_FR(fi) (*(LAS const bf16x8*)(im + (fi) * 1024 + lane * 16))
            if (wid < 4) {
                const int tl = wid * 16;
                const f32x4 gr = *(LAS const f32x4*)(gv + tl + 4 * q4);
                const f32x4 eg = {__expf(gr[0]), __expf(gr[1]), __expf(gr[2]), __expf(gr[3])};
                const bf16x8 wA0 = MS_FR(16 + wid * 2), wA1 = MS_FR(16 + wid * 2 + 1);
                bf16x8 sb[4][4], xf[4][2];
#pragma unroll
                for (int pj = 0; pj < 4; ++pj) {
#pragma unroll
                    for (int kk = 0; kk < 4; ++kk) sb[pj][kk] = Sx[((buf * 4 + pj) * 4 + kk) * 64 + lane];
                    xf[pj][0] = MS_FR(pj * 2); xf[pj][1] = MS_FR(pj * 2 + 1);
                }
                __builtin_amdgcn_sched_barrier(0);
                f32x4 acc[4];
#pragma unroll
                for (int pj = 0; pj < 4; ++pj) acc[pj] = (f32x4){0.f, 0.f, 0.f, 0.f};
#pragma unroll
                for (int kk = 0; kk < 4; ++kk)
#pragma unroll
                    for (int pj = 0; pj < 4; ++pj) acc[pj] = __builtin_amdgcn_mfma_f32_16x16x32_bf16(u.fr[kk], sb[pj][kk], acc[pj], 0, 0, 0);
#pragma unroll
                for (int pj = 0; pj < 4; ++pj) acc[pj] = acc[pj] * eg;
#pragma unroll
                for (int pj = 0; pj < 4; ++pj) acc[pj] = __builtin_amdgcn_mfma_f32_16x16x32_bf16(wA0, xf[pj][0], acc[pj], 0, 0, 0);
#pragma unroll
                for (int pj = 0; pj < 4; ++pj) acc[pj] = __builtin_amdgcn_mfma_f32_16x16x32_bf16(wA1, xf[pj][1], acc[pj], 0, 0, 0);
#pragma unroll
                for (int pj = 0; pj < 4; ++pj)
#pragma unroll
                    for (int i = 0; i < 4; ++i) ((LAS bf16_t*)(lds + MS_YT + (j & 1) * 8192))[(tl + 4 * q4 + i) * 64 + pj * 16 + r16] = f2bf_n(acc[pj][i]);
            } else {
                const float Dc = __expf(gv[d ? 0 : 63]);
                bf16x8 xc[4][2];
#pragma unroll
                for (int pj = 0; pj < 4; ++pj) { xc[pj][0] = MS_FR(8 + pj * 2); xc[pj][1] = MS_FR(8 + pj * 2 + 1); }
                __builtin_amdgcn_sched_barrier(0);
#pragma unroll
                for (int pj = 0; pj < 4; ++pj)
#pragma unroll
                    for (int a = 0; a < 2; ++a) S[a][pj] = Dc * S[a][pj];
#pragma unroll
                for (int h2 = 0; h2 < 2; ++h2)
#pragma unroll
                    for (int pj = 0; pj < 4; ++pj)
#pragma unroll
                        for (int a = 0; a < 2; ++a) S[a][pj] = __builtin_amdgcn_mfma_f32_16x16x32_bf16(u.fr[a * 2 + h2], xc[pj][h2], S[a][pj], 0, 0, 0);
            }
#undef MS_FR
            derive(buf ^ 1, inx, vn);
            if (wid >= 4) {
#pragma unroll
                for (int pj = 0; pj < 4; ++pj) {
                    u32x4 sw; sw.x = cvt_pk_bf16_n(S[0][pj][0], S[0][pj][1]); sw.y = cvt_pk_bf16_n(S[0][pj][2], S[0][pj][3]); sw.z = cvt_pk_bf16_n(S[1][pj][0], S[1][pj][1]); sw.w = cvt_pk_bf16_n(S[1][pj][2], S[1][pj][3]);
                    ((LAS u32x4*)lds)[(((buf ^ 1) * 4 + pj) * 4 + (wid - 4)) * 64 + lane] = sw;
                }
            }
            if (wid < 2) VX[vn2 * 128 + wid * 64 + lane] = vnext;
            lds_barrier();
            buf ^= 1; vcur = vn;
        };
#pragma unroll 1
        for (int j = 0; j < NCH; j += 2) { step(j, o0, o1, ib, ia); step(j + 1, o1, o0, ia, ib); }
        flush_y(NCH - 1);
    }
}
struct MrRaw { u32x4 a[2], b[2], x[2], z[2]; };
__device__ __forceinline__ void phase_mb_readout(PP p) {
    const int tid = mk_tid(), lane = tid & 63, wid = __builtin_amdgcn_readfirstlane(tid >> 6), G = gridDim.x, bid = mk_bid();
    const bf16_t* Y0 = wsp<const bf16_t>(p, MB_Y); const bf16_t* Y1 = Y0 + (size_t)T * 8192; const bf16_t* XS = wsp<const bf16_t>(p, MB_XS); const bf16_t* Z = wsp<const bf16_t>(p, MB_Z);
    bf16_t* Y = wsp<bf16_t>(p, WS_YB); const float* ng = p->in[I_SSMNORM]; const float* dsk = p->in[I_SSMD];
    const unsigned c = (unsigned)(wid & 7) * 1024u + (unsigned)lane * 8u;
    f32x4 n[2][2]; float dk[2];
#pragma unroll
    for (int i = 0; i < 2; ++i) { n[i][0] = *(const f32x4*)(ng + c + i * 512u); n[i][1] = *(const f32x4*)(ng + c + i * 512u + 4u); dk[i] = dsk[(c + i * 512u) >> 6]; }
    auto load = [&](int i, MrRaw& w) {
        const int r = bid + i * G; const size_t ro = (size_t)(r < T ? r : T - 1) * 8192;
#pragma unroll
        for (int h = 0; h < 2; ++h) { w.a[h] = *(const u32x4*)(Y0 + ro + c + h * 512u); w.b[h] = *(const u32x4*)(Y1 + ro + c + h * 512u); w.x[h] = *(const u32x4*)(XS + ro + c + h * 512u); w.z[h] = *(const u32x4*)(Z + ro + c + h * 512u); }
    };
    auto process = [&](int i, const MrRaw& w) {
        int r = bid + i * G;
        asm volatile("" : "+s"(r));
        float v[2][8]; float ss = 0.f;
#pragma unroll
        for (int h = 0; h < 2; ++h) {
            float a[8], b[8], x[8], z[8]; unpack8u(w.a[h], a); unpack8u(w.b[h], b); unpack8u(w.x[h], x); unpack8u(w.z[h], z);
#pragma unroll
            for (int e = 0; e < 8; ++e) { const float y = (a[e] + b[e] + dk[h] * x[e]) * siluf_(z[e]); v[h][e] = y; ss += y * y; }
        }
        const float rs = rsqrtf(wave_sum(ss) * (1.0f / 1024.0f) + RMS_EPS);
        if (r < T) {
#pragma unroll
            for (int h = 0; h < 2; ++h) {
                f32x4 o0, o1;
#pragma unroll
                for (int e = 0; e < 4; ++e) { o0[e] = v[h][e] * rs * n[h][0][e]; o1[e] = v[h][4 + e] * rs * n[h][1][e]; }
                st_bf16x8(Y + (size_t)r * 8192 + c + h * 512u, o0, o1);
            }
        }
    };
    const int nmine = bid < T ? (T - bid + G - 1) / G : 0;
    MrRaw ra, rb, rc;
    load(0, ra); load(1, rb);
#pragma unroll 1
    for (int i = 0; i < nmine; i += 3) {
        load(i + 2, rc); process(i, ra);
        load(i + 3, ra); process(i + 1, rb);
        load(i + 4, rb); process(i + 2, rc);
    }
}

struct QkRaw { u32x4 x[10]; f32x2 cs[4]; };
__device__ __forceinline__ void phase_at_qknorm(PP p) {
    const int tid = mk_tid(), lane = tid & 63, wid = __builtin_amdgcn_readfirstlane(tid >> 6), G = gridDim.x, bid = mk_bid();
    const int sub = lane >> 4, l16 = lane & 15;
    bf16_t* Qb = wsp<bf16_t>(p, AT_Q); bf16_t* Kb = wsp<bf16_t>(p, AT_K);
    const float* rope = wsp<const float>(p, WS_ROPE);
    float gq[8], gk[8];
#pragma unroll
    for (int e = 0; e < 8; ++e) { gq[e] = p->in[I_ATQN][l16 * 8 + e]; gk[e] = p->in[I_ATKN][l16 * 8 + e]; }
    auto piece_ptr = [&](int r, int it) -> bf16_t* {
        return it < 8 ? Qb + (size_t)r * 4096 + (it * 4 + sub) * 128 + l16 * 8 : Kb + (size_t)r * 1024 + ((it - 8) * 4 + sub) * 128 + l16 * 8;
    };
    auto one = [&](u32x4 raw, bool isq, const float (&cs)[4], const float (&sn)[4], bf16_t* ptr) {
        float x[8]; unpack8u(raw, x);
        float ss = 0.f;
#pragma unroll
        for (int e = 0; e < 8; ++e) ss += x[e] * x[e];
        ss = row16_all(ss, OpSum());
        const float rs = rsqrtf(ss * (1.0f / 128.0f) + RMS_EPS);
        float y[8], o[8];
#pragma unroll
        for (int e = 0; e < 8; ++e) y[e] = x[e] * rs * (isq ? gq[e] : gk[e]);
#pragma unroll
        for (int e2 = 0; e2 < 4; ++e2) { o[2 * e2] = y[2 * e2] * cs[e2] - y[2 * e2 + 1] * sn[e2]; o[2 * e2 + 1] = y[2 * e2] * sn[e2] + y[2 * e2 + 1] * cs[e2]; }
        u32x4 w; w.x = cvt_pk_bf16(o[0], o[1]); w.y = cvt_pk_bf16(o[2], o[3]); w.z = cvt_pk_bf16(o[4], o[5]); w.w = cvt_pk_bf16(o[6], o[7]);
        *(u32x4*)ptr = w;
    };
    const int rw0 = bid * 8 + wid, nmine = rw0 < TL ? (TL - rw0 + G * 8 - 1) / (G * 8) : 0;
    auto load = [&](int i, QkRaw& w) {
        int r = rw0 + i * G * 8; r = r < TL ? r : TL - 1;
#pragma unroll
        for (int it = 0; it < 10; ++it) w.x[it] = *(const u32x4*)piece_ptr(r, it);
        const int pos = (l16 < 8) ? (r >> 6) : (r & 63);
#pragma unroll
        for (int e2 = 0; e2 < 4; ++e2) w.cs[e2] = *(const f32x2*)(rope + (size_t)(pos * 32 + ((l16 * 4 + e2) & 31)) * 2);
    };
    auto process = [&](int i, const QkRaw& w) {
        int r = rw0 + i * G * 8;
        asm volatile("" : "+s"(r));
        if (r < TL) {
            float cs[4], sn[4];
#pragma unroll
            for (int e2 = 0; e2 < 4; ++e2) { cs[e2] = w.cs[e2][0]; sn[e2] = w.cs[e2][1]; }
#pragma unroll
            for (int it = 0; it < 10; ++it) one(w.x[it], it < 8, cs, sn, piece_ptr(r, it));
        }
    };
    {
        QkRaw ra;
#pragma unroll 1
        for (int i = 0; i < nmine; ++i) { load(i, ra); process(i, ra); }
    }
    {
        const float cs[4] = {1.f, 1.f, 1.f, 1.f}, sn[4] = {0.f, 0.f, 0.f, 0.f};
        static_assert(pg8::TailOrder::pick_sk(AT_PROJ / 256, D / 64) == 8, "q/k norm sums 8 context partial sums");
        const bf16_t* part = wsp<const bf16_t>(p, WS_PART); bf16_t* Vb = wsp<bf16_t>(p, AT_V);
        auto sum8 = [&](int rr, int col) -> u32x4 {
            u32x4 pw[8];
#pragma unroll
            for (int s = 0; s < 8; ++s) pw[s] = *(const u32x4*)(part + ((size_t)(s * 256 + rr)) * AT_PROJ + col);
            f32x4 a = {0.f, 0.f, 0.f, 0.f}, b = a;
#pragma unroll
            for (int s = 0; s < 8; ++s) { a += (f32x4){bf_lo(pw[s].x), bf_hi(pw[s].x), bf_lo(pw[s].y), bf_hi(pw[s].y)}; b += (f32x4){bf_lo(pw[s].z), bf_hi(pw[s].z), bf_lo(pw[s].w), bf_hi(pw[s].w)}; }
            u32x4 o; o.x = cvt_pk_bf16(a[0], a[1]); o.y = cvt_pk_bf16(a[2], a[3]); o.z = cvt_pk_bf16(b[0], b[1]); o.w = cvt_pk_bf16(b[2], b[3]); return o;
        };
        for (int rr = bid; rr < TC; rr += G) {
            const int r = TL + rr;
            bf16_t* pq = piece_ptr(r, wid); bf16_t* pk = piece_ptr(r, 8 + (wid & 1));
            const u32x4 xq = sum8(rr, (wid * 4 + sub) * 128 + l16 * 8);
            const int c2 = wid < 2 ? 4096 + ((wid & 1) * 4 + sub) * 128 + l16 * 8 : 5120 + (((wid - 2) & 1) * 64 + lane) * 8;
            const u32x4 x2 = sum8(rr, c2);
            if (wid < 2) one(x2, false, cs, sn, pk);
            else if (wid < 4) *(u32x4*)(Vb + (size_t)r * 1024 + ((wid - 2) * 64 + lane) * 8) = x2;
            one(xq, true, cs, sn, pq);
        }
    }
}
__device__ __forceinline__ void phase_attention(PP p, unsigned char* lds, bool ctx_out) {
    const int G = gridDim.x, b = mk_bid();
    const bf16_t* Qb = wsp<const bf16_t>(p, AT_Q); const bf16_t* Kb = wsp<const bf16_t>(p, AT_K); const bf16_t* Vb = wsp<const bf16_t>(p, AT_V);
    bf16_t* Y = wsp<bf16_t>(p, WS_YB);
    const int nit = ctx_out ? 2048 + 32 : 2048;
    for (int idx = b; idx < nit; idx += G) {
        int hq, row0, krow0, seq;
        if (idx < 2048) { const int kvh = idx & 7, li = idx >> 3; hq = kvh * 4 + (li >> 6); row0 = (li & 63) * 256; krow0 = 0; seq = T; }
        else { hq = idx - 2048; row0 = TL; krow0 = TL; seq = TC; }
        const int kvh = hq >> 2;
        att::attn_dense_body<bf16_t>(Qb + (size_t)row0 * 4096 + hq * 128, Kb + (size_t)krow0 * 1024 + kvh * 128, Vb + (size_t)krow0 * 1024 + kvh * 128,
                                     Y + (size_t)row0 * 4096 + hq * 128, seq, (char*)lds);
        __syncthreads();
    }
}
constexpr int N_PHASE = 3 + 16 * DEPTH;
__global__ void __launch_bounds__(NT, 2) mk_fwd(Params p_unused) {
    extern __shared__ __attribute__((aligned(16))) unsigned char lds[];
    LAS unsigned char* ldsl = (LAS unsigned char*)lds;
    ((LAS int*)(ldsl + LDS_WMAP))[mk_hwslot()] = (int)(threadIdx.x >> 6);
#if !MK_MULTI
    if (threadIdx.x < 4) ((LAS unsigned*)(ldsl + LDS_XB))[threadIdx.x] = 0u;
#endif
    __syncthreads();
#if !MK_MULTI
    XcdBarrier bar = xcd_barrier_post(wsp<unsigned>((PP)__builtin_amdgcn_kernarg_segment_ptr(), WS_CTL), (volatile LAS unsigned*)(ldsl + LDS_XB));
#endif
    PP kp = (PP)__builtin_amdgcn_kernarg_segment_ptr();
    const int lo = kp->ph_lo, hi = kp->ph_hi;
#ifndef MK_PROBE
#define MK_PROBE 0
#endif
#define REPS(t) ((MK_PROBE == 1 && ((t) == 3 || (t) == 8 || (t) == 9 || (t) == 12 || (t) == 13 || (t) == 19 || (t) == 21 || (t) == 23)) || (MK_PROBE == 2 && (t) == 11) || \
                 (MK_PROBE == 4 && (t) == 0) || (MK_PROBE == 5 && (t) == 4) || (MK_PROBE == 6 && (t) == 6) || (MK_PROBE == 7 && ((t) == 15 || (t) == 17)) || \
                 (MK_PROBE == 8 && ((t) == 7 || (t) == 18 || (t) == 22 || (t) == 14)) || (MK_PROBE == 9 && (t) == 15) || (MK_PROBE == 10 && (t) == 18) || (MK_PROBE == 11 && (t) == 7) || (MK_PROBE == 12 && (t) == 22) || (MK_PROBE == 13 && (t) == 14) || (MK_PROBE == 14 && (t) == 10) || (MK_PROBE == 15 && (t) == 17) || (MK_PROBE == 16 && ((t) == 20 || (t) == 24) && 0) ? 2 : 1)
#ifdef MK_ONLY
#define TAGON(t) ((t) == MK_ONLY)
#else
#define TAGON(t) true
#endif
#if MK_MULTI
#define PHASE(tag, id, body) do { if (TAGON(tag)) if (lo <= (id) && (id) < hi) { PP p = launder(kp); body; } } while (0)
#else
#define PHASE(tag, id, body) do { if (TAGON(tag)) if (lo <= (id) && (id) < hi) { for (int rep_ = 0; rep_ < REPS(tag); ++rep_) { { PP p = launder(kp); body; } if ((id) + 1 < hi) { xcd_barrier(bar); } } } } while (0)
#endif
    PHASE(0, 0, phase_prologue1(p, ldsl));
    PHASE(1, 1, phase_modreduce(p));
    PHASE(2, 2, phase_mod0(p));
#pragma unroll 1
    for (int l = 0; l < DEPTH; ++l) {
        const int kind = l % 3, j = l / 3, pb = 3 + 16 * l;
        const bool ctx_out = l < DEPTH - 1;
        const int Mo = ctx_out ? T : TL;
        if (kind == 0) {
#define F_HGIN FHgIn{wsp<bf16_t>(p, HG_QB), wsp<float>(p, HG_LF), wsp<bf16_t>(p, HG_KB), wsp<bf16_t>(p, HG_V), wsp<bf16_t>(p, HG_SG), wsp<const float>(p, WS_LB) + j * 2048}
            PHASE(3, pb + 0, run_gemm(p, ldsl, wsp<const bf16_t>(p, WS_H), wsp<const bf16_t>(p, WS_HGIN + j * SZ_HGIN), T, HG_PROJ, D, F_HGIN));
            PHASE(25, pb + 1, run_ctx_reduce(p, HG_PROJ, D, F_HGIN));
            PHASE(4, pb + 2, phase_hg_prep(p, ldsl));
            PHASE(6, pb + 4, phase_hg_scan(p, ldsl, ctx_out));
            PHASE(7, pb + 6, phase_hg_readout(p, ldsl, j, ctx_out));
            PHASE(8, pb + 7, run_gemm(p, ldsl, wsp<const bf16_t>(p, WS_YB), wsp<const bf16_t>(p, WS_HGOUT + j * SZ_SQ), Mo, D, D, FBf16{wsp<bf16_t>(p, WS_OB), D}));
        } else if (kind == 1) {
#define F_ATIN FAtIn{wsp<bf16_t>(p, AT_Q), wsp<bf16_t>(p, AT_K), wsp<bf16_t>(p, AT_V)}
            PHASE(9, pb + 0, run_gemm(p, ldsl, wsp<const bf16_t>(p, WS_H), wsp<const bf16_t>(p, WS_ATQKV), T, AT_PROJ, D, F_ATIN));
            PHASE(10, pb + 2, phase_at_qknorm(p));
            PHASE(11, pb + 3, phase_attention(p, lds, ctx_out));
            PHASE(12, pb + 7, run_gemm(p, ldsl, wsp<const bf16_t>(p, WS_YB), wsp<const bf16_t>(p, WS_ATOUT), Mo, D, D, FBf16{wsp<bf16_t>(p, WS_OB), D}));
        } else {
#define F_MBIN FMbIn{wsp<bf16_t>(p, MB_Z), wsp<bf16_t>(p, MB_XBC), wsp<float>(p, MB_DT)}
            PHASE(13, pb + 0, run_gemm(p, ldsl, wsp<const bf16_t>(p, WS_H), wsp<const bf16_t>(p, WS_SSMIN), T, SSM_PROJ, D, F_MBIN));
            PHASE(27, pb + 1, run_ctx_reduce(p, SSM_PROJ, D, F_MBIN));
            PHASE(15, pb + 3, phase_mb_prep(p, ldsl));
            PHASE(17, pb + 5, phase_mb_scan(p, ldsl, ctx_out));
            PHASE(18, pb + 6, phase_mb_readout(p));
            PHASE(19, pb + 7, run_gemm(p, ldsl, wsp<const bf16_t>(p, WS_YB), wsp<const bf16_t>(p, WS_SSMOUT), Mo, D, 8192, FBf16{wsp<bf16_t>(p, WS_OB), D}));
        }
        static_assert(pg8::TailOrder::pick_sk(D / 256, D / 64) == 16 && pg8::TailOrder::pick_sk(D / 256, 8192 / 64) == 16, "phase_ln sums 16 context partial sums");
        PHASE(20, pb + 9, phase_ln(p, ldsl, l, 0));
        PHASE(21, pb + 10, run_gemm_gu(p, ldsl, l, Mo));
        PHASE(22, pb + 12, phase_ffn_fix(p, l, ctx_out));
        PHASE(23, pb + 13, run_gemm(p, ldsl, wsp<const bf16_t>(p, WS_HID), wsp<const bf16_t>(p, WS_FD + l * SZ_SQ), Mo, D, D, FBf16{wsp<bf16_t>(p, WS_OB), D}));
        PHASE(24, pb + 15, phase_ln(p, ldsl, l, 1));
    }
#undef PHASE
}

static bool phase_used_host(int id) {
    if (id < 3) return true;
    const int l = (id - 3) >> 4, k = (id - 3) & 15, kind = l % 3; const bool ctx_out = l < DEPTH - 1;
    if (k == 11) return false;
    if (k == 8 || k == 14) return false;
    if (kind == 0) return !(k == 3 || k == 5);
    if (kind == 1) return !(k == 1 || k == 4 || k == 5 || k == 6);
    return !(k == 2 || k == 4);
}
extern "C" void kernel_launch(void* const* d_in, const int* in_sizes, int n_in, void* d_out, int out_size, void* d_ws, size_t ws_size, hipStream_t stream) {
    static int grid = 0;
    if (grid == 0) {
        if (n_in != 29 || out_size != TL * D || ws_size < WS_END) { fprintf(stderr, "kernel_launch: expected 29 inputs, %d outputs, >= %zu bytes of workspace; got %d, %d, %zu\n", TL * D, (size_t)WS_END, n_in, out_size, ws_size); grid = -1; return; }
        int dev = 0, cus = 0, per_cu = 0;
        if (hipGetDevice(&dev) != hipSuccess || hipDeviceGetAttribute(&cus, hipDeviceAttributeMultiprocessorCount, dev) != hipSuccess) { grid = -1; return; }
        if (hipFuncSetAttribute((const void*)mk_fwd, hipFuncAttributeMaxDynamicSharedMemorySize, LDS_BYTES) != hipSuccess) { fprintf(stderr, "kernel_launch: hipFuncSetAttribute failed\n"); grid = -1; return; }
        if (hipOccupancyMaxActiveBlocksPerMultiprocessor(&per_cu, (const void*)mk_fwd, NT, LDS_BYTES) != hipSuccess || per_cu < 1) { fprintf(stderr, "kernel_launch: occupancy query reports %d\n", per_cu); (void)hipGetLastError(); }
        grid = cus;
    }
    if (grid < 0) return;
    Params p{};
    for (int i = 0; i < 29; ++i) p.in[i] = (const float*)d_in[i];
    p.out = (float*)d_out; p.ws = (unsigned char*)d_ws;
#if MK_MULTI
    for (int id = 0; id < N_PHASE; ++id) {
        if (!phase_used_host(id)) continue;
        p.ph_lo = id; p.ph_hi = id + 1;
        hipLaunchKernelGGL(mk_fwd, dim3(grid), dim3(NT), LDS_BYTES, stream, p);
    }
#else
    (void)hipMemsetAsync((char*)d_ws + WS_CTL, 0, 65536, stream);
    p.ph_lo = 0; p.ph_hi = N_PHASE;
    hipLaunchKernelGGL(mk_fwd, dim3(grid), dim3(NT), LDS_BYTES, stream, p);
#endif
    const hipError_t le = hipPeekAtLastError();
    if (le != hipSuccess) fprintf(stderr, "kernel_launch: launch failed: %s\n", hipGetErrorName(le));
}
```
